# Optimizing an MI355X kernel written in HIP

```python
import jax
import jax.numpy as jnp
from jax import lax
import numpy as np

D_MODEL = 1024
BATCH = 4
SEQ = 4096
DEPTH = 2

CTX_LEN = 256
GRID_W = 64
CHUNK = 64
CONV_W = 3
EPS = 1e-6
M_INIT = -1e30
N_MOD = 6
N_EVEN = (DEPTH + 1) // 2
N_ODD = DEPTH // 2

GLA_HEADS = 4
GLA_DK = D_MODEL // (2 * GLA_HEADS)
GLA_DV = D_MODEL // GLA_HEADS
GLA_QK = GLA_HEADS * GLA_DK
GLA_V = GLA_HEADS * GLA_DV
GLA_GATE_RANK = 16
GLA_GATE_TAU = 16.0

SSD_HEADDIM = 64
SSD_HEADS = D_MODEL // SSD_HEADDIM
SSD_STATE = 128
SSD_GROUPS = 2
SSD_INNER = SSD_HEADS * SSD_HEADDIM
SSD_BC = SSD_GROUPS * SSD_STATE
SSD_XBC = SSD_INNER + 2 * SSD_BC

A_SIZES = (GLA_QK, GLA_QK, GLA_V, GLA_V, 2 * GLA_GATE_RANK, SSD_INNER, SSD_XBC, 2 * SSD_HEADS)
A_SPLITS = [sum(A_SIZES[:i + 1]) for i in range(len(A_SIZES) - 1)]
A_IN = sum(A_SIZES)
A_MIX = GLA_V + SSD_INNER

MLSTM_INNER = 2 * D_MODEL
MLSTM_HEADS = 4
MLSTM_DH = MLSTM_INNER // MLSTM_HEADS
QKV_BLOCK = 4

D_FF = -(-(8 * D_MODEL) // (3 * 256)) * 256

kernel_name = 'hybrid_gla_ssd_mlstm_prefix_trunk'


def rmsnorm(x, w):
    xf = x.astype(jnp.float32)
    xf = xf * lax.rsqrt(jnp.mean(xf * xf, axis=-1, keepdims=True) + EPS)
    return (xf * w.astype(jnp.float32)).astype(x.dtype)


def layernorm_nobias(x, w):
    xf = x.astype(jnp.float32)
    mu = jnp.mean(xf, axis=-1, keepdims=True)
    var = jnp.mean(jnp.square(xf - mu), axis=-1, keepdims=True)
    return ((xf - mu) * lax.rsqrt(var + EPS) * w.astype(jnp.float32)).astype(x.dtype)


def modulate(h, shift, scale):
    return h * (1.0 + scale) + shift


def swiglu(h, w1, w3, w2):
    return (jax.nn.silu(h @ w1) * (h @ w3)) @ w2


def dwconv_centred(x, w, b):
    left = (CONV_W - 1) // 2
    y = lax.conv_general_dilated(x, w[:, None, :], window_strides=(1,),
                                 padding=[(left, CONV_W - 1 - left)],
                                 dimension_numbers=('NWC', 'WIO', 'NWC'),
                                 feature_group_count=x.shape[-1])
    return y + b


def to_heads(t, n):
    b, l, f = t.shape
    return t.reshape(b, l, n, f // n).transpose(0, 2, 1, 3)


def flip_seq(t):
    return jnp.flip(t, axis=2)


def to_colmajor(x):
    b, l, d = x.shape
    rows = l // GRID_W
    return x.reshape(b, rows, GRID_W, d).transpose(0, 2, 1, 3).reshape(b, l, d)


def from_colmajor(x):
    b, l, d = x.shape
    rows = l // GRID_W
    return x.reshape(b, GRID_W, rows, d).transpose(0, 2, 1, 3).reshape(b, l, d)


def _chunks(t):
    return jnp.moveaxis(t.reshape(t.shape[:2] + (t.shape[2] // CHUNK, CHUNK) + t.shape[3:]), 2, 0)


def _unchunk(t):
    t = jnp.moveaxis(t, 0, 2)
    return t.reshape(t.shape[:2] + (-1,) + t.shape[4:])


def gated_linear_scan(q, k, v, log_a, s0):
    f32 = jnp.float32
    causal = jnp.tril(jnp.ones((CHUNK, CHUNK), dtype=bool))
    vector_decay = log_a.shape[-1] != 1

    def step(s, inp):
        qc, kc, vc, gc = inp
        g_cum = jnp.cumsum(gc, axis=2)
        g_last = g_cum[:, :, -1:, :]
        rel = jnp.exp(jnp.where(causal[:, :, None],
                                g_cum[:, :, :, None, :] - g_cum[:, :, None, :, :], -jnp.inf))
        if vector_decay:
            scores = jnp.einsum('bhik,bhjk,bhijk->bhij', qc, kc, rel)
        else:
            scores = jnp.einsum('bhik,bhjk->bhij', qc, kc) * rel[..., 0]
        o = (jnp.einsum('bhij,bhjv->bhiv', scores, vc)
             + jnp.einsum('bhik,bhkv->bhiv', qc * jnp.exp(g_cum), s))
        s = (s * jnp.exp(g_last)[:, :, 0, :, None]
             + jnp.einsum('bhjk,bhjv->bhkv', kc * jnp.exp(g_last - g_cum), vc))
        return s, o

    xs = tuple(_chunks(t.astype(f32)) for t in (q, k, v, log_a))
    s_fin, o = lax.scan(step, s0.astype(f32), xs)
    return _unchunk(o).astype(v.dtype), s_fin


def bidir_scan(q, k_f, k_b, v, la_f, la_b, s0_f, s0_b):
    o_f, s_f = gated_linear_scan(q, k_f, v, la_f, s0_f)
    o_b, s_b = gated_linear_scan(flip_seq(q), flip_seq(k_b), flip_seq(v), flip_seq(la_b), s0_b)
    return o_f + flip_seq(o_b), s_f, s_b


def mlstm_scan(q, k, v, log_i, log_f, state):
    f32 = jnp.float32
    causal = jnp.tril(jnp.ones((CHUNK, CHUNK), dtype=bool))

    def step(carry, inp):
        c0, n0, m0 = carry
        qc, kc, vc, ic, fc = inp
        b = jnp.cumsum(fc, axis=-1)
        log_d = jnp.where(causal, b[..., :, None] - b[..., None, :] + ic[..., None, :], -jnp.inf)
        log_inter = b + m0[..., None]
        m_row = jnp.maximum(log_inter, jnp.max(log_d, axis=-1))
        s = jnp.einsum('bhid,bhjd->bhij', qc, kc) * jnp.exp(log_d - m_row[..., None])
        w_inter = jnp.exp(log_inter - m_row)
        num = (jnp.einsum('bhij,bhje->bhie', s, vc)
               + w_inter[..., None] * jnp.einsum('bhid,bhde->bhie', qc, c0))
        den = jnp.sum(s, axis=-1) + w_inter * jnp.einsum('bhid,bhd->bhi', qc, n0)
        h = num / jnp.maximum(jnp.abs(den), jnp.exp(-m_row))[..., None]
        log_w = b[..., -1:] - b + ic
        m_new = jnp.maximum(b[..., -1] + m0, jnp.max(log_w, axis=-1))
        w_k = jnp.exp(log_w - m_new[..., None])[..., None]
        decay0 = jnp.exp(b[..., -1] + m0 - m_new)
        c_new = decay0[..., None, None] * c0 + jnp.einsum('bhjd,bhje->bhde', kc * w_k, vc)
        n_new = decay0[..., None] * n0 + jnp.sum(kc * w_k, axis=2)
        return (c_new, n_new, m_new), h

    xs = tuple(_chunks(t.astype(f32)) for t in (q, k, v, log_i, log_f))
    final, h = lax.scan(step, state, xs)
    return _unchunk(h).astype(v.dtype), final


def zero_states_gla_ssd(b):
    f32 = jnp.float32
    gla = jnp.zeros((b, GLA_HEADS, GLA_DK, GLA_DV), f32)
    ssd = jnp.zeros((b, SSD_HEADS, SSD_STATE, SSD_HEADDIM), f32)
    return (gla, gla, ssd, ssd)


def zero_states_mlstm(b):
    f32 = jnp.float32
    st = (jnp.zeros((b, MLSTM_HEADS, MLSTM_DH, MLSTM_DH), f32),
          jnp.zeros((b, MLSTM_HEADS, MLSTM_DH), f32),
          jnp.full((b, MLSTM_HEADS), M_INIT, f32))
    return (st, st)


def gla_ssd_features(h, init, w_in, gla_w_gate, gla_b_gate, gla_norm, conv_w, conv_b,
                     a_log, dt_bias, d_skip, ssd_norm):
    b, l, _ = h.shape
    f32 = jnp.float32
    q, k, v, g, r, z, xbc, dt = jnp.split(h @ w_in, A_SPLITS, axis=-1)
    qh = to_heads(q, GLA_HEADS) * (GLA_DK ** -0.5)
    kh = to_heads(k, GLA_HEADS)
    vh = to_heads(v, GLA_HEADS)
    gate_logit = jnp.einsum('bldr,drk->bldk', r.reshape(b, l, 2, GLA_GATE_RANK), gla_w_gate) + gla_b_gate
    log_alpha = jax.nn.log_sigmoid(gate_logit.astype(f32)) / GLA_GATE_TAU
    o_gla, sg_f, sg_b = bidir_scan(qh, kh, kh, vh,
                                   to_heads(log_alpha[:, :, 0], GLA_HEADS),
                                   to_heads(log_alpha[:, :, 1], GLA_HEADS), init[0], init[1])
    o_gla = rmsnorm(o_gla.transpose(0, 2, 1, 3), gla_norm).reshape(b, l, GLA_V) * jax.nn.silu(g)
    xbc = jax.nn.silu(dwconv_centred(xbc, conv_w, conv_b))
    xs, bm, cm = jnp.split(xbc, [SSD_INNER, SSD_INNER + SSD_BC], axis=-1)
    dt = jax.nn.softplus(dt.reshape(b, l, 2, SSD_HEADS).astype(f32) + dt_bias.astype(f32))
    dt = dt.transpose(2, 0, 3, 1)[..., None]
    log_a = dt * (-jnp.exp(a_log.astype(f32)))[:, None, :, None, None]
    rep = SSD_HEADS // SSD_GROUPS
    xh = to_heads(xs, SSD_HEADS)
    bh = jnp.repeat(to_heads(bm, SSD_GROUPS), rep, axis=1)
    ch = jnp.repeat(to_heads(cm, SSD_GROUPS), rep, axis=1)
    y, ss_f, ss_b = bidir_scan(ch, bh * dt[0], bh * dt[1], xh, log_a[0], log_a[1], init[2], init[3])
    y = y + xh * d_skip[None, :, None, None]
    y = y.transpose(0, 2, 1, 3).reshape(b, l, SSD_INNER) * jax.nn.silu(z)
    y = rmsnorm(y.reshape(b, l, SSD_GROUPS, SSD_INNER // SSD_GROUPS),
                ssd_norm.reshape(SSD_GROUPS, SSD_INNER // SSD_GROUPS)).reshape(b, l, SSD_INNER)
    return jnp.concatenate([o_gla, y.astype(o_gla.dtype)], axis=-1), (sg_f, sg_b, ss_f, ss_b)


def mlstm_features(h, init, w_up, conv_w, conv_b, wq, wk, wv, w_if, b_if, mh_norm, skip):
    b, l, _ = h.shape
    f32 = jnp.float32
    xm, z = jnp.split(h @ w_up, 2, axis=-1)
    xc = jax.nn.silu(dwconv_centred(xm, conv_w, conv_b))

    def blockdiag(t, w):
        return jnp.einsum('blnd,nde->blne', t.reshape(b, l, -1, QKV_BLOCK), w).reshape(b, l, MLSTM_INNER)

    q, k, v = blockdiag(xc, wq), blockdiag(xc, wk), blockdiag(xm, wv)
    gates = sum(jnp.einsum('blc,dcg->dbgl', t, w_if[:, i * MLSTM_INNER:(i + 1) * MLSTM_INNER]).astype(f32)
                for i, t in enumerate((q, k, v)))
    gates = gates + b_if.astype(f32)[:, None, :, None]
    log_i = gates[:, :, :MLSTM_HEADS]
    log_f = jax.nn.log_sigmoid(gates[:, :, MLSTM_HEADS:])
    qh = to_heads(q, MLSTM_HEADS)
    kh = to_heads(k, MLSTM_HEADS) * (MLSTM_DH ** -0.5)
    vh = to_heads(v, MLSTM_HEADS)
    h_f, st_f = mlstm_scan(qh, kh, vh, log_i[0], log_f[0], init[0])
    h_b, st_b = mlstm_scan(flip_seq(qh), flip_seq(kh), flip_seq(vh),
                           flip_seq(log_i[1]), flip_seq(log_f[1]), init[1])
    hs = (h_f + flip_seq(h_b)).transpose(0, 2, 1, 3)
    hs = layernorm_nobias(hs, mh_norm.reshape(MLSTM_HEADS, MLSTM_DH)).reshape(b, l, MLSTM_INNER)
    return (hs + skip * xc) * jax.nn.silu(z), (st_f, st_b)


def setup_inputs(seed: int = 0) -> dict:
    key = jax.random.key(seed)
    keys = iter(jax.random.split(key, 48))

    def nrm(shape, scale):
        return jax.random.normal(next(keys), shape, jnp.float32) * scale

    def gain(shape):
        return 1.0 + nrm(shape, 0.05)

    def uni(shape, lo, hi):
        return jax.random.uniform(next(keys), shape, jnp.float32, lo, hi)

    dt0 = jnp.exp(uni((N_EVEN, 2, SSD_HEADS), float(np.log(1e-3)), float(np.log(1e-1))))
    qkv_shape = (N_ODD, MLSTM_INNER // QKV_BLOCK, QKV_BLOCK, QKV_BLOCK)
    return {
        'x': nrm((BATCH, SEQ, D_MODEL), 1.0),
        'c': nrm((BATCH, D_MODEL), 1.0),
        'ctx': nrm((BATCH, CTX_LEN, D_MODEL), 1.0),
        'c_ctx': nrm((D_MODEL,), 1.0),
        'w_mod': nrm((DEPTH, D_MODEL, N_MOD * D_MODEL), D_MODEL ** -0.5),
        'b_mod': nrm((DEPTH, N_MOD * D_MODEL), 0.02),
        'norm_mix': gain((DEPTH, D_MODEL)),
        'norm_ffn': gain((DEPTH, D_MODEL)),
        'ffn_w1': nrm((DEPTH, D_MODEL, D_FF), D_MODEL ** -0.5),
        'ffn_w3': nrm((DEPTH, D_MODEL, D_FF), D_MODEL ** -0.5),
        'ffn_w2': nrm((DEPTH, D_FF, D_MODEL), D_FF ** -0.5),
        'a_w_in': nrm((N_EVEN, D_MODEL, A_IN), D_MODEL ** -0.5),
        'a_gla_w_gate': nrm((N_EVEN, 2, GLA_GATE_RANK, GLA_QK), GLA_GATE_RANK ** -0.5),
        'a_gla_b_gate': nrm((N_EVEN, 2, GLA_QK), 0.5),
        'a_gla_norm': gain((N_EVEN, GLA_DV)),
        'a_ssd_conv_w': nrm((N_EVEN, CONV_W, SSD_XBC), CONV_W ** -0.5),
        'a_ssd_conv_b': nrm((N_EVEN, SSD_XBC), 0.02),
        'a_ssd_A_log': jnp.log(uni((N_EVEN, 2, SSD_HEADS), 1.0, 16.0)),
        'a_ssd_dt_bias': dt0 + jnp.log(-jnp.expm1(-dt0)),
        'a_ssd_D': gain((N_EVEN, SSD_HEADS)),
        'a_ssd_norm': gain((N_EVEN, SSD_INNER)),
        'a_w_out': nrm((N_EVEN, A_MIX, D_MODEL), A_MIX ** -0.5),
        'b_w_up': nrm((N_ODD, D_MODEL, 2 * MLSTM_INNER), D_MODEL ** -0.5),
        'b_conv_w': nrm((N_ODD, CONV_W, MLSTM_INNER), CONV_W ** -0.5),
        'b_conv_b': nrm((N_ODD, MLSTM_INNER), 0.02),
        'b_wq': nrm(qkv_shape, QKV_BLOCK ** -0.5),
        'b_wk': nrm(qkv_shape, QKV_BLOCK ** -0.5),
        'b_wv': nrm(qkv_shape, QKV_BLOCK ** -0.5),
        'b_w_if': nrm((N_ODD, 2, 3 * MLSTM_INNER, 2 * MLSTM_HEADS), (3 * MLSTM_INNER) ** -0.5),
        'b_b_if': jnp.concatenate([nrm((N_ODD, 2, MLSTM_HEADS), 0.1),
                                   jnp.linspace(3.0, 6.0, MLSTM_HEADS) + nrm((N_ODD, 2, MLSTM_HEADS), 0.1)],
                                  axis=-1),
        'b_mh_norm': gain((N_ODD, MLSTM_INNER)),
        'b_skip': gain((N_ODD, MLSTM_INNER)),
        'b_w_down': nrm((N_ODD, MLSTM_INNER, D_MODEL), MLSTM_INNER ** -0.5),
        'final_norm': gain((D_MODEL,)),
    }


def reference(x, c, ctx, c_ctx, w_mod, b_mod, norm_mix, norm_ffn, ffn_w1, ffn_w3, ffn_w2,
              a_w_in, a_gla_w_gate, a_gla_b_gate, a_gla_norm, a_ssd_conv_w, a_ssd_conv_b,
              a_ssd_A_log, a_ssd_dt_bias, a_ssd_D, a_ssd_norm, a_w_out,
              b_w_up, b_conv_w, b_conv_b, b_wq, b_wk, b_wv, b_w_if, b_b_if, b_mh_norm, b_skip,
              b_w_down, final_norm):
    bsz = x.shape[0]
    for layer in range(DEPTH):
        last = layer == DEPTH - 1
        j = layer // 2
        mx = jnp.split((jax.nn.silu(c) @ w_mod[layer] + b_mod[layer])[:, None, :], N_MOD, axis=-1)
        mc = jnp.split(jax.nn.silu(c_ctx) @ w_mod[layer] + b_mod[layer], N_MOD, axis=-1)
        hx = modulate(rmsnorm(x, norm_mix[layer]), mx[0], mx[1])
        hc = modulate(rmsnorm(ctx, norm_mix[layer]), mc[0], mc[1])
        if layer % 2 == 0:
            pa = (a_w_in[j], a_gla_w_gate[j], a_gla_b_gate[j], a_gla_norm[j], a_ssd_conv_w[j],
                  a_ssd_conv_b[j], a_ssd_A_log[j], a_ssd_dt_bias[j], a_ssd_D[j], a_ssd_norm[j])
            fc, st = gla_ssd_features(hc, zero_states_gla_ssd(bsz), *pa)
            fx, _ = gla_ssd_features(hx, st, *pa)
            w_o = a_w_out[j]
        else:
            pb = (b_w_up[j], b_conv_w[j], b_conv_b[j], b_wq[j], b_wk[j], b_wv[j],
                  b_w_if[j], b_b_if[j], b_mh_norm[j], b_skip[j])
            fc, st = mlstm_features(hc, zero_states_mlstm(bsz), *pb)
            fx, _ = mlstm_features(to_colmajor(hx), st, *pb)
            fx = from_colmajor(fx)
            w_o = b_w_down[j]
        x = x + mx[2] * (fx @ w_o)
        x = x + mx[5] * swiglu(modulate(rmsnorm(x, norm_ffn[layer]), mx[3], mx[4]),
                               ffn_w1[layer], ffn_w3[layer], ffn_w2[layer])
        if not last:
            ctx = ctx + mc[2] * (fc @ w_o)
            ctx = ctx + mc[5] * swiglu(modulate(rmsnorm(ctx, norm_ffn[layer]), mc[3], mc[4]),
                                       ffn_w1[layer], ffn_w3[layer], ffn_w2[layer])
    return rmsnorm(x, final_norm)
```

```cpp
#ifndef EMU
#include <hip/hip_runtime.h>
#include <cstdio>
#include <cstdint>
#endif

#ifndef CFG_BATCH
#define CFG_BATCH 4
#define CFG_SEQ 4096
#define CFG_CTX 256
#define CFG_GW 64
#endif
constexpr int D = 1024, NB = CFG_BATCH, SEQ = CFG_SEQ, CTX = CFG_CTX, GW = CFG_GW, GROWS = SEQ / GW, CHUNK = 64;
constexpr int ML = NB * SEQ, MC = NB * CTX, MT = ML + MC;
static_assert(ML % 256 == 0 && MT % 256 == 0 && SEQ % 64 == 0 && CTX % 64 == 0, "row tiling");
constexpr int NMOD = 6 * D;
constexpr int DFF = 2816;
constexpr int A_IN = 5696, NP0 = 5888;
constexpr int C_G = 0, C_Z = 1024, C_Q = 2048, C_K = 2560, C_V = 3072, C_XS = 4096, C_B = 5120, C_C = 5376, C_R = 5632, C_DT = 5664;
constexpr float EPS = 1e-6f;
constexpr int NTHREADS = 512, NWAVES = 8;

#ifdef EMU
#define LAS
#define GAS
#define ASM_VMCNT(n) do {} while (0)
#define ASM_LGKMCNT(n) do {} while (0)
#define ASM_FENCE() do {} while (0)
#define WAVE_LDS_SYNC() emu::wave_sync()
#define OPAQUE_V(x) do {} while (0)
#else
#define LAS __attribute__((address_space(3)))
#define GAS __attribute__((address_space(1)))
#define ASM_VMCNT(n) asm volatile("s_waitcnt vmcnt(" #n ")" ::: "memory")
#define ASM_LGKMCNT(n) asm volatile("s_waitcnt lgkmcnt(" #n ")" ::: "memory")
#define ASM_FENCE() asm volatile("" ::: "memory")
#define OPAQUE_V(x) asm volatile("" : "+v"(x))
#define WAVE_LDS_SYNC() do { asm volatile("s_waitcnt lgkmcnt(0)" ::: "memory"); } while (0)
#endif

typedef unsigned short bf16_t;
typedef short bf16x8 __attribute__((ext_vector_type(8)));
typedef short bf16x4 __attribute__((ext_vector_type(4)));
typedef float f32x4 __attribute__((ext_vector_type(4)));
typedef float f32x2 __attribute__((ext_vector_type(2)));
typedef unsigned u32x4 __attribute__((ext_vector_type(4)));
typedef unsigned u32x2 __attribute__((ext_vector_type(2)));

__device__ __forceinline__ unsigned f2bf(float f) { unsigned u = __builtin_bit_cast(unsigned, f); return (u + 0x7fffu + ((u >> 16) & 1u)) >> 16; }
__device__ __forceinline__ unsigned pk2(float lo, float hi) { return f2bf(lo) | (f2bf(hi) << 16); }
__device__ __forceinline__ float bf2f(unsigned h) { return __builtin_bit_cast(float, (h & 0xffffu) << 16); }
__device__ __forceinline__ float bflo(unsigned w) { return __builtin_bit_cast(float, w << 16); }
__device__ __forceinline__ float bfhi(unsigned w) { return __builtin_bit_cast(float, w & 0xffff0000u); }
__device__ __forceinline__ float sigmoidf_(float x) { return 1.0f / (1.0f + __expf(-x)); }
__device__ __forceinline__ float siluf_(float x) { return x / (1.0f + __expf(-x)); }
__device__ __forceinline__ float log_sigmoidf_(float x) { return fminf(x, 0.f) - log1pf(__expf(-fabsf(x))); }
__device__ __forceinline__ float softplusf_(float x) { return fmaxf(x, 0.f) + log1pf(__expf(-fabsf(x))); }
__device__ __forceinline__ float wave_sum(float v) {
#pragma unroll
    for (int o = 1; o < 64; o <<= 1) v += __shfl_xor(v, o);
    return v;
}

constexpr size_t MiB = 1u << 20;
constexpr size_t WS_CTL = 0;
constexpr size_t WS_MOD = 64 * 1024;
constexpr size_t MOD_BYTES = (size_t)2 * (NB + 1) * NMOD * 4;
constexpr size_t CTL_ZERO_BYTES = 512 * 1024;
static_assert(WS_MOD + MOD_BYTES <= CTL_ZERO_BYTES, "mods inside the memset region");
constexpr size_t WS_GATES = 1 * MiB;
constexpr size_t WS_WB = 3 * MiB;
constexpr size_t WS_CTXRES = 9 * MiB;
constexpr size_t WS_H = 13 * MiB;
constexpr size_t WS_BIG = 47 * MiB;
constexpr size_t BIG_BYTES = (size_t)MT * NP0 * 2;
constexpr size_t WS_WA = WS_BIG + ((BIG_BYTES + 255) & ~(size_t)255);
constexpr size_t WS_END = WS_WA + 12 * MiB;
static_assert(WS_CTXRES + (size_t)MC * D * 4 <= WS_H && WS_H + (size_t)MT * D * 2 <= WS_BIG, "workspace map");
static_assert((size_t)MT * 4096 * 2 + (size_t)ML * 2048 * 2 <= BIG_BYTES + 5 * MiB, "layer-1 O spills at most 5 MiB into WA");
static_assert(WS_END <= 256 * MiB, "workspace fits 256 MiB");

struct Params {
    const float* in[34];
    float* out;
    unsigned char* ws;
};
enum { I_X = 0, I_C, I_CTX, I_CCTX, I_WMOD, I_BMOD, I_NMIX, I_NFFN, I_W1, I_W3, I_W2, I_AWIN, I_AGW, I_AGB, I_AGN, I_ACW, I_ACB, I_AALOG, I_ADTB, I_AD, I_ASN, I_AWOUT,
       I_BWUP, I_BCW, I_BCB, I_BWQ, I_BWK, I_BWV, I_BWIF, I_BBIF, I_BMHN, I_BSKIP, I_BWDOWN, I_FNORM };

namespace pg8 {
constexpr int BM = 256, BK = 64, HALF = 128, HTB = HALF * BK * 2, STAGE_BYTES = 8 * HTB, NXCD = 8, WGM = 8;
__host__ __device__ __forceinline__ int lds_byte(int r, int c) { const int st = (r >> 4) * 2 + (c >> 5), rr = r & 15, cc = c & 31, ob = rr * 64 + cc * 2; return st * 1024 + (ob ^ (((ob >> 9) & 1) << 5)); }
__host__ __device__ __forceinline__ void stage_rc(int b, int& R, int& C) { const int st = b / 1024, sb = b % 1024, swz = sb ^ (((sb >> 9) & 1) << 5); R = (st >> 1) * 16 + swz / 64; C = (st & 1) * 32 + (swz % 64) / 2; }
__host__ __device__ __forceinline__ int perm32(int rho) { const int n = rho >> 4, i = rho & 15; return 8 * (i >> 2) + 4 * n + (i & 3); }
struct Unit { int pm, pn; };
struct Gemm { const bf16_t* A; const bf16_t* Bt; int M, N, K, lda; };
struct StaticOrder {
    int nM, nN, nwg, G, c;
    __host__ __device__ void init(int M, int N, int G_, int c_) { nM = M / BM; nN = N / BM; nwg = nM * nN; G = G_; c = c_; }
    __host__ __device__ bool next(int i, Unit& u) const {
        const long L = (long)i * G + c; if (L >= nwg) return false;
        int wgid = (int)L; { const int q = nwg / NXCD, r = nwg % NXCD, xcd = wgid % NXCD, off = wgid / NXCD; wgid = (xcd < r ? xcd * (q + 1) : r * (q + 1) + (xcd - r) * q) + off; }
        const int nig = WGM * nN, gid = wgid / nig, fm = gid * WGM, gsz = (nM - fm) < WGM ? (nM - fm) : WGM;
        u.pm = fm + ((wgid % nig) % gsz); u.pn = (wgid % nig) / gsz; return true;
    }
};
template <class Epi>
__device__ __forceinline__ void gemm_phase(LAS unsigned char* lds, const Gemm g, const StaticOrder& S, const Epi& E) {
    const int tid = threadIdx.x, wid = __builtin_amdgcn_readfirstlane(tid >> 6), lane = tid & 63, wr = wid >> 2, wc = wid & 3, fr = lane & 15, fq = lane >> 4;
    const int K = g.K, nt = K / BK, lda = g.lda;
    unsigned voffA[2], voffB[2];
#pragma unroll
    for (int i = 0; i < 2; ++i) { int R, C; stage_rc(tid * 16 + i * 8192, R, C); const int Rb = Epi::PERM ? ((R & ~31) + perm32(R & 31)) : R;
        voffA[i] = (unsigned)(R * lda + C) * 2u; voffB[i] = (unsigned)(Rb * K + C) * 2u; }
    const size_t kstep = (size_t)(BK * 2);
    const size_t hstepA = (size_t)HALF * lda * 2, hstepB = (size_t)HALF * K * 2;
    const size_t tstepA = 2 * hstepA, tstepB = 2 * hstepB;
    const unsigned ldsw = (unsigned)wid * 1024u;
    const int aoff = lds_byte(wr * 64 + fr, fq * 8), boff = lds_byte(wc * 32 + fr, fq * 8);
#define PG8_SA(b, h) (((b) * 2 + (h)) * HTB)
#define PG8_SB(b, h) ((4 + (b) * 2 + (h)) * HTB)
#define PG8_STAGE(bufoff, gbase, voff) do { _Pragma("unroll") for (int _i = 0; _i < 2; ++_i) \
        __builtin_amdgcn_global_load_lds((const unsigned*)((const char*)(gbase) + (voff)[_i]), (LAS unsigned*)(lds + (bufoff) + ldsw + _i * 8192), 16, 0, 0); } while (0)
#define PG8_LDA(dst, b, h) do { _Pragma("unroll") for (int m = 0; m < 4; ++m) _Pragma("unroll") for (int k = 0; k < 2; ++k) dst[m][k] = *(const LAS bf16x8*)(lds + PG8_SA(b, h) + aoff + m * 2048 + k * 1024); } while (0)
#define PG8_LDB(dst, b, h) do { _Pragma("unroll") for (int n = 0; n < 2; ++n) _Pragma("unroll") for (int k = 0; k < 2; ++k) dst[n][k] = *(const LAS bf16x8*)(lds + PG8_SB(b, h) + boff + n * 2048 + k * 1024); } while (0)
#define PG8_MMA(ai, bj, At, Bt) do { __builtin_amdgcn_s_setprio(1); _Pragma("unroll") for (int m = 0; m < 4; ++m) _Pragma("unroll") for (int n = 0; n < 2; ++n) _Pragma("unroll") for (int k = 0; k < 2; ++k) \
        acc[ai][bj][m][n] = __builtin_amdgcn_mfma_f32_16x16x32_bf16(Bt[n][k], At[m][k], acc[ai][bj][m][n], 0, 0, 0); __builtin_amdgcn_s_setprio(0); } while (0)
#define PG8_BAR __builtin_amdgcn_s_barrier()
#define PG8_SCHED __builtin_amdgcn_sched_barrier(0)
    Unit cur, nxt; int ui = 0;
    if (!S.next(0, cur)) return;
    f32x4 acc[2][2][4][2];
#pragma unroll
    for (int a = 0; a < 2; ++a)
#pragma unroll
        for (int b = 0; b < 2; ++b)
#pragma unroll
            for (int m = 0; m < 4; ++m)
#pragma unroll
                for (int n = 0; n < 2; ++n) acc[a][b][m][n] = (f32x4){0.f, 0.f, 0.f, 0.f};
    bf16x8 At[4][2], B0[2][2], B1[2][2];
    const char* cA = (const char*)g.A + (size_t)cur.pm * tstepA; const char* cB = (const char*)g.Bt + (size_t)cur.pn * tstepB;
    PG8_STAGE(PG8_SB(0, 0), cB, voffB); PG8_STAGE(PG8_SB(0, 1), cB + hstepB, voffB); PG8_STAGE(PG8_SA(0, 0), cA, voffA); PG8_STAGE(PG8_SA(0, 1), cA + hstepA, voffA);
    if (wr == 1) PG8_BAR;
    ASM_VMCNT(2); PG8_BAR;
    PG8_STAGE(PG8_SB(1, 0), cB + kstep, voffB); PG8_STAGE(PG8_SA(1, 0), cA + kstep, voffA); PG8_STAGE(PG8_SB(1, 1), cB + hstepB + kstep, voffB);
    ASM_VMCNT(6); PG8_BAR;
    for (;;) {
        const bool has_next = S.next(ui + 1, nxt);
        const char* nA = has_next ? (const char*)g.A + (size_t)nxt.pm * tstepA : cA; const char* nB = has_next ? (const char*)g.Bt + (size_t)nxt.pn * tstepB : cB;
        for (int t = 0; t < nt; t += 2) {
            const bool last = (t == nt - 2);
            const char* a1 = cA + (size_t)(t + 1) * kstep;
            const char* a2 = last ? nA : cA + (size_t)(t + 2) * kstep; const char* b2 = last ? nB : cB + (size_t)(t + 2) * kstep;
            const char* a3 = a2 + kstep; const char* b3 = b2 + kstep;
            PG8_LDB(B0, 0, 0); PG8_LDB(B1, 0, 1); PG8_SCHED; PG8_LDA(At, 0, 0); PG8_STAGE(PG8_SA(1, 1), a1 + hstepA, voffA);
            ASM_VMCNT(8); ASM_LGKMCNT(0); PG8_BAR; PG8_MMA(0, 0, At, B0); PG8_MMA(0, 1, At, B1); PG8_BAR; PG8_SCHED;
            PG8_LDA(At, 0, 1); PG8_STAGE(PG8_SB(0, 0), b2, voffB); PG8_STAGE(PG8_SB(0, 1), b2 + hstepB, voffB); PG8_STAGE(PG8_SA(0, 0), a2, voffA);
            ASM_VMCNT(8); ASM_LGKMCNT(0); PG8_BAR; PG8_MMA(1, 0, At, B0); PG8_MMA(1, 1, At, B1); PG8_BAR; PG8_SCHED;
            PG8_LDB(B0, 1, 0); PG8_LDB(B1, 1, 1); PG8_SCHED; PG8_LDA(At, 1, 0); PG8_STAGE(PG8_SA(0, 1), a2 + hstepA, voffA);
            ASM_VMCNT(8); ASM_LGKMCNT(0); PG8_BAR; PG8_MMA(0, 0, At, B0); PG8_MMA(0, 1, At, B1); PG8_BAR; PG8_SCHED;
            PG8_LDA(At, 1, 1); PG8_STAGE(PG8_SB(1, 0), b3, voffB); PG8_STAGE(PG8_SB(1, 1), b3 + hstepB, voffB); PG8_STAGE(PG8_SA(1, 0), a3, voffA);
            ASM_VMCNT(8); ASM_LGKMCNT(0); PG8_BAR; PG8_MMA(1, 0, At, B0); PG8_MMA(1, 1, At, B1); PG8_BAR; PG8_SCHED;
        }
        if (wr == 0) PG8_BAR;
        E(acc, cur, wr, wc, fr, fq);
        if (!has_next) break;
#pragma unroll
        for (int a = 0; a < 2; ++a)
#pragma unroll
            for (int b = 0; b < 2; ++b)
#pragma unroll
                for (int m = 0; m < 4; ++m)
#pragma unroll
                    for (int n = 0; n < 2; ++n) acc[a][b][m][n] = (f32x4){0.f, 0.f, 0.f, 0.f};
        cur = nxt; cA = nA; cB = nB; ++ui;
        if (wr == 1) PG8_BAR;
    }
    ASM_VMCNT(0);
    PG8_BAR;
#undef PG8_SA
#undef PG8_SB
#undef PG8_STAGE
#undef PG8_LDA
#undef PG8_LDB
#undef PG8_MMA
#undef PG8_BAR
#undef PG8_SCHED
}
}

struct EpiStoreBf16 {
    static constexpr bool PERM = true;
    bf16_t* O; int ldc;
    __device__ __forceinline__ void operator()(const f32x4 (&acc)[2][2][4][2], const pg8::Unit& u, int wr, int wc, int fr, int fq) const {
        const int row0 = u.pm * 256 + wr * 64 + fr, col0 = u.pn * 256 + wc * 32 + 8 * fq;
#pragma unroll
        for (int ai = 0; ai < 2; ++ai)
#pragma unroll
            for (int m = 0; m < 4; ++m) { bf16_t* rowp = O + (size_t)(row0 + ai * 128 + m * 16) * ldc + col0;
#pragma unroll
                for (int bj = 0; bj < 2; ++bj) { const f32x4 v0 = acc[ai][bj][m][0], v1 = acc[ai][bj][m][1];
                    u32x4 w; w.x = pk2(v0[0], v0[1]); w.y = pk2(v0[2], v0[3]); w.z = pk2(v1[0], v1[1]); w.w = pk2(v1[2], v1[3]);
                    *(u32x4*)(rowp + bj * 128) = w; } }
    }
};
struct EpiSwiGLU {
    static constexpr bool PERM = true;
    bf16_t* O; int ldc;
    __device__ __forceinline__ void operator()(const f32x4 (&acc)[2][2][4][2], const pg8::Unit& u, int wr, int wc, int fr, int fq) const {
        const int row0 = u.pm * 256 + wr * 64 + fr, col0 = u.pn * 128 + wc * 32 + 8 * fq;
#pragma unroll
        for (int ai = 0; ai < 2; ++ai)
#pragma unroll
            for (int m = 0; m < 4; ++m) { bf16_t* rowp = O + (size_t)(row0 + ai * 128 + m * 16) * ldc + col0;
                float r[8];
#pragma unroll
                for (int n = 0; n < 2; ++n)
#pragma unroll
                    for (int i = 0; i < 4; ++i) r[n * 4 + i] = siluf_(acc[ai][0][m][n][i]) * acc[ai][1][m][n][i];
                u32x4 w; w.x = pk2(r[0], r[1]); w.y = pk2(r[2], r[3]); w.z = pk2(r[4], r[5]); w.w = pk2(r[6], r[7]);
                *(u32x4*)rowp = w; }
    }
};
struct EpiResid {
    static constexpr bool PERM = false;
    const float* xin_lat; const float* xin_ctx; float* xout_lat; float* xout_ctx; const float* gate;
    __device__ __forceinline__ void operator()(const f32x4 (&acc)[2][2][4][2], const pg8::Unit& u, int wr, int wc, int fr, int fq) const {
        const int rbase = u.pm * 256;
        const bool isctx = rbase >= ML;
        const float* xin = isctx ? xin_ctx - (size_t)ML * D : xin_lat; float* xout = isctx ? xout_ctx - (size_t)ML * D : xout_lat;
        const float* gp = gate + (size_t)(isctx ? NB : rbase / SEQ) * NMOD;
        const int col0 = u.pn * 256 + wc * 32 + 4 * fq;
        f32x4 gv[2][2];
#pragma unroll
        for (int bj = 0; bj < 2; ++bj)
#pragma unroll
            for (int n = 0; n < 2; ++n) gv[bj][n] = *(const f32x4*)(gp + col0 + bj * 128 + n * 16);
#pragma unroll
        for (int ai = 0; ai < 2; ++ai)
#pragma unroll
            for (int m = 0; m < 4; ++m) { const size_t off = (size_t)(rbase + ai * 128 + wr * 64 + m * 16 + fr) * D + col0;
#pragma unroll
                for (int bj = 0; bj < 2; ++bj)
#pragma unroll
                    for (int n = 0; n < 2; ++n) { const f32x4 xi = *(const f32x4*)(xin + off + bj * 128 + n * 16);
                        *(f32x4*)(xout + off + bj * 128 + n * 16) = xi + gv[bj][n] * acc[ai][bj][m][n]; } }
    }
};

struct Ctx {
    LAS unsigned char* lds; int tid, lane, wave, bid, G;
};
__device__ __forceinline__ void cvt_item(const float* W, int ldw, int K, int c0, bf16_t* WT, int r0, LAS float* scr, int item, int nblk, int lane) {
    const int kb = item / nblk, nb = item % nblk, k0 = 64 * kb, n0 = 32 * nb;
#pragma unroll 8
    for (int i = 0; i < 32; ++i) { const int kk = 2 * i + (lane >> 5); scr[kk * 33 + (lane & 31)] = W[(size_t)(k0 + kk) * ldw + c0 + n0 + (lane & 31)]; }
    WAVE_LDS_SYNC();
    const int c = lane & 7;
#pragma unroll
    for (int j = 0; j < 4; ++j) { const int n = (lane >> 3) + 8 * j; const LAS float* s = scr + (8 * c) * 33 + n;
        u32x4 o; o.x = pk2(s[0 * 33], s[1 * 33]); o.y = pk2(s[2 * 33], s[3 * 33]); o.z = pk2(s[4 * 33], s[5 * 33]); o.w = pk2(s[6 * 33], s[7 * 33]);
        *(u32x4*)(WT + (size_t)(r0 + n0 + n) * K + k0 + 8 * c) = o; }
    WAVE_LDS_SYNC();
}
__device__ __forceinline__ void cvt_seg(const Ctx& c, const float* W, int ldw, int K, int c0, int ncols, bf16_t* WT, int r0, int& base) {
    LAS float* scr = (LAS float*)(c.lds + c.wave * 16384);
    const int nblk = ncols / 32, nitems = (K / 64) * nblk, NGW = c.G * NWAVES, gw = c.bid * NWAVES + c.wave;
    int first = (gw - base) % NGW; if (first < 0) first += NGW;
    for (int it = first; it < nitems; it += NGW) cvt_item(W, ldw, K, c0, WT, r0, scr, it, nblk, c.lane);
    base = (base + nitems) % NGW;
}

__device__ __forceinline__ void phase_hnorm(const Ctx& c, const float* xlat, const float* xctx, const float* w, const float* mod, int shift_blk, int scale_blk, bf16_t* H, int row_lo, int row_hi) {
    const int gw = c.bid * NWAVES + c.wave, NGW = c.G * NWAVES;
    f32x4 wv[4];
#pragma unroll
    for (int j = 0; j < 4; ++j) wv[j] = *(const f32x4*)(w + 4 * c.lane + 256 * j);
    for (int row = row_lo + gw; row < row_hi; row += NGW) {
        const bool isctx = row >= ML;
        const float* xr = isctx ? xctx + (size_t)(row - ML) * D : xlat + (size_t)row * D;
        const float* mp = mod + (size_t)(isctx ? NB : row / SEQ) * NMOD;
        f32x4 v[4]; float s = 0.f;
#pragma unroll
        for (int j = 0; j < 4; ++j) { v[j] = *(const f32x4*)(xr + 4 * c.lane + 256 * j); s += (v[j].x * v[j].x + v[j].y * v[j].y) + (v[j].z * v[j].z + v[j].w * v[j].w); }
        const float rs = 1.0f / sqrtf(wave_sum(s) * (1.0f / D) + EPS);
#pragma unroll
        for (int j = 0; j < 4; ++j) {
            const f32x4 sh = *(const f32x4*)(mp + shift_blk * D + 4 * c.lane + 256 * j), sc = *(const f32x4*)(mp + scale_blk * D + 4 * c.lane + 256 * j);
            const f32x4 o = v[j] * rs * wv[j] * (1.0f + sc) + sh;
            u32x2 pw; pw.x = pk2(o.x, o.y); pw.y = pk2(o.z, o.w);
            *(u32x2*)(H + (size_t)row * D + 4 * c.lane + 256 * j) = pw;
        }
    }
}

__device__ __forceinline__ void phase_mods(const Ctx& c, const Params& P) {
    float* mod = (float*)(P.ws + WS_MOD);
    const float* cv = P.in[I_C]; const float* cc = P.in[I_CCTX]; const float* wm = P.in[I_WMOD]; const float* bm = P.in[I_BMOD];
    LAS float* sc = (LAS float*)c.lds;
    LAS float* pt = sc + (NB + 1) * D;
    for (int i = c.tid; i < (NB + 1) * D; i += NTHREADS) { const int r = i / D, k = i % D; sc[i] = siluf_(r < NB ? cv[r * D + k] : cc[k]); }
    __syncthreads();
    constexpr int NU = 2 * (NMOD / 64);
    for (int u = c.bid; u < NU; u += c.G) {
        const int l = u / (NMOD / 64), n = (u % (NMOD / 64)) * 64 + c.lane, k0 = c.wave * 128;
        float acc[NB + 1];
#pragma unroll
        for (int i = 0; i <= NB; ++i) acc[i] = 0.f;
#pragma unroll 4
        for (int k = 0; k < 128; ++k) { const float wv = wm[((size_t)l * D + k0 + k) * NMOD + n];
#pragma unroll
            for (int i = 0; i <= NB; ++i) acc[i] += sc[i * D + k0 + k] * wv; }
#pragma unroll
        for (int i = 0; i <= NB; ++i) pt[(c.wave * (NB + 1) + i) * 64 + c.lane] = acc[i];
        __syncthreads();
        if (c.tid < (NB + 1) * 64) { const int r = c.tid >> 6, nn = c.tid & 63; float s = bm[(size_t)l * NMOD + (u % (NMOD / 64)) * 64 + nn];
#pragma unroll
            for (int w = 0; w < 8; ++w) s += pt[(w * (NB + 1) + r) * 64 + nn];
            mod[((size_t)l * (NB + 1) + r) * NMOD + (u % (NMOD / 64)) * 64 + nn] = s; }
        __syncthreads();
    }
}

namespace sc0 {
constexpr int LQ = 136, LT = 72;
constexpr int O_Q = 0;
constexpr int O_K = O_Q + 64 * LQ * 2;
constexpr int O_KT = O_K + 64 * LQ * 2;
constexpr int O_VT = O_KT + 128 * LT * 2;
constexpr int O_S = O_VT + 64 * LT * 2;
constexpr int O_ST = O_S + 64 * LT * 2;
constexpr int O_LA = O_ST + 64 * LQ * 2;
constexpr int O_PART = O_LA + 64 * 128 * 4;
constexpr int O_R = O_PART + 4 * 128 * 4;
constexpr int O_WG = O_R + 64 * 40 * 2;
constexpr int O_VEC = O_WG + 128 * 40 * 2;
constexpr int O_CW = O_LA;
constexpr int O_END = O_VEC + 320 * 4;
static_assert(O_END <= 140 * 1024, "scan0 LDS");

__device__ __forceinline__ bf16x8 frag(const LAS unsigned char* lds, int off, int ld, int row, int k) { return *(const LAS bf16x8*)(lds + off + (row * ld + k) * 2); }

template <bool SSD>
__device__ __forceinline__ void chain(const Ctx& c, const Params& P, int dir, int b, int h, int vb, bf16_t* T_lat, bf16_t* T_ctx) {
    LAS unsigned char* lds = c.lds;
    const int tid = c.tid, lane = c.lane, w = c.wave, fr = lane & 15, fq = lane >> 4;
    const bf16_t* P0 = (const bf16_t*)(P.ws + WS_BIG);
    LAS float* vec = (LAS float*)(lds + O_VEC);
    const int ti_ = tid >> 3, seg = tid & 7;
    const int qcol = SSD ? C_C + (h >> 3) * 128 : C_Q + h * 128, kcol = SSD ? C_B + (h >> 3) * 128 : C_K + h * 128, vcol = SSD ? C_XS + h * 64 : C_V + h * 256 + vb * 64;
    const int tcol = SSD ? 1024 + h * 64 : h * 256 + vb * 64;
    float alog = 0.f, dtb = 0.f;
    if (SSD) {
        alog = __expf(P.in[I_AALOG][dir * 16 + h]); dtb = P.in[I_ADTB][dir * 16 + h];
        LAS float* cw = (LAS float*)(lds + O_CW);
        for (int i = tid; i < 4 * 320; i += NTHREADS) { const int tap = i / 320, cc = i % 320; const int gc_ = cc < 128 ? 1280 + (h >> 3) * 128 + cc : (cc < 256 ? 1024 + (h >> 3) * 128 + (cc - 128) : h * 64 + (cc - 256));
            cw[i] = tap < 3 ? P.in[I_ACW][tap * 1536 + gc_] : P.in[I_ACB][gc_]; }
    } else {
        const float* wg = P.in[I_AGW] + (size_t)dir * 16 * 512 + h * 128;
        LAS bf16_t* wgt = (LAS bf16_t*)(lds + O_WG);
        for (int i = tid; i < 128 * 32; i += NTHREADS) { const int kk = i >> 5, r = i & 31; wgt[kk * 40 + r] = r < 16 ? (bf16_t)f2bf(wg[r * 512 + kk]) : (bf16_t)0; }
        if (tid < 128) vec[tid] = P.in[I_AGB][dir * 512 + h * 128 + tid];
        LAS bf16_t* rl = (LAS bf16_t*)(lds + O_R);
        for (int i = tid; i < 64 * 16; i += NTHREADS) rl[(i >> 4) * 40 + 16 + (i & 15)] = 0;
    }
    f32x4 st[4];
#pragma unroll
    for (int t = 0; t < 4; ++t) st[t] = (f32x4){0.f, 0.f, 0.f, 0.f};
    for (int i = tid; i < 64 * LQ / 2; i += NTHREADS) ((LAS unsigned*)(lds + O_ST))[i] = 0u;
    __syncthreads();

    for (int sgi = 0; sgi < 2; ++sgi) {
        const int isctx = (sgi == 0);
        const int L = isctx ? CTX : SEQ, nch = L / 64;
        const size_t rbase = isctx ? (size_t)ML + (size_t)b * CTX : (size_t)b * SEQ;
        bf16_t* T = isctx ? T_ctx + (size_t)b * CTX * 2048 : T_lat + (size_t)b * SEQ * 2048;
        for (int ci = 0; ci < nch; ++ci) {
            int zoff = 0; OPAQUE_V(zoff);
            LAS unsigned char* lds = c.lds + zoff; LAS float* vec = (LAS float*)(lds + O_VEC); LAS float* la = (LAS float*)(lds + O_LA);
            const int ch = dir ? nch - 1 - ci : ci;
            const int tok = ch * 64 + (dir ? 63 - ti_ : ti_);
            const bf16_t* prow = P0 + (rbase + tok) * NP0;
            if (!SSD) {
                if (seg < 2) { const u32x4 rv = *(const u32x4*)(prow + C_R + dir * 16 + seg * 8); *(LAS u32x4*)(lds + O_R + (ti_ * 40 + seg * 8) * 2) = rv; }
                __syncthreads();
                { const int ti = w >> 1; const bf16x8 a = frag(lds, O_R, 40, ti * 16 + fr, 8 * fq);
#pragma unroll
                  for (int q = 0; q < 4; ++q) { const int tk = 4 * (w & 1) + q; const bf16x8 bb = frag(lds, O_WG, 40, tk * 16 + fr, 8 * fq);
                      f32x4 acc = (f32x4){0.f, 0.f, 0.f, 0.f}; acc = __builtin_amdgcn_mfma_f32_16x16x32_bf16(a, bb, acc, 0, 0, 0);
                      const float bg = vec[tk * 16 + fr];
#pragma unroll
                      for (int r = 0; r < 4; ++r) la[(ti * 16 + 4 * fq + r) * 128 + tk * 16 + fr] = log_sigmoidf_(acc[r] + bg) * (1.0f / 16.0f); } }
                __syncthreads();
                { const int kk = tid & 127, qd = tid >> 7; float run = 0.f;
#pragma unroll
                  for (int r = 0; r < 16; ++r) { run += la[(qd * 16 + r) * 128 + kk]; la[(qd * 16 + r) * 128 + kk] = run; }
                  ((LAS float*)(lds + O_PART))[qd * 128 + kk] = run; }
                __syncthreads();
                { const int kk = tid & 127, qd = tid >> 7; float offv = 0.f; const LAS float* part = (const LAS float*)(lds + O_PART);
                  for (int q = 0; q < qd; ++q) offv += part[q * 128 + kk];
                  if (qd > 0) {
#pragma unroll
                      for (int r = 0; r < 16; ++r) la[(qd * 16 + r) * 128 + kk] += offv; } }
                __syncthreads();
                { const u32x4 q0 = *(const u32x4*)(prow + qcol + seg * 16), q1 = *(const u32x4*)(prow + qcol + seg * 16 + 8);
                  const u32x4 k0 = *(const u32x4*)(prow + kcol + seg * 16), k1 = *(const u32x4*)(prow + kcol + seg * 16 + 8);
                  const u32x4 vv = *(const u32x4*)(prow + vcol + seg * 8);
                  const unsigned qw[8] = {q0.x, q0.y, q0.z, q0.w, q1.x, q1.y, q1.z, q1.w}, kw[8] = {k0.x, k0.y, k0.z, k0.w, k1.x, k1.y, k1.z, k1.w};
                  unsigned qo[8], ko[8];
                  LAS bf16_t* kt = (LAS bf16_t*)(lds + O_KT);
#pragma unroll
                  for (int e = 0; e < 8; ++e) { const float g0 = la[ti_ * 128 + seg * 16 + 2 * e], g1 = la[ti_ * 128 + seg * 16 + 2 * e + 1];
                      const float e0 = __expf(g0), e1 = __expf(g1);
                      qo[e] = pk2(bflo(qw[e]) * e0 * 0.08838834764831845f, bfhi(qw[e]) * e1 * 0.08838834764831845f);
                      const float ka = bflo(kw[e]) / e0, kb = bfhi(kw[e]) / e1; ko[e] = pk2(ka, kb);
                      kt[(seg * 16 + 2 * e) * LT + ti_] = (bf16_t)(ko[e] & 0xffffu); kt[(seg * 16 + 2 * e + 1) * LT + ti_] = (bf16_t)(ko[e] >> 16); }
                  *(LAS u32x4*)(lds + O_Q + (ti_ * LQ + seg * 16) * 2) = (u32x4){qo[0], qo[1], qo[2], qo[3]}; *(LAS u32x4*)(lds + O_Q + (ti_ * LQ + seg * 16 + 8) * 2) = (u32x4){qo[4], qo[5], qo[6], qo[7]};
                  *(LAS u32x4*)(lds + O_K + (ti_ * LQ + seg * 16) * 2) = (u32x4){ko[0], ko[1], ko[2], ko[3]}; *(LAS u32x4*)(lds + O_K + (ti_ * LQ + seg * 16 + 8) * 2) = (u32x4){ko[4], ko[5], ko[6], ko[7]};
                  LAS bf16_t* vt = (LAS bf16_t*)(lds + O_VT); const unsigned vw[4] = {vv.x, vv.y, vv.z, vv.w};
#pragma unroll
                  for (int e = 0; e < 4; ++e) { vt[(seg * 8 + 2 * e) * LT + ti_] = (bf16_t)(vw[e] & 0xffffu); vt[(seg * 8 + 2 * e + 1) * LT + ti_] = (bf16_t)(vw[e] >> 16); }
                }
                __syncthreads();
            } else {
                const LAS float* cw = (const LAS float*)(lds + O_CW);
                const int tm = tok - 1, tp = tok + 1;
                const bf16_t* prm = P0 + (rbase + (tm >= 0 ? tm : 0)) * NP0; const bf16_t* prp = P0 + (rbase + (tp < L ? tp : L - 1)) * NP0;
                const float mm = tm >= 0 ? 1.f : 0.f, mp = tp < L ? 1.f : 0.f;
#pragma unroll
                for (int part = 0; part < 5; ++part) {
                    const int gcol = part < 2 ? qcol + seg * 16 + part * 8 : (part < 4 ? kcol + seg * 16 + (part - 2) * 8 : vcol + seg * 8);
                    const int lc = part < 2 ? seg * 16 + part * 8 : (part < 4 ? 128 + seg * 16 + (part - 2) * 8 : 256 + seg * 8);
                    const u32x4 a0 = *(const u32x4*)(prm + gcol), a1 = *(const u32x4*)(prow + gcol), a2 = *(const u32x4*)(prp + gcol);
                    const unsigned w0[4] = {a0.x, a0.y, a0.z, a0.w}, w1[4] = {a1.x, a1.y, a1.z, a1.w}, w2[4] = {a2.x, a2.y, a2.z, a2.w};
                    float y[8];
#pragma unroll
                    for (int e = 0; e < 8; ++e) { const int col = lc + e;
                        const float xm = (e & 1) ? bfhi(w0[e >> 1]) : bflo(w0[e >> 1]), x0 = (e & 1) ? bfhi(w1[e >> 1]) : bflo(w1[e >> 1]), xp = (e & 1) ? bfhi(w2[e >> 1]) : bflo(w2[e >> 1]);
                        y[e] = siluf_(cw[col] * xm * mm + cw[320 + col] * x0 + cw[640 + col] * xp * mp + cw[960 + col]); }
                    if (part < 4) { const u32x4 pw = (u32x4){pk2(y[0], y[1]), pk2(y[2], y[3]), pk2(y[4], y[5]), pk2(y[6], y[7])};
                        *(LAS u32x4*)(lds + (part < 2 ? O_Q : O_K) + (ti_ * LQ + seg * 16 + (part & 1) * 8) * 2) = pw; }
                    else { LAS bf16_t* vt = (LAS bf16_t*)(lds + O_VT);
#pragma unroll
                        for (int e = 0; e < 8; ++e) vt[(seg * 8 + e) * LT + ti_] = (bf16_t)f2bf(y[e]); }
                    ASM_FENCE();
                }
                if (seg == 0) { const float dtr = bf2f(prow[C_DT + dir * 16 + h]); const float dtv = softplusf_(dtr + dtb); vec[192 + ti_] = dtv; vec[128 + ti_] = -dtv * alog; }
                __syncthreads();
                if (w == 0) { float v = vec[128 + lane];
#pragma unroll
                    for (int o = 1; o < 64; o <<= 1) { const float u = __shfl(v, lane >= o ? lane - o : lane); if (lane >= o) v += u; }
                    vec[128 + lane] = v; vec[256 + lane] = __expf(v); }
                __syncthreads();
                { const float gci = vec[128 + ti_], gcl = vec[128 + 63], dti = vec[192 + ti_]; const float kf = dti * __expf(gcl - gci);
                  const u32x4 b0 = *(const LAS u32x4*)(lds + O_K + (ti_ * LQ + seg * 16) * 2), b1 = *(const LAS u32x4*)(lds + O_K + (ti_ * LQ + seg * 16 + 8) * 2);
                  const unsigned bw[8] = {b0.x, b0.y, b0.z, b0.w, b1.x, b1.y, b1.z, b1.w}; LAS bf16_t* kt = (LAS bf16_t*)(lds + O_KT);
#pragma unroll
                  for (int e = 0; e < 8; ++e) { kt[(seg * 16 + 2 * e) * LT + ti_] = (bf16_t)f2bf(bflo(bw[e]) * kf); kt[(seg * 16 + 2 * e + 1) * LT + ti_] = (bf16_t)f2bf(bfhi(bw[e]) * kf); } }
                __syncthreads();
            }
            { const int ti = w >> 1; bf16x8 a[4];
#pragma unroll
              for (int kq = 0; kq < 4; ++kq) a[kq] = frag(lds, O_Q, LQ, ti * 16 + fr, kq * 32 + 8 * fq);
#pragma unroll
              for (int q = 0; q < 2; ++q) { const int tj = 2 * (w & 1) + q; f32x4 acc = (f32x4){0.f, 0.f, 0.f, 0.f};
                  if (tj <= ti) {
#pragma unroll
                      for (int kq = 0; kq < 4; ++kq) acc = __builtin_amdgcn_mfma_f32_16x16x32_bf16(a[kq], frag(lds, O_K, LQ, tj * 16 + fr, kq * 32 + 8 * fq), acc, 0, 0, 0); }
                  const int j = tj * 16 + fr; LAS bf16_t* sl = (LAS bf16_t*)(lds + O_S);
#pragma unroll
                  for (int r = 0; r < 4; ++r) { const int i = ti * 16 + 4 * fq + r; float s = (j <= i) ? acc[r] : 0.f;
                      if (SSD) s *= vec[192 + j] * __expf(fminf(vec[128 + i] - vec[128 + j], 0.f));
                      sl[i * LT + j] = (bf16_t)f2bf(s); } } }
            __syncthreads();
            { const int ti = w >> 1; bf16x8 a[4], sa[2];
#pragma unroll
              for (int kq = 0; kq < 4; ++kq) a[kq] = frag(lds, O_Q, LQ, ti * 16 + fr, kq * 32 + 8 * fq);
#pragma unroll
              for (int kq = 0; kq < 2; ++kq) sa[kq] = frag(lds, O_S, LT, ti * 16 + fr, kq * 32 + 8 * fq);
#pragma unroll
              for (int q = 0; q < 2; ++q) { const int tv = 2 * (w & 1) + q; f32x4 a1 = (f32x4){0.f, 0.f, 0.f, 0.f}, a2 = (f32x4){0.f, 0.f, 0.f, 0.f};
#pragma unroll
                  for (int kq = 0; kq < 2; ++kq) a1 = __builtin_amdgcn_mfma_f32_16x16x32_bf16(sa[kq], frag(lds, O_VT, LT, tv * 16 + fr, kq * 32 + 8 * fq), a1, 0, 0, 0);
#pragma unroll
                  for (int kq = 0; kq < 4; ++kq) a2 = __builtin_amdgcn_mfma_f32_16x16x32_bf16(a[kq], frag(lds, O_ST, LQ, tv * 16 + fr, kq * 32 + 8 * fq), a2, 0, 0, 0);
#pragma unroll
                  for (int r = 0; r < 4; ++r) { const int i = ti * 16 + 4 * fq + r; const float rf = SSD ? vec[256 + i] : 1.f; float o = a1[r] + rf * a2[r];
                      const int tk = ch * 64 + (dir ? 63 - i : i); bf16_t* tp = T + (size_t)tk * 2048 + tcol + tv * 16 + fr;
                      if (dir) o += bf2f(*tp);
                      *tp = (bf16_t)f2bf(o); } } }
            { bf16x8 ka[2];
#pragma unroll
              for (int kq = 0; kq < 2; ++kq) ka[kq] = frag(lds, O_KT, LT, w * 16 + fr, kq * 32 + 8 * fq);
              float fk[4], fu[4];
#pragma unroll
              for (int r = 0; r < 4; ++r) { if (SSD) { fk[r] = vec[256 + 63]; fu[r] = 1.f; } else { fk[r] = __expf(la[63 * 128 + w * 16 + 4 * fq + r]); fu[r] = fk[r]; } }
              __syncthreads();
#pragma unroll
              for (int t = 0; t < 4; ++t) { f32x4 u = (f32x4){0.f, 0.f, 0.f, 0.f};
#pragma unroll
                  for (int kq = 0; kq < 2; ++kq) u = __builtin_amdgcn_mfma_f32_16x16x32_bf16(ka[kq], frag(lds, O_VT, LT, t * 16 + fr, kq * 32 + 8 * fq), u, 0, 0, 0);
#pragma unroll
                  for (int r = 0; r < 4; ++r) st[t][r] = fk[r] * st[t][r] + fu[r] * u[r];
                  u32x2 pw; pw.x = pk2(st[t][0], st[t][1]); pw.y = pk2(st[t][2], st[t][3]);
                  *(LAS u32x2*)(lds + O_ST + ((t * 16 + fr) * LQ + w * 16 + 4 * fq) * 2) = pw; } }
            __syncthreads();
        }
    }
}
}

__device__ __forceinline__ void phase_scan0(const Ctx& c, const Params& P, int dir) {
    bf16_t* T_lat = (bf16_t*)P.out; bf16_t* T_ctx = (bf16_t*)(P.ws + WS_H);
    const int nitems = NB * 32;
    for (int it = c.bid; it < nitems; it += c.G) {
        const int b = it / 32, r = it % 32;
        if (r < 16) sc0::chain<false>(c, P, dir, b, r >> 2, r & 3, T_lat, T_ctx);
        else sc0::chain<true>(c, P, dir, b, r - 16, 0, T_lat, T_ctx);
        __syncthreads();
    }
}

__device__ __forceinline__ void phase_post0(const Ctx& c, const Params& P) {
    bf16_t* P0 = (bf16_t*)(P.ws + WS_BIG);
    const bf16_t* T_lat = (const bf16_t*)P.out; const bf16_t* T_ctx = (const bf16_t*)(P.ws + WS_H);
    const int gw = c.bid * NWAVES + c.wave, NGW = c.G * NWAVES, lane = c.lane;
    const float* gn = P.in[I_AGN]; const float* sn = P.in[I_ASN]; const float* cwt = P.in[I_ACW]; const float* cb = P.in[I_ACB];
    const float dsk = P.in[I_AD][lane >> 2];
    for (int row = gw; row < MT; row += NGW) {
        const bool isctx = row >= ML;
        const bf16_t* T = isctx ? T_ctx + (size_t)(row - ML) * 2048 : T_lat + (size_t)row * 2048;
        bf16_t* pr = P0 + (size_t)row * NP0;
        const int L = isctx ? CTX : SEQ, pos = isctx ? (row - ML) % CTX : row % SEQ;
        {   const u32x4 t0 = *(const u32x4*)(T + 16 * lane), t1 = *(const u32x4*)(T + 16 * lane + 8);
            const u32x4 g0 = *(const u32x4*)(pr + C_G + 16 * lane), g1 = *(const u32x4*)(pr + C_G + 16 * lane + 8);
            const unsigned tw[8] = {t0.x, t0.y, t0.z, t0.w, t1.x, t1.y, t1.z, t1.w}, gq[8] = {g0.x, g0.y, g0.z, g0.w, g1.x, g1.y, g1.z, g1.w};
            float tv[16], ss = 0.f;
#pragma unroll
            for (int e = 0; e < 8; ++e) { tv[2 * e] = bflo(tw[e]); tv[2 * e + 1] = bfhi(tw[e]); ss += tv[2 * e] * tv[2 * e] + tv[2 * e + 1] * tv[2 * e + 1]; }
            ss += __shfl_xor(ss, 1); ss += __shfl_xor(ss, 2); ss += __shfl_xor(ss, 4); ss += __shfl_xor(ss, 8);
            const float rs = 1.0f / sqrtf(ss * (1.0f / 256.0f) + EPS);
            unsigned o[8];
#pragma unroll
            for (int e = 0; e < 8; ++e) { const int cc = (16 * lane + 2 * e) & 255;
                o[e] = pk2(tv[2 * e] * rs * gn[cc] * siluf_(bflo(gq[e])), tv[2 * e + 1] * rs * gn[cc + 1] * siluf_(bfhi(gq[e]))); }
            *(u32x4*)(pr + C_G + 16 * lane) = (u32x4){o[0], o[1], o[2], o[3]}; *(u32x4*)(pr + C_G + 16 * lane + 8) = (u32x4){o[4], o[5], o[6], o[7]}; }
        {   const u32x4 t0 = *(const u32x4*)(T + 1024 + 16 * lane), t1 = *(const u32x4*)(T + 1024 + 16 * lane + 8);
            const u32x4 z0 = *(const u32x4*)(pr + C_Z + 16 * lane), z1 = *(const u32x4*)(pr + C_Z + 16 * lane + 8);
            const bool hm = pos > 0, hp = pos + 1 < L;
            const bf16_t* prm = hm ? pr - NP0 : pr; const bf16_t* prp = hp ? pr + NP0 : pr;
            const u32x4 a0 = *(const u32x4*)(prm + C_XS + 16 * lane), a1 = *(const u32x4*)(prm + C_XS + 16 * lane + 8);
            const u32x4 b0 = *(const u32x4*)(pr + C_XS + 16 * lane), b1 = *(const u32x4*)(pr + C_XS + 16 * lane + 8);
            const u32x4 c0 = *(const u32x4*)(prp + C_XS + 16 * lane), c1 = *(const u32x4*)(prp + C_XS + 16 * lane + 8);
            const unsigned tw[8] = {t0.x, t0.y, t0.z, t0.w, t1.x, t1.y, t1.z, t1.w}, zq[8] = {z0.x, z0.y, z0.z, z0.w, z1.x, z1.y, z1.z, z1.w};
            const unsigned am[8] = {a0.x, a0.y, a0.z, a0.w, a1.x, a1.y, a1.z, a1.w}, a_[8] = {b0.x, b0.y, b0.z, b0.w, b1.x, b1.y, b1.z, b1.w}, ap[8] = {c0.x, c0.y, c0.z, c0.w, c1.x, c1.y, c1.z, c1.w};
            const float mm = hm ? 1.f : 0.f, mp = hp ? 1.f : 0.f;
            float y[16], ss = 0.f;
#pragma unroll
            for (int e = 0; e < 16; ++e) { const int cc = 16 * lane + e; const int wi = e >> 1; const bool hi = e & 1;
                const float xm = hi ? bfhi(am[wi]) : bflo(am[wi]), x0 = hi ? bfhi(a_[wi]) : bflo(a_[wi]), xp = hi ? bfhi(ap[wi]) : bflo(ap[wi]);
                const float xs = siluf_(cwt[cc] * xm * mm + cwt[1536 + cc] * x0 + cwt[3072 + cc] * xp * mp + cb[cc]);
                const float tvv = hi ? bfhi(tw[wi]) : bflo(tw[wi]), zv = hi ? bfhi(zq[wi]) : bflo(zq[wi]);
                y[e] = (tvv + xs * dsk) * siluf_(zv); ss += y[e] * y[e]; }
            ss += __shfl_xor(ss, 1); ss += __shfl_xor(ss, 2); ss += __shfl_xor(ss, 4); ss += __shfl_xor(ss, 8); ss += __shfl_xor(ss, 16);
            const float rs = 1.0f / sqrtf(ss * (1.0f / 512.0f) + EPS);
            unsigned o[8];
#pragma unroll
            for (int e = 0; e < 8; ++e) o[e] = pk2(y[2 * e] * rs * sn[16 * lane + 2 * e], y[2 * e + 1] * rs * sn[16 * lane + 2 * e + 1]);
            *(u32x4*)(pr + C_Z + 16 * lane) = (u32x4){o[0], o[1], o[2], o[3]}; *(u32x4*)(pr + C_Z + 16 * lane + 8) = (u32x4){o[4], o[5], o[6], o[7]}; }
    }
}

__device__ __forceinline__ int row_of(int isctx, int b, int p) { return isctx ? ML + b * CTX + p : b * SEQ + (p % GROWS) * GW + p / GROWS; }

__device__ __forceinline__ void build_gate_weights(const Ctx& c, const Params& P, bf16_t* WG) {
    const float* wq = P.in[I_BWQ]; const float* wk = P.in[I_BWK]; const float* wv = P.in[I_BWV]; const float* wif = P.in[I_BWIF];
    for (int idx = c.bid * NTHREADS + c.tid; idx < 256 * 4096; idx += c.G * NTHREADS) {
        const int g = idx >> 12, cc = idx & 4095; float v = 0.f;
        if (g < 16) { const int dir = g >> 3, gi = g & 7; const float* wd = wif + (size_t)dir * 6144 * 8;
            if (cc < 2048) { const int n = cc >> 2, dp = cc & 3;
#pragma unroll
                for (int e = 0; e < 4; ++e) v += wv[n * 16 + dp * 4 + e] * wd[(size_t)(4096 + 4 * n + e) * 8 + gi]; }
            else { const int c2 = cc - 2048, n = c2 >> 2, dp = c2 & 3;
#pragma unroll
                for (int e = 0; e < 4; ++e) v += wq[n * 16 + dp * 4 + e] * wd[(size_t)(4 * n + e) * 8 + gi] + wk[n * 16 + dp * 4 + e] * wd[(size_t)(2048 + 4 * n + e) * 8 + gi]; } }
        WG[idx] = (bf16_t)f2bf(v);
    }
}
struct EpiGates {
    static constexpr bool PERM = false;
    float* G; const float* bif;
    __device__ __forceinline__ void operator()(const f32x4 (&acc)[2][2][4][2], const pg8::Unit& u, int wr, int wc, int fr, int fq) const {
        if (wc != 0 || u.pn != 0) return;
        const f32x4 bv = *(const f32x4*)(bif + 4 * fq);
#pragma unroll
        for (int ai = 0; ai < 2; ++ai)
#pragma unroll
            for (int m = 0; m < 4; ++m) { const int row = u.pm * 256 + ai * 128 + wr * 64 + m * 16 + fr; *(f32x4*)(G + (size_t)row * 16 + 4 * fq) = acc[ai][0][m][0] + bv; }
    }
};
__device__ __forceinline__ void phase_prep1(const Ctx& c, const Params& P) {
    bf16_t* XMC = (bf16_t*)(P.ws + WS_BIG);
    const float* cw = P.in[I_BCW]; const float* cb = P.in[I_BCB];
    const int gw = c.bid * NWAVES + c.wave, NGW = c.G * NWAVES, lane = c.lane;
    for (int row = gw; row < MT; row += NGW) {
        int rm, rp; bool hm, hp;
        if (row >= ML) { const int p = (row - ML) % CTX; hm = p > 0; hp = p + 1 < CTX; rm = row - 1; rp = row + 1; }
        else { const int b = row / SEQ, t = row % SEQ, r = t / GW, col = t % GW;
            hm = !(r == 0 && col == 0); hp = !(r == GROWS - 1 && col == GW - 1);
            rm = b * SEQ + (r > 0 ? (r - 1) * GW + col : (GROWS - 1) * GW + col - 1);
            rp = b * SEQ + (r < GROWS - 1 ? (r + 1) * GW + col : col + 1); }
        const float mm = hm ? 1.f : 0.f, mp = hp ? 1.f : 0.f;
        if (!hm) rm = row; if (!hp) rp = row;
#pragma unroll
        for (int q = 0; q < 4; ++q) { const int ch = 32 * lane + 8 * q;
            const u32x4 a = *(const u32x4*)(XMC + (size_t)rm * 4096 + ch), b_ = *(const u32x4*)(XMC + (size_t)row * 4096 + ch), d = *(const u32x4*)(XMC + (size_t)rp * 4096 + ch);
            const unsigned aw[4] = {a.x, a.y, a.z, a.w}, bw[4] = {b_.x, b_.y, b_.z, b_.w}, dw[4] = {d.x, d.y, d.z, d.w}; unsigned o[4];
#pragma unroll
            for (int e = 0; e < 4; ++e) { const int c0 = ch + 2 * e;
                const float y0 = siluf_(cw[c0] * bflo(aw[e]) * mm + cw[2048 + c0] * bflo(bw[e]) + cw[4096 + c0] * bflo(dw[e]) * mp + cb[c0]);
                const float y1 = siluf_(cw[c0 + 1] * bfhi(aw[e]) * mm + cw[2048 + c0 + 1] * bfhi(bw[e]) + cw[4096 + c0 + 1] * bfhi(dw[e]) * mp + cb[c0 + 1]);
                o[e] = pk2(y0, y1); }
            *(u32x4*)(XMC + (size_t)row * 4096 + 2048 + ch) = (u32x4){o[0], o[1], o[2], o[3]}; }
    }
}

namespace sc1 {
constexpr int LT = 72, LC = 520, EB = 32;
constexpr int O_CT = 0;
constexpr int O_Q = O_CT + EB * LC * 2;
constexpr int O_K = O_Q + 64 * LT * 2;
constexpr int O_KT = O_K + 64 * LT * 2;
constexpr int O_VT = O_KT + 64 * LT * 2;
constexpr int O_VW = O_VT + EB * LT * 2;
constexpr int O_S = O_VW + EB * LT * 2;
constexpr int O_WQ = O_S + 64 * LT * 2;
constexpr int O_WK = O_WQ + 128 * 16 * 2;
constexpr int O_WV = O_WK + 128 * 16 * 2;
constexpr int O_N = O_WV + (EB / 4) * 16 * 2;
constexpr int O_VEC = O_N + 512 * 4;
constexpr int O_END = O_VEC + 768 * 4;
static_assert(O_END <= 144 * 1024, "scan1 LDS");
__device__ __forceinline__ bf16x8 frag(const LAS unsigned char* lds, int off, int ld, int row, int k) { return *(const LAS bf16x8*)(lds + off + (row * ld + k) * 2); }

__device__ __forceinline__ void chain(const Ctx& c, const Params& P, int dir, int b, int h, int eb) {
    LAS unsigned char* lds = c.lds;
    const int tid = c.tid, lane = c.lane, w = c.wave, fr = lane & 15, fq = lane >> 4;
    const bf16_t* XMC = (const bf16_t*)(P.ws + WS_BIG);
    bf16_t* O = (bf16_t*)(P.ws + WS_BIG + (size_t)MT * 4096 * 2);
    const float* GT = (const float*)(P.ws + WS_GATES);
    LAS float* vec = (LAS float*)(lds + O_VEC); LAS float* nst = (LAS float*)(lds + O_N);
    const int ti_ = tid >> 3, seg = tid & 7;
    { LAS bf16_t* wql = (LAS bf16_t*)(lds + O_WQ); LAS bf16_t* wkl = (LAS bf16_t*)(lds + O_WK); LAS bf16_t* wvl = (LAS bf16_t*)(lds + O_WV);
      for (int i = tid; i < 128 * 16; i += NTHREADS) { wql[i] = (bf16_t)f2bf(P.in[I_BWQ][(size_t)h * 2048 + i]); wkl[i] = (bf16_t)f2bf(P.in[I_BWK][(size_t)h * 2048 + i] * 0.04419417382415922f); }
      if (tid < EB * 4) wvl[tid] = (bf16_t)f2bf(P.in[I_BWV][(size_t)h * 2048 + eb * (EB * 4) + tid]);
      for (int i = tid; i < EB * LC / 2; i += NTHREADS) ((LAS unsigned*)(lds + O_CT))[i] = 0u;
      nst[tid] = 0.f;
      if (tid == 0) { vec[448] = 0.f; vec[449] = -1e30f; } }
    f32x4 cst[8];
#pragma unroll
    for (int s = 0; s < 8; ++s) cst[s] = (f32x4){0.f, 0.f, 0.f, 0.f};
    __syncthreads();
    const int ti = w >> 1, tp = 2 * (w & 1), te = w & 1;
    for (int sgi = 0; sgi < 2; ++sgi) {
        const int isctx = (sgi == 0); const int L = isctx ? CTX : SEQ, nch = L / 64;
        for (int ci = 0; ci < nch; ++ci) {
            int zoff = 0; OPAQUE_V(zoff);
            LAS unsigned char* lds = c.lds + zoff; LAS float* vec = (LAS float*)(lds + O_VEC); LAS float* nst = (LAS float*)(lds + O_N);
            const int ch = dir ? nch - 1 - ci : ci;
            const int row = row_of(isctx, b, ch * 64 + (dir ? 63 - ti_ : ti_));
            if (w == 0) {
                const int rl = row_of(isctx, b, ch * 64 + (dir ? 63 - lane : lane));
                const float ig = GT[(size_t)rl * 16 + dir * 8 + h], lf = log_sigmoidf_(GT[(size_t)rl * 16 + dir * 8 + 4 + h]);
                float bc = lf;
#pragma unroll
                for (int o = 1; o < 64; o <<= 1) { const float u = __shfl(bc, lane >= o ? lane - o : lane); if (lane >= o) bc += u; }
                const float a = ig - bc; float pm = a;
#pragma unroll
                for (int o = 1; o < 64; o <<= 1) { const float u = __shfl(pm, lane >= o ? lane - o : lane); if (lane >= o) pm = fmaxf(pm, u); }
                const float m0 = vec[449];
                const float mrow = bc + fmaxf(m0, pm);
                const float mnew = __shfl(mrow, 63), b63 = __shfl(bc, 63);
                vec[lane] = bc - mrow; vec[64 + lane] = a; vec[128 + lane] = __expf(bc + m0 - mrow); vec[192 + lane] = __expf(b63 - bc + ig - mnew);
                vec[256 + lane] = __expf(-mrow);
                if (lane == 0) { vec[448] = __expf(b63 + m0 - mnew); vec[450] = mnew; }
            }
            __syncthreads();
            if (tid == 0) vec[449] = vec[450];
            { const int cv = h * 512 + eb * EB + seg * 4; const u32x2 xv = *(const u32x2*)(XMC + (size_t)row * 4096 + cv);
              const float x[4] = {bflo(xv.x), bfhi(xv.x), bflo(xv.y), bfhi(xv.y)};
              const LAS bf16_t* wvl = (const LAS bf16_t*)(lds + O_WV); LAS bf16_t* vt = (LAS bf16_t*)(lds + O_VT); LAS bf16_t* vw = (LAS bf16_t*)(lds + O_VW);
              const float wkj = vec[192 + ti_];
#pragma unroll
              for (int e = 0; e < 4; ++e) { float v = 0.f;
#pragma unroll
                  for (int dp = 0; dp < 4; ++dp) v += x[dp] * bf2f(wvl[seg * 16 + dp * 4 + e]);
                  vt[(seg * 4 + e) * LT + ti_] = (bf16_t)f2bf(v); vw[(seg * 4 + e) * LT + ti_] = (bf16_t)f2bf(v * wkj); } }
            f32x4 accS[2], accI; float qn = 0.f;
#pragma unroll
            for (int q = 0; q < 2; ++q) accS[q] = (f32x4){0.f, 0.f, 0.f, 0.f};
            accI = (f32x4){0.f, 0.f, 0.f, 0.f};
            const float decay0 = vec[448];
#pragma unroll
            for (int s = 0; s < 8; ++s) {
                { const int cq = 2048 + h * 512 + s * 64 + seg * 8; const u32x4 xv = *(const u32x4*)(XMC + (size_t)row * 4096 + cq);
                  const float x[8] = {bflo(xv.x), bfhi(xv.x), bflo(xv.y), bfhi(xv.y), bflo(xv.z), bfhi(xv.z), bflo(xv.w), bfhi(xv.w)};
                  const LAS bf16_t* wql = (const LAS bf16_t*)(lds + O_WQ); const LAS bf16_t* wkl = (const LAS bf16_t*)(lds + O_WK);
                  float qv[8], kv[8]; float part = 0.f;
#pragma unroll
                  for (int bl = 0; bl < 2; ++bl) { const int nb = (s * 16 + seg * 2 + bl) * 16;
                      const u32x4 wq0 = *(const LAS u32x4*)(wql + nb), wq1 = *(const LAS u32x4*)(wql + nb + 8), wk0 = *(const LAS u32x4*)(wkl + nb), wk1 = *(const LAS u32x4*)(wkl + nb + 8);
                      const unsigned wqw[8] = {wq0.x, wq0.y, wq0.z, wq0.w, wq1.x, wq1.y, wq1.z, wq1.w}, wkw[8] = {wk0.x, wk0.y, wk0.z, wk0.w, wk1.x, wk1.y, wk1.z, wk1.w};
#pragma unroll
                      for (int e = 0; e < 4; ++e) { float a = 0.f, bb = 0.f;
#pragma unroll
                          for (int dp = 0; dp < 4; ++dp) { const int wi = (dp * 4 + e) >> 1; const bool hi = (dp * 4 + e) & 1;
                              a += x[bl * 4 + dp] * (hi ? bfhi(wqw[wi]) : bflo(wqw[wi])); bb += x[bl * 4 + dp] * (hi ? bfhi(wkw[wi]) : bflo(wkw[wi])); }
                          qv[bl * 4 + e] = a; kv[bl * 4 + e] = bb; part += a * nst[s * 64 + seg * 8 + bl * 4 + e]; }
                      ASM_FENCE(); }
                  part += __shfl_xor(part, 1); part += __shfl_xor(part, 2); part += __shfl_xor(part, 4); qn += part;
                  *(LAS u32x4*)(lds + O_Q + (ti_ * LT + seg * 8) * 2) = (u32x4){pk2(qv[0], qv[1]), pk2(qv[2], qv[3]), pk2(qv[4], qv[5]), pk2(qv[6], qv[7])};
                  *(LAS u32x4*)(lds + O_K + (ti_ * LT + seg * 8) * 2) = (u32x4){pk2(kv[0], kv[1]), pk2(kv[2], kv[3]), pk2(kv[4], kv[5]), pk2(kv[6], kv[7])};
                  LAS bf16_t* kt = (LAS bf16_t*)(lds + O_KT);
#pragma unroll
                  for (int e = 0; e < 8; ++e) kt[(seg * 8 + e) * LT + ti_] = (bf16_t)f2bf(kv[e]); }
                __syncthreads();
                f32x4 U;
                { bf16x8 qa[2];
                  if (!isctx) {
#pragma unroll
                      for (int kq = 0; kq < 2; ++kq) qa[kq] = frag(lds, O_Q, LT, ti * 16 + fr, kq * 32 + 8 * fq);
#pragma unroll
                      for (int q = 0; q < 2; ++q) {
                          if (tp + q <= ti) {
#pragma unroll
                              for (int kq = 0; kq < 2; ++kq) accS[q] = __builtin_amdgcn_mfma_f32_16x16x32_bf16(qa[kq], frag(lds, O_K, LT, (tp + q) * 16 + fr, kq * 32 + 8 * fq), accS[q], 0, 0, 0); } }
#pragma unroll
                      for (int kq = 0; kq < 2; ++kq) accI = __builtin_amdgcn_mfma_f32_16x16x32_bf16(qa[kq], frag(lds, O_CT, LC, te * 16 + fr, s * 64 + kq * 32 + 8 * fq), accI, 0, 0, 0); }
                  bf16x8 ka[2];
#pragma unroll
                  for (int kq = 0; kq < 2; ++kq) ka[kq] = frag(lds, O_KT, LT, ti * 16 + fr, kq * 32 + 8 * fq);
                  U = (f32x4){0.f, 0.f, 0.f, 0.f};
#pragma unroll
                  for (int kq = 0; kq < 2; ++kq) U = __builtin_amdgcn_mfma_f32_16x16x32_bf16(ka[kq], frag(lds, O_VW, LT, te * 16 + fr, kq * 32 + 8 * fq), U, 0, 0, 0); }
                float nsum;
                { const int dd = 8 * w + (lane >> 3), jo = lane & 7; const bf16x8 kk8 = frag(lds, O_KT, LT, dd, 8 * jo); nsum = 0.f;
#pragma unroll
                  for (int e = 0; e < 8; ++e) nsum += bf2f((unsigned short)kk8[e]) * vec[192 + 8 * jo + e];
                  nsum += __shfl_xor(nsum, 1); nsum += __shfl_xor(nsum, 2); nsum += __shfl_xor(nsum, 4); }
                __syncthreads();
                {
#pragma unroll
                    for (int r = 0; r < 4; ++r) cst[s][r] = decay0 * cst[s][r] + U[r];
                    u32x2 pw; pw.x = pk2(cst[s][0], cst[s][1]); pw.y = pk2(cst[s][2], cst[s][3]);
                    *(LAS u32x2*)(lds + O_CT + ((te * 16 + fr) * LC + s * 64 + ti * 16 + 4 * fq) * 2) = pw; }
                if ((lane & 7) == 0) { const int dd = s * 64 + 8 * w + (lane >> 3); nst[dd] = decay0 * nst[dd] + nsum; }
            }
            if (!isctx) {
                if (seg == 0) vec[384 + ti_] = qn;
                { LAS bf16_t* sl = (LAS bf16_t*)(lds + O_S);
#pragma unroll
                  for (int q = 0; q < 2; ++q) { const int j = (tp + q) * 16 + fr; const float aj = vec[64 + j];
#pragma unroll
                      for (int r = 0; r < 4; ++r) { const int i = ti * 16 + 4 * fq + r; float sv = (j <= i) ? accS[q][r] * __expf(fminf(vec[i] + aj, 0.f)) : 0.f;
                          sl[i * LT + j] = (bf16_t)f2bf(sv);
                          sv += __shfl_xor(sv, 1); sv += __shfl_xor(sv, 2); sv += __shfl_xor(sv, 4); sv += __shfl_xor(sv, 8);
                          if (fr == 0) vec[512 + (tp + q) * 64 + i] = sv; } } }
                __syncthreads();
                { bf16x8 sa[2];
#pragma unroll
                  for (int kq = 0; kq < 2; ++kq) sa[kq] = frag(lds, O_S, LT, ti * 16 + fr, kq * 32 + 8 * fq);
                  { f32x4 a1 = (f32x4){0.f, 0.f, 0.f, 0.f};
#pragma unroll
                      for (int kq = 0; kq < 2; ++kq) a1 = __builtin_amdgcn_mfma_f32_16x16x32_bf16(sa[kq], frag(lds, O_VT, LT, te * 16 + fr, kq * 32 + 8 * fq), a1, 0, 0, 0);
#pragma unroll
                      for (int r = 0; r < 4; ++r) { const int i = ti * 16 + 4 * fq + r; const float wi = vec[128 + i];
                          const float den = ((vec[512 + i] + vec[576 + i]) + (vec[640 + i] + vec[704 + i])) + wi * vec[384 + i]; const float dn = fmaxf(fabsf(den), vec[256 + i]);
                          float o = (a1[r] + wi * accI[r]) / dn;
                          const int orow = row_of(0, b, ch * 64 + (dir ? 63 - i : i));
                          bf16_t* op = O + (size_t)orow * 2048 + h * 512 + eb * EB + te * 16 + fr;
                          if (dir) o += bf2f(*op);
                          *op = (bf16_t)f2bf(o); } } }
            }
            __syncthreads();
        }
    }
}
}
__device__ __forceinline__ void phase_scan1(const Ctx& c, const Params& P, int dir) {
    const int nitems = NB * 64;
    for (int it = c.bid; it < nitems; it += c.G) { sc1::chain(c, P, dir, it / 64, (it % 64) >> 4, it & 15); __syncthreads(); }
}
__device__ __forceinline__ void phase_post1(const Ctx& c, const Params& P) {
    const bf16_t* XMC = (const bf16_t*)(P.ws + WS_BIG); bf16_t* O = (bf16_t*)(P.ws + WS_BIG + (size_t)MT * 4096 * 2);
    const float* mh = P.in[I_BMHN]; const float* sk = P.in[I_BSKIP];
    const int gw = c.bid * NWAVES + c.wave, NGW = c.G * NWAVES, lane = c.lane;
    for (int row = gw; row < ML; row += NGW) {
        float hv[32]; float s = 0.f;
#pragma unroll
        for (int q = 0; q < 4; ++q) { const u32x4 a = *(const u32x4*)(O + (size_t)row * 2048 + 32 * lane + 8 * q); const unsigned aw[4] = {a.x, a.y, a.z, a.w};
#pragma unroll
            for (int e = 0; e < 4; ++e) { hv[q * 8 + 2 * e] = bflo(aw[e]); hv[q * 8 + 2 * e + 1] = bfhi(aw[e]); s += hv[q * 8 + 2 * e] + hv[q * 8 + 2 * e + 1]; } }
        s += __shfl_xor(s, 1); s += __shfl_xor(s, 2); s += __shfl_xor(s, 4); s += __shfl_xor(s, 8);
        const float mu = s * (1.0f / 512.0f); float v = 0.f;
#pragma unroll
        for (int e = 0; e < 32; ++e) { hv[e] -= mu; v += hv[e] * hv[e]; }
        v += __shfl_xor(v, 1); v += __shfl_xor(v, 2); v += __shfl_xor(v, 4); v += __shfl_xor(v, 8);
        const float rs = 1.0f / sqrtf(v * (1.0f / 512.0f) + EPS);
#pragma unroll
        for (int q = 0; q < 4; ++q) { const int ch = 32 * lane + 8 * q;
            const u32x4 xc = *(const u32x4*)(XMC + (size_t)row * 4096 + 2048 + ch), z = *(const u32x4*)(XMC + (size_t)row * 4096 + ch);
            const unsigned xw[4] = {xc.x, xc.y, xc.z, xc.w}, zw[4] = {z.x, z.y, z.z, z.w}; unsigned o[4];
#pragma unroll
            for (int e = 0; e < 4; ++e) { const int c0 = ch + 2 * e;
                const float f0 = (hv[q * 8 + 2 * e] * rs * mh[c0] + sk[c0] * bflo(xw[e])) * siluf_(bflo(zw[e]));
                const float f1 = (hv[q * 8 + 2 * e + 1] * rs * mh[c0 + 1] + sk[c0 + 1] * bfhi(xw[e])) * siluf_(bfhi(zw[e]));
                o[e] = pk2(f0, f1); }
            *(u32x4*)(O + (size_t)row * 2048 + ch) = (u32x4){o[0], o[1], o[2], o[3]}; }
    }
}
__device__ __forceinline__ void phase_final(const Ctx& c, const Params& P) {
    const float* w = P.in[I_FNORM]; const int gw = c.bid * NWAVES + c.wave, NGW = c.G * NWAVES;
    f32x4 wv[4];
#pragma unroll
    for (int j = 0; j < 4; ++j) wv[j] = *(const f32x4*)(w + 4 * c.lane + 256 * j);
    for (int row = gw; row < ML; row += NGW) { float* xr = P.out + (size_t)row * D; f32x4 v[4]; float s = 0.f;
#pragma unroll
        for (int j = 0; j < 4; ++j) { v[j] = *(const f32x4*)(xr + 4 * c.lane + 256 * j); s += (v[j].x * v[j].x + v[j].y * v[j].y) + (v[j].z * v[j].z + v[j].w * v[j].w); }
        const float rs = 1.0f / sqrtf(wave_sum(s) * (1.0f / D) + EPS);
#pragma unroll
        for (int j = 0; j < 4; ++j) *(f32x4*)(xr + 4 * c.lane + 256 * j) = v[j] * rs * wv[j]; }
}

enum { PH_PRO = 0, PH_H0, PH_G0, PH_S0F, PH_S0B, PH_POST0, PH_G1, PH_H1, PH_G2, PH_G3, PH_H2, PH_G4, PH_PREP1, PH_GG, PH_S1F, PH_S1B, PH_G5, PH_POST1, PH_G6, PH_H3, PH_G7, PH_G8, PH_FIN, PH_COUNT };

__device__ __forceinline__ void run_phase(int ph, const Params& P, LAS unsigned char* lds, int bid, int G) {
    Ctx c; c.lds = lds; c.tid = threadIdx.x; c.lane = c.tid & 63; c.wave = __builtin_amdgcn_readfirstlane(c.tid >> 6); c.bid = bid; c.G = G;
    unsigned char* ws = P.ws;
    float* mod = (float*)(ws + WS_MOD); float* mod1 = mod + (size_t)(NB + 1) * NMOD;
    bf16_t* WA = (bf16_t*)(ws + WS_WA); bf16_t* WB = (bf16_t*)(ws + WS_WB);
    bf16_t* H = (bf16_t*)(ws + WS_H); bf16_t* BIG = (bf16_t*)(ws + WS_BIG);
    float* ctxres = (float*)(ws + WS_CTXRES);
    switch (ph) {
    case PH_PRO: {
        phase_mods(c, P);
        int base = 0; const float* W = P.in[I_AWIN];
        cvt_seg(c, W, A_IN, D, 2048, 1024, WA, C_G, base);
        cvt_seg(c, W, A_IN, D, 3104, 1024, WA, C_Z, base);
        cvt_seg(c, W, A_IN, D, 0, 512, WA, C_Q, base);
        cvt_seg(c, W, A_IN, D, 512, 512, WA, C_K, base);
        cvt_seg(c, W, A_IN, D, 1024, 1024, WA, C_V, base);
        cvt_seg(c, W, A_IN, D, 4128, 1536, WA, C_XS, base);
        cvt_seg(c, W, A_IN, D, 3072, 32, WA, C_R, base);
        cvt_seg(c, W, A_IN, D, 5664, 32, WA, C_DT, base);
        for (int i = c.bid * NTHREADS + c.tid; i < (NP0 - A_IN) * D / 8; i += c.G * NTHREADS) *(u32x4*)(WA + (size_t)A_IN * D + (size_t)i * 8) = (u32x4){0u, 0u, 0u, 0u};
    } break;
    case PH_H0:
        phase_hnorm(c, P.in[I_X], P.in[I_CTX], P.in[I_NMIX], mod, 0, 1, H, 0, MT);
        break;
    case PH_G0: {
        pg8::Gemm g{H, WA, MT, NP0, D, D}; pg8::StaticOrder S; S.init(MT, NP0, G, bid);
        EpiStoreBf16 E{BIG, NP0};
        pg8::gemm_phase(lds, g, S, E);
    } break;
    case PH_S0F: phase_scan0(c, P, 0); break;
    case PH_S0B: phase_scan0(c, P, 1); break;
    case PH_POST0: {
        phase_post0(c, P);
        int base = 0; cvt_seg(c, P.in[I_AWOUT], D, 2048, 0, 1024, WB, 0, base);
    } break;
    case PH_G1: {
        pg8::Gemm g{BIG, WB, MT, D, 2048, NP0}; pg8::StaticOrder S; S.init(MT, D, G, bid);
        EpiResid E{P.in[I_X], P.in[I_CTX], P.out, ctxres, mod + 2 * D};
        pg8::gemm_phase(lds, g, S, E);
    } break;
    case PH_H1: {
        phase_hnorm(c, P.out, ctxres, P.in[I_NFFN], mod, 3, 4, H, 0, MT);
        int base = 0;
        for (int pn = 0; pn < DFF / 128; ++pn) { cvt_seg(c, P.in[I_W1], DFF, D, 128 * pn, 128, WA, 256 * pn, base); cvt_seg(c, P.in[I_W3], DFF, D, 128 * pn, 128, WA, 256 * pn + 128, base); }
        cvt_seg(c, P.in[I_W2], D, DFF, 0, 1024, WB, 0, base);
    } break;
    case PH_G2: {
        pg8::Gemm g{H, WA, MT, 2 * DFF, D, D}; pg8::StaticOrder S; S.init(MT, 2 * DFF, G, bid);
        EpiSwiGLU E{BIG, DFF};
        pg8::gemm_phase(lds, g, S, E);
    } break;
    case PH_G3: {
        pg8::Gemm g{BIG, WB, MT, D, DFF, DFF}; pg8::StaticOrder S; S.init(MT, D, G, bid);
        EpiResid E{P.out, ctxres, P.out, ctxres, mod + 5 * D};
        pg8::gemm_phase(lds, g, S, E);
    } break;
    case PH_H2: {
        phase_hnorm(c, P.out, ctxres, P.in[I_NMIX] + D, mod1, 0, 1, H, 0, MT);
        int base = 0;
        cvt_seg(c, P.in[I_BWUP], 4096, D, 0, 2048, WA, 0, base);
        cvt_seg(c, P.in[I_BWUP], 4096, D, 2048, 2048, WB, 0, base);
        build_gate_weights(c, P, WA + (size_t)5 * MiB / 2);
    } break;
    case PH_G4: {
        pg8::Gemm g{H, WA, MT, 2048, D, D}; pg8::StaticOrder S; S.init(MT, 2048, G, bid);
        EpiStoreBf16 E{BIG, 4096};
        pg8::gemm_phase(lds, g, S, E);
    } break;
    case PH_PREP1: phase_prep1(c, P); break;
    case PH_GG: {
        pg8::Gemm g{BIG, WA + (size_t)5 * MiB / 2, MT, 256, 4096, 4096}; pg8::StaticOrder S; S.init(MT, 256, G, bid);
        EpiGates E{(float*)(ws + WS_GATES), P.in[I_BBIF]};
        pg8::gemm_phase(lds, g, S, E);
    } break;
    case PH_S1F: phase_scan1(c, P, 0); break;
    case PH_S1B: phase_scan1(c, P, 1); break;
    case PH_G5: {
        pg8::Gemm g{H, WB, ML, 2048, D, D}; pg8::StaticOrder S; S.init(ML, 2048, G, bid);
        EpiStoreBf16 E{BIG, 4096};
        pg8::gemm_phase(lds, g, S, E);
    } break;
    case PH_POST1: {
        phase_post1(c, P);
        int base = 0; cvt_seg(c, P.in[I_BWDOWN], D, 2048, 0, 1024, WB, 0, base);
    } break;
    case PH_G6: {
        pg8::Gemm g{BIG + (size_t)MT * 4096, WB, ML, D, 2048, 2048}; pg8::StaticOrder S; S.init(ML, D, G, bid);
        EpiResid E{P.out, ctxres, P.out, ctxres, mod1 + 2 * D};
        pg8::gemm_phase(lds, g, S, E);
    } break;
    case PH_H3: {
        phase_hnorm(c, P.out, ctxres, P.in[I_NFFN] + D, mod1, 3, 4, H, 0, ML);
        int base = 0; const float* w1 = P.in[I_W1] + (size_t)D * DFF; const float* w3 = P.in[I_W3] + (size_t)D * DFF;
        for (int pn = 0; pn < DFF / 128; ++pn) { cvt_seg(c, w1, DFF, D, 128 * pn, 128, WA, 256 * pn, base); cvt_seg(c, w3, DFF, D, 128 * pn, 128, WA, 256 * pn + 128, base); }
        cvt_seg(c, P.in[I_W2] + (size_t)DFF * D, D, DFF, 0, 1024, WB, 0, base);
    } break;
    case PH_G7: {
        pg8::Gemm g{H, WA, ML, 2 * DFF, D, D}; pg8::StaticOrder S; S.init(ML, 2 * DFF, G, bid);
        EpiSwiGLU E{BIG, DFF};
        pg8::gemm_phase(lds, g, S, E);
    } break;
    case PH_G8: {
        pg8::Gemm g{BIG, WB, ML, D, DFF, DFF}; pg8::StaticOrder S; S.init(ML, D, G, bid);
        EpiResid E{P.out, ctxres, P.out, ctxres, mod1 + 5 * D};
        pg8::gemm_phase(lds, g, S, E);
    } break;
    case PH_FIN: phase_final(c, P); break;
    default: break;
    }
}

#ifndef EMU
constexpr int LDS_BYTES = 147456;
__global__ void __launch_bounds__(NTHREADS, 2) phase_kernel(Params P, int ph) {
    extern __shared__ __attribute__((aligned(16))) unsigned char lds[];
    run_phase(ph, P, (LAS unsigned char*)lds, blockIdx.x, gridDim.x);
}
extern "C" void kernel_launch(void* const* d_in, const int* in_sizes, int n_in, void* d_out, int out_size, void* d_ws, size_t ws_size, hipStream_t stream) {
    static int grid = 0;
    if (grid == 0) {
        int dev = 0, cus = 0;
        hipGetDevice(&dev); hipDeviceGetAttribute(&cus, hipDeviceAttributeMultiprocessorCount, dev);
        hipFuncSetAttribute((const void*)phase_kernel, hipFuncAttributeMaxDynamicSharedMemorySize, LDS_BYTES);
        grid = cus > 0 ? cus : 256;
    }
    Params P{};
    for (int i = 0; i < 34; ++i) P.in[i] = (const float*)d_in[i];
    P.out = (float*)d_out; P.ws = (unsigned char*)d_ws;
    hipMemsetAsync((char*)d_ws + WS_CTL, 0, CTL_ZERO_BYTES, stream);
    for (int ph = 0; ph < PH_COUNT; ++ph) hipLaunchKernelGGL(phase_kernel, dim3(grid), dim3(NTHREADS), LDS_BYTES, stream, P, ph);
}
#endif
```

```cpp
#ifndef EMU
#include <hip/hip_runtime.h>
#include <cstdio>
#include <cstdint>
#endif

#ifndef CFG_BATCH
#define CFG_BATCH 4
#define CFG_SEQ 4096
#define CFG_CTX 256
#define CFG_GW 64
#endif
constexpr int D = 1024, NB = CFG_BATCH, SEQ = CFG_SEQ, CTX = CFG_CTX, GW = CFG_GW, GROWS = SEQ / GW, CHUNK = 64;
constexpr int ML = NB * SEQ, MC = NB * CTX, MT = ML + MC;
static_assert(ML % 256 == 0 && MT % 256 == 0 && SEQ % 64 == 0 && CTX % 64 == 0, "row tiling");
constexpr int NMOD = 6 * D;
constexpr int DFF = 2816;
constexpr int A_IN = 5696, NP0 = 5888;
constexpr int C_G = 0, C_Z = 1024, C_Q = 2048, C_K = 2560, C_V = 3072, C_XS = 4096, C_B = 5120, C_C = 5376, C_R = 5632, C_DT = 5664;
constexpr float EPS = 1e-6f;
constexpr int NTHREADS = 512, NWAVES = 8;
constexpr int G1_NSL = 3, G3_NSL = ((size_t)MT * (NP0 - DFF) * 2 >= (size_t)11 * MC * D * 4) ? 11 : 4;

#ifdef EMU
#define LAS
#define GAS
#define GAS
#define ASM_VMCNT(n) do {} while (0)
#define ASM_LGKMCNT(n) do {} while (0)
#define ASM_FENCE() do {} while (0)
#define WAVE_LDS_SYNC() emu::wave_sync()
#define LDS_BARRIER() __syncthreads()
#define SCHED_FENCE() do {} while (0)
#define OPAQUE_V(x) do {} while (0)
#else
#define LAS __attribute__((address_space(3)))
#define GAS __attribute__((address_space(1)))
#define GAS __attribute__((address_space(1)))
#define ASM_VMCNT(n) asm volatile("s_waitcnt vmcnt(" #n ")" ::: "memory")
#define ASM_LGKMCNT(n) asm volatile("s_waitcnt lgkmcnt(" #n ")" ::: "memory")
#define ASM_FENCE() asm volatile("" ::: "memory")
#define LDS_BARRIER() asm volatile("s_waitcnt lgkmcnt(0)\n\ts_barrier" ::: "memory")
#define SCHED_FENCE() do { asm volatile("" ::: "memory"); __builtin_amdgcn_sched_barrier(0); } while (0)
#define OPAQUE_V(x) asm volatile("" : "+v"(x))
#define WAVE_LDS_SYNC() do { asm volatile("s_waitcnt lgkmcnt(0)" ::: "memory"); } while (0)
#endif

typedef unsigned short bf16_t;
typedef short bf16x8 __attribute__((ext_vector_type(8)));
typedef short bf16x4 __attribute__((ext_vector_type(4)));
typedef float f32x4 __attribute__((ext_vector_type(4)));
typedef float f32x2 __attribute__((ext_vector_type(2)));
typedef unsigned u32x4 __attribute__((ext_vector_type(4)));
typedef unsigned u32x2 __attribute__((ext_vector_type(2)));

__device__ __forceinline__ unsigned f2bf(float f) { unsigned u = __builtin_bit_cast(unsigned, f); return (u + 0x7fffu + ((u >> 16) & 1u)) >> 16; }
#ifdef EMU
__device__ __forceinline__ unsigned pk2(float lo, float hi) { return f2bf(lo) | (f2bf(hi) << 16); }
#else
typedef __bf16 hwbf16x2 __attribute__((ext_vector_type(2)));
__device__ __forceinline__ unsigned pk2(float lo, float hi) { const f32x2 v = {lo, hi}; return __builtin_bit_cast(unsigned, __builtin_convertvector(v, hwbf16x2)); }
#endif
#ifdef EMU
__device__ __forceinline__ float dot2bf(unsigned a, unsigned b, float c) { return emu_fdot2_bf16(a, b, c); }
#else
__device__ __forceinline__ float dot2bf(unsigned a, unsigned b, float c) { return __builtin_amdgcn_fdot2_f32_bf16(__builtin_bit_cast(hwbf16x2, a), __builtin_bit_cast(hwbf16x2, b), c, false); }
#endif
__device__ __forceinline__ float bf2f(unsigned h) { return __builtin_bit_cast(float, (h & 0xffffu) << 16); }
__device__ __forceinline__ float bflo(unsigned w) { return __builtin_bit_cast(float, w << 16); }
__device__ __forceinline__ float bfhi(unsigned w) { return __builtin_bit_cast(float, w & 0xffff0000u); }
__device__ __forceinline__ float sigmoidf_(float x) { return __builtin_amdgcn_rcpf(1.0f + __expf(-x)); }
__device__ __forceinline__ float siluf_(float x) { return x * __builtin_amdgcn_rcpf(1.0f + __expf(-x)); }
__device__ __forceinline__ float log1pexp_(float ax) { return __logf(1.0f + __expf(-ax)); }
__device__ __forceinline__ float log_sigmoidf_(float x) { return fminf(x, 0.f) - log1pexp_(fabsf(x)); }
__device__ __forceinline__ float softplusf_(float x) { return fmaxf(x, 0.f) + log1pexp_(fabsf(x)); }
__device__ __forceinline__ float wave_sum(float v) {
#pragma unroll
    for (int o = 1; o < 64; o <<= 1) v += __shfl_xor(v, o);
    return v;
}

constexpr size_t MiB = 1u << 20;
constexpr size_t WS_CTL = 0;
constexpr size_t WS_MOD = 64 * 1024;
constexpr size_t MOD_BYTES = (size_t)2 * (NB + 1) * NMOD * 4;
constexpr size_t CTL_ZERO_BYTES = 512 * 1024;
static_assert(WS_MOD + MOD_BYTES <= CTL_ZERO_BYTES && 3456 * 4 <= WS_MOD, "mods and barrier words inside the memset region");
constexpr size_t WS_GATES = 1 * MiB;
constexpr size_t WS_WB = 3 * MiB;
constexpr size_t WS_CTXRES = 9 * MiB;
constexpr size_t WS_H = 13 * MiB;
constexpr size_t WS_BIG = 47 * MiB;
constexpr size_t BIG_BYTES = (size_t)MT * NP0 * 2;
constexpr size_t WS_WA = WS_BIG + ((BIG_BYTES + 255) & ~(size_t)255);
constexpr size_t WS_END = WS_WA + 12 * MiB;
static_assert((size_t)MT * DFF * 2 + (size_t)G3_NSL * MC * D * 4 <= BIG_BYTES, "FFN-down partial slabs fit behind the hidden activations");
static_assert(WS_CTXRES + (size_t)MC * D * 4 <= WS_H && WS_H + (size_t)MT * D * 2 <= WS_BIG, "workspace map");
static_assert((size_t)MT * 4096 * 2 + (size_t)ML * 2048 * 2 <= BIG_BYTES + 5 * MiB, "layer-1 O spills at most 5 MiB into WA");
static_assert(WS_END <= 256 * MiB, "workspace fits 256 MiB");

struct ParamsK {
    const float* in[34];
    float* out;
    unsigned char* ws;
};
constexpr int PARAM_LDS_OFF = 147456 - 512;
struct Params {
    const LAS unsigned long long* pl;
    __device__ __forceinline__ unsigned long long ld(int i) const {
#ifdef EMU
        return pl[i];
#else
        const unsigned long long v = pl[i]; const unsigned lo = __builtin_amdgcn_readfirstlane((unsigned)v), hi = __builtin_amdgcn_readfirstlane((unsigned)(v >> 32));
        return ((unsigned long long)hi << 32) | lo;
#endif
    }
    __device__ __forceinline__ const float* in_(int i) const { return (const float*)ld(i); }
    __device__ __forceinline__ float* out_() const { return (float*)ld(34); }
    __device__ __forceinline__ unsigned char* ws_() const { return (unsigned char*)ld(35); }
};
#ifdef EMU
template <class T> __device__ __forceinline__ T* gmem(T* p) { return p; }
#else
template <class T> __device__ __forceinline__ T* gmem(T* p) { return (T*)(GAS T*)(unsigned long long)p; }
#endif
enum { I_X = 0, I_C, I_CTX, I_CCTX, I_WMOD, I_BMOD, I_NMIX, I_NFFN, I_W1, I_W3, I_W2, I_AWIN, I_AGW, I_AGB, I_AGN, I_ACW, I_ACB, I_AALOG, I_ADTB, I_AD, I_ASN, I_AWOUT,
       I_BWUP, I_BCW, I_BCB, I_BWQ, I_BWK, I_BWV, I_BWIF, I_BBIF, I_BMHN, I_BSKIP, I_BWDOWN, I_FNORM };

namespace pg8 {
constexpr int BM = 256, BK = 64, HALF = 128, HTB = HALF * BK * 2, STAGE_BYTES = 8 * HTB, NXCD = 8, WGM = 8;
__host__ __device__ __forceinline__ int lds_byte(int r, int c) { const int st = (r >> 4) * 2 + (c >> 5), rr = r & 15, cc = c & 31, ob = rr * 64 + cc * 2; return st * 1024 + (ob ^ (((ob >> 9) & 1) << 5)); }
__host__ __device__ __forceinline__ void stage_rc(int b, int& R, int& C) { const int st = b / 1024, sb = b % 1024, swz = sb ^ (((sb >> 9) & 1) << 5); R = (st >> 1) * 16 + swz / 64; C = (st & 1) * 32 + (swz % 64) / 2; }
__host__ __device__ __forceinline__ int perm32(int rho) { const int n = rho >> 4, i = rho & 15; return 8 * (i >> 2) + 4 * n + (i & 3); }
struct Unit { int pm, pn, k0, nt, sl; };
struct Gemm { const bf16_t* A; const bf16_t* Bt; int M, N, K, lda; };
template <int NXM = 0, int NSL = 1>
struct StaticOrderT {
    int nM, nN, G, c, ntK;
    __host__ __device__ void init(int M, int N, int K, int G_, int c_) { nM = M / BM; nN = N / BM; G = G_; c = c_; ntK = K / BK; }
    __host__ __device__ bool next(int i, Unit& u) const {
        const int nwg = nM * nN; const int L = i * G + c;
        int pm = 0, pn = 0, k0 = 0, nt = ntK, sl = -1; bool ok = false;
        if (L < nwg) {
            int wgid = L; { const int q = nwg / NXCD, r = nwg % NXCD, xcd = wgid % NXCD, off = wgid / NXCD; wgid = (xcd < r ? xcd * (q + 1) : r * (q + 1) + (xcd - r) * q) + off; }
            const int nig = WGM * nN, gid = wgid / nig, fm = gid * WGM, gsz = (nM - fm) < WGM ? (nM - fm) : WGM;
            pm = fm + ((wgid % nig) % gsz); pn = (wgid % nig) / gsz; ok = true; }
        else if (NXM != 0) {
            const int xunits = NXM * nN * NSL, nmain = (nwg - c + G - 1) / G;
            const int j = (i - nmain) * G + c;
            if (j < xunits) { sl = j % NSL; const int t = j / NSL; pn = t % nN; pm = nM + t / nN;
                const int base = (ntK / NSL) & ~1; k0 = sl * base; nt = (sl == NSL - 1) ? ntK - base * (NSL - 1) : base; ok = true; }
        }
        u.pm = pm; u.pn = pn; u.k0 = k0; u.nt = nt; u.sl = sl; return ok;
    }
};
typedef StaticOrderT<0, 1> StaticOrder;
template <class Epi, class Order>
__device__ __forceinline__ void gemm_phase(LAS unsigned char* lds, const Gemm g, const Order& S, const Epi& E, const int tid) {
    const int wid = __builtin_amdgcn_readfirstlane(tid >> 6), lane = tid & 63, wr = wid >> 2, wc = wid & 3, fr = lane & 15, fq = lane >> 4;
    const int K = g.K, lda = g.lda;
    unsigned voffA[2], voffB[2];
#pragma unroll
    for (int i = 0; i < 2; ++i) { int R, C; stage_rc(tid * 16 + i * 8192, R, C); const int Rb = Epi::PERM ? ((R & ~31) + perm32(R & 31)) : R;
        voffA[i] = (unsigned)(R * lda + C) * 2u; voffB[i] = (unsigned)(Rb * K + C) * 2u; }
    const size_t kstep = (size_t)(BK * 2);
    const size_t hstepA = (size_t)HALF * lda * 2, hstepB = (size_t)HALF * K * 2;
    const size_t tstepA = 2 * hstepA, tstepB = 2 * hstepB;
    const unsigned ldsw = (unsigned)wid * 1024u;
    const int aoff = lds_byte(wr * 64 + fr, fq * 8), boff = lds_byte(wc * 32 + fr, fq * 8);
#define PG8_SA(b, h) (((b) * 2 + (h)) * HTB)
#define PG8_SB(b, h) ((4 + (b) * 2 + (h)) * HTB)
#define PG8_STAGE(bufoff, gbase, voff) do { _Pragma("unroll") for (int _i = 0; _i < 2; ++_i) \
        __builtin_amdgcn_global_load_lds((const unsigned*)((const char*)(gbase) + (voff)[_i]), (LAS unsigned*)(lds + (bufoff) + ldsw + _i * 8192), 16, 0, 0); } while (0)
#define PG8_LDA(dst, b, h) do { _Pragma("unroll") for (int m = 0; m < 4; ++m) _Pragma("unroll") for (int k = 0; k < 2; ++k) dst[m][k] = *(const LAS bf16x8*)(lds + PG8_SA(b, h) + aoff + m * 2048 + k * 1024); } while (0)
#define PG8_LDB(dst, b, h) do { _Pragma("unroll") for (int n = 0; n < 2; ++n) _Pragma("unroll") for (int k = 0; k < 2; ++k) dst[n][k] = *(const LAS bf16x8*)(lds + PG8_SB(b, h) + boff + n * 2048 + k * 1024); } while (0)
#define PG8_MMA(ai, bj, At, Bt) do { __builtin_amdgcn_s_setprio(1); _Pragma("unroll") for (int m = 0; m < 4; ++m) _Pragma("unroll") for (int n = 0; n < 2; ++n) _Pragma("unroll") for (int k = 0; k < 2; ++k) \
        acc[ai][bj][m][n] = __builtin_amdgcn_mfma_f32_16x16x32_bf16(Bt[n][k], At[m][k], acc[ai][bj][m][n], 0, 0, 0); __builtin_amdgcn_s_setprio(0); } while (0)
#define PG8_BAR __builtin_amdgcn_s_barrier()
#define PG8_SCHED __builtin_amdgcn_sched_barrier(0)
    Unit cur, nxt; int ui = 0;
    if (!S.next(0, cur)) return;
    f32x4 acc[2][2][4][2];
#pragma unroll
    for (int a = 0; a < 2; ++a)
#pragma unroll
        for (int b = 0; b < 2; ++b)
#pragma unroll
            for (int m = 0; m < 4; ++m)
#pragma unroll
                for (int n = 0; n < 2; ++n) acc[a][b][m][n] = (f32x4){0.f, 0.f, 0.f, 0.f};
    bf16x8 At[4][2], B0[2][2], B1[2][2];
    const char* cA = (const char*)g.A + (size_t)cur.pm * tstepA + (size_t)cur.k0 * kstep; const char* cB = (const char*)g.Bt + (size_t)cur.pn * tstepB + (size_t)cur.k0 * kstep;
    PG8_STAGE(PG8_SB(0, 0), cB, voffB); PG8_STAGE(PG8_SB(0, 1), cB + hstepB, voffB); PG8_STAGE(PG8_SA(0, 0), cA, voffA); PG8_STAGE(PG8_SA(0, 1), cA + hstepA, voffA);
    if (wr == 1) PG8_BAR;
    ASM_VMCNT(2); PG8_BAR;
    PG8_STAGE(PG8_SB(1, 0), cB + kstep, voffB); PG8_STAGE(PG8_SA(1, 0), cA + kstep, voffA); PG8_STAGE(PG8_SB(1, 1), cB + hstepB + kstep, voffB);
    ASM_VMCNT(6); PG8_BAR;
    for (;;) {
        const bool has_next = S.next(ui + 1, nxt);
        const char* nA = has_next ? (const char*)g.A + (size_t)nxt.pm * tstepA + (size_t)nxt.k0 * kstep : cA; const char* nB = has_next ? (const char*)g.Bt + (size_t)nxt.pn * tstepB + (size_t)nxt.k0 * kstep : cB;
        const int nt = cur.nt;
        for (int t = 0; t < nt; t += 2) {
            const bool last = (t == nt - 2);
            const char* a1 = cA + (size_t)(t + 1) * kstep;
            const char* a2 = last ? nA : cA + (size_t)(t + 2) * kstep; const char* b2 = last ? nB : cB + (size_t)(t + 2) * kstep;
            const char* a3 = a2 + kstep; const char* b3 = b2 + kstep;
            PG8_LDB(B0, 0, 0); PG8_LDB(B1, 0, 1); PG8_SCHED; PG8_LDA(At, 0, 0); PG8_STAGE(PG8_SA(1, 1), a1 + hstepA, voffA);
            ASM_VMCNT(8); ASM_LGKMCNT(0); PG8_BAR; PG8_MMA(0, 0, At, B0); PG8_MMA(0, 1, At, B1); PG8_BAR; PG8_SCHED;
            PG8_LDA(At, 0, 1); PG8_STAGE(PG8_SB(0, 0), b2, voffB); PG8_STAGE(PG8_SB(0, 1), b2 + hstepB, voffB); PG8_STAGE(PG8_SA(0, 0), a2, voffA);
            ASM_VMCNT(8); ASM_LGKMCNT(0); PG8_BAR; PG8_MMA(1, 0, At, B0); PG8_MMA(1, 1, At, B1); PG8_BAR; PG8_SCHED;
            PG8_LDB(B0, 1, 0); PG8_LDB(B1, 1, 1); PG8_SCHED; PG8_LDA(At, 1, 0); PG8_STAGE(PG8_SA(0, 1), a2 + hstepA, voffA);
            ASM_VMCNT(8); ASM_LGKMCNT(0); PG8_BAR; PG8_MMA(0, 0, At, B0); PG8_MMA(0, 1, At, B1); PG8_BAR; PG8_SCHED;
            PG8_LDA(At, 1, 1); PG8_STAGE(PG8_SB(1, 0), b3, voffB); PG8_STAGE(PG8_SB(1, 1), b3 + hstepB, voffB); PG8_STAGE(PG8_SA(1, 0), a3, voffA);
            ASM_VMCNT(8); ASM_LGKMCNT(0); PG8_BAR; PG8_MMA(1, 0, At, B0); PG8_MMA(1, 1, At, B1); PG8_BAR; PG8_SCHED;
        }
        if (wr == 0) PG8_BAR;
        E(acc, cur, wr, wc, fr, fq);
        if (!has_next) break;
#pragma unroll
        for (int a = 0; a < 2; ++a)
#pragma unroll
            for (int b = 0; b < 2; ++b)
#pragma unroll
                for (int m = 0; m < 4; ++m)
#pragma unroll
                    for (int n = 0; n < 2; ++n) acc[a][b][m][n] = (f32x4){0.f, 0.f, 0.f, 0.f};
        cur = nxt; cA = nA; cB = nB; ++ui;
        if (wr == 1) PG8_BAR;
    }
    ASM_VMCNT(0);
    PG8_BAR;
#undef PG8_SA
#undef PG8_SB
#undef PG8_STAGE
#undef PG8_LDA
#undef PG8_LDB
#undef PG8_MMA
#undef PG8_BAR
#undef PG8_SCHED
}
}

struct EpiStoreBf16 {
    static constexpr bool PERM = true;
    bf16_t* O; int ldc;
    __device__ __forceinline__ void operator()(const f32x4 (&acc)[2][2][4][2], const pg8::Unit& u, int wr, int wc, int fr, int fq) const {
        const int row0 = u.pm * 256 + wr * 64 + fr, col0 = u.pn * 256 + wc * 32 + 8 * fq;
#pragma unroll
        for (int ai = 0; ai < 2; ++ai)
#pragma unroll
            for (int m = 0; m < 4; ++m) { bf16_t* rowp = O + (size_t)(row0 + ai * 128 + m * 16) * ldc + col0;
#pragma unroll
                for (int bj = 0; bj < 2; ++bj) { const f32x4 v0 = acc[ai][bj][m][0], v1 = acc[ai][bj][m][1];
                    u32x4 w; w.x = pk2(v0[0], v0[1]); w.y = pk2(v0[2], v0[3]); w.z = pk2(v1[0], v1[1]); w.w = pk2(v1[2], v1[3]);
                    *(u32x4*)(rowp + bj * 128) = w; } }
    }
};
struct EpiSwiGLU {
    static constexpr bool PERM = true;
    bf16_t* O; int ldc;
    __device__ __forceinline__ void operator()(const f32x4 (&acc)[2][2][4][2], const pg8::Unit& u, int wr, int wc, int fr, int fq) const {
        const int row0 = u.pm * 256 + wr * 64 + fr, col0 = u.pn * 128 + wc * 32 + 8 * fq;
#pragma unroll
        for (int ai = 0; ai < 2; ++ai)
#pragma unroll
            for (int m = 0; m < 4; ++m) { bf16_t* rowp = O + (size_t)(row0 + ai * 128 + m * 16) * ldc + col0;
                float r[8];
#pragma unroll
                for (int n = 0; n < 2; ++n)
#pragma unroll
                    for (int i = 0; i < 4; ++i) r[n * 4 + i] = siluf_(acc[ai][0][m][n][i]) * acc[ai][1][m][n][i];
                u32x4 w; w.x = pk2(r[0], r[1]); w.y = pk2(r[2], r[3]); w.z = pk2(r[4], r[5]); w.w = pk2(r[6], r[7]);
                *(u32x4*)rowp = w; }
    }
};
struct EpiResid {
    static constexpr bool PERM = false;
    const float* xin_lat; const float* xin_ctx; float* xout_lat; float* xout_ctx; const float* gate;
    float* part; int prs;
    __device__ __forceinline__ void operator()(const f32x4 (&acc)[2][2][4][2], const pg8::Unit& u, int wr, int wc, int fr, int fq) const {
        if (u.sl >= 0) { const int col0 = u.pn * 256 + wc * 32 + 4 * fq;
#pragma unroll
            for (int ai = 0; ai < 2; ++ai)
#pragma unroll
                for (int m = 0; m < 4; ++m) { float* pr = part + (size_t)(u.sl * MC + u.pm * 256 - ML + ai * 128 + wr * 64 + m * 16 + fr) * prs + col0;
#pragma unroll
                    for (int bj = 0; bj < 2; ++bj)
#pragma unroll
                        for (int n = 0; n < 2; ++n) *(f32x4*)(pr + bj * 128 + n * 16) = acc[ai][bj][m][n]; }
            return; }
        const int rbase = u.pm * 256;
        const bool isctx = rbase >= ML;
        const float* xin = isctx ? xin_ctx - (size_t)ML * D : xin_lat; float* xout = isctx ? xout_ctx - (size_t)ML * D : xout_lat;
        const float* gp = gate + (size_t)(isctx ? NB : rbase / SEQ) * NMOD;
        const int col0 = u.pn * 256 + wc * 32 + 4 * fq;
        f32x4 gv[2][2];
#pragma unroll
        for (int bj = 0; bj < 2; ++bj)
#pragma unroll
            for (int n = 0; n < 2; ++n) gv[bj][n] = *(const f32x4*)(gp + col0 + bj * 128 + n * 16);
#pragma unroll
        for (int ai = 0; ai < 2; ++ai)
#pragma unroll
            for (int m = 0; m < 4; ++m) { const size_t off = (size_t)(rbase + ai * 128 + wr * 64 + m * 16 + fr) * D + col0;
#pragma unroll
                for (int bj = 0; bj < 2; ++bj)
#pragma unroll
                    for (int n = 0; n < 2; ++n) { const f32x4 xi = *(const f32x4*)(xin + off + bj * 128 + n * 16);
                        *(f32x4*)(xout + off + bj * 128 + n * 16) = xi + gv[bj][n] * acc[ai][bj][m][n]; } }
    }
};

struct Ctx {
    LAS unsigned char* lds; int tid, lane, wave, bid, G;
};
__device__ __forceinline__ void cvt_item(const float* W, int ldw, int K, int c0, bf16_t* WT, int r0, LAS float* scr, int item, int nblk, int lane) {
    const int kb = item / nblk, nb = item % nblk, k0 = 64 * kb, n0 = 32 * nb;
#pragma unroll
    for (int i = 0; i < 8; ++i) { const int kk = 8 * i + (lane >> 3), c4 = (lane & 7) * 4; const f32x4 v = *(const f32x4*)(W + (size_t)(k0 + kk) * ldw + c0 + n0 + c4);
        LAS float* d = scr + kk * 33 + c4; d[0] = v[0]; d[1] = v[1]; d[2] = v[2]; d[3] = v[3]; }
    WAVE_LDS_SYNC();
    const int c = lane & 7;
#pragma unroll
    for (int j = 0; j < 4; ++j) { const int n = (lane >> 3) + 8 * j; const LAS float* s = scr + (8 * c) * 33 + n;
        u32x4 o; o.x = pk2(s[0 * 33], s[1 * 33]); o.y = pk2(s[2 * 33], s[3 * 33]); o.z = pk2(s[4 * 33], s[5 * 33]); o.w = pk2(s[6 * 33], s[7 * 33]);
        *(u32x4*)(WT + (size_t)(r0 + n0 + n) * K + k0 + 8 * c) = o; }
    WAVE_LDS_SYNC();
}
__device__ __forceinline__ void cvt_seg(const Ctx& c, const float* W, int ldw, int K, int c0, int ncols, bf16_t* WT, int r0, int& base) {
    LAS float* scr = (LAS float*)(c.lds + c.wave * 16384);
    const int nblk = ncols / 32, nitems = (K / 64) * nblk, NGW = c.G * NWAVES, gw = c.bid * NWAVES + c.wave;
    int first = (gw - base) % NGW; if (first < 0) first += NGW;
    for (int it = first; it < nitems; it += NGW) cvt_item(W, ldw, K, c0, WT, r0, scr, it, nblk, c.lane);
    base = (base + nitems) % NGW;
}

struct CtxFix { const float* part; int prs, nsl; const float* gate; float* ctx_out; };
__device__ __forceinline__ void phase_hnorm(const Ctx& c, const float* xlat, const float* xctx, const float* w, const float* mod, int shift_blk, int scale_blk, bf16_t* H, int row_lo, int row_hi, const CtxFix fx = CtxFix{nullptr, 0, 0, nullptr, nullptr}) {
    const int gw = c.bid * NWAVES + c.wave, NGW = c.G * NWAVES;
    f32x4 wv[4];
#pragma unroll
    for (int j = 0; j < 4; ++j) wv[j] = *(const f32x4*)(w + 4 * c.lane + 256 * j);
    f32x4 nv[4];
    { const int r0 = row_lo + gw; if (r0 < row_hi) { const float* xr = r0 >= ML ? xctx + (size_t)(r0 - ML) * D : xlat + (size_t)r0 * D;
#pragma unroll
        for (int j = 0; j < 4; ++j) nv[j] = *(const f32x4*)(xr + 4 * c.lane + 256 * j); } }
    for (int row = row_lo + gw; row < row_hi; row += NGW) {
        const bool isctx = row >= ML;
        const float* mp = mod + (size_t)(isctx ? NB : row / SEQ) * NMOD;
        f32x4 v[4]; float s = 0.f;
#pragma unroll
        for (int j = 0; j < 4; ++j) v[j] = nv[j];
        { const int r1 = row + NGW; if (r1 < row_hi) { const float* xr = r1 >= ML ? xctx + (size_t)(r1 - ML) * D : xlat + (size_t)r1 * D;
#pragma unroll
            for (int j = 0; j < 4; ++j) nv[j] = *(const f32x4*)(xr + 4 * c.lane + 256 * j); } }
#pragma unroll
        for (int j = 0; j < 4; ++j) {
            if (isctx && fx.part) { f32x4 a = (f32x4){0.f, 0.f, 0.f, 0.f};
                for (int sl = 0; sl < fx.nsl; ++sl) a += *(const f32x4*)(fx.part + (size_t)(sl * MC + row - ML) * fx.prs + 4 * c.lane + 256 * j);
                v[j] += *(const f32x4*)(fx.gate + 4 * c.lane + 256 * j) * a;
                *(f32x4*)(fx.ctx_out + (size_t)(row - ML) * D + 4 * c.lane + 256 * j) = v[j]; }
            s += (v[j].x * v[j].x + v[j].y * v[j].y) + (v[j].z * v[j].z + v[j].w * v[j].w); }
        const float rs = 1.0f / sqrtf(wave_sum(s) * (1.0f / D) + EPS);
#pragma unroll
        for (int j = 0; j < 4; ++j) {
            const f32x4 sh = *(const f32x4*)(mp + shift_blk * D + 4 * c.lane + 256 * j), sc = *(const f32x4*)(mp + scale_blk * D + 4 * c.lane + 256 * j);
            const f32x4 o = v[j] * rs * wv[j] * (1.0f + sc) + sh;
            u32x2 pw; pw.x = pk2(o.x, o.y); pw.y = pk2(o.z, o.w);
            *(u32x2*)(H + (size_t)row * D + 4 * c.lane + 256 * j) = pw;
        }
    }
}

__device__ __forceinline__ void phase_mods(const Ctx& c, const Params& P) {
    float* mod = (float*)(gmem(P.ws_()) + WS_MOD);
    const float* cv = gmem(P.in_(I_C)); const float* cc = gmem(P.in_(I_CCTX)); const float* wm = gmem(P.in_(I_WMOD)); const float* bm = gmem(P.in_(I_BMOD));
    LAS float* sc = (LAS float*)c.lds;
    LAS float* pt = sc + (NB + 1) * D;
    for (int i = c.tid; i < (NB + 1) * D; i += NTHREADS) { const int r = i / D, k = i % D; sc[i] = siluf_(r < NB ? cv[r * D + k] : cc[k]); }
    __syncthreads();
    constexpr int NU = 2 * (NMOD / 64);
    for (int u = c.bid; u < NU; u += c.G) {
        const int l = u / (NMOD / 64), kq = c.lane >> 4, n4 = (c.lane & 15) * 4, k0 = c.wave * 128;
        const float* wcol = wm + (size_t)l * D * NMOD + (u % (NMOD / 64)) * 64 + n4;
        f32x4 acc[NB + 1];
#pragma unroll
        for (int i = 0; i <= NB; ++i) acc[i] = (f32x4){0.f, 0.f, 0.f, 0.f};
#pragma unroll 8
        for (int kk = 0; kk < 32; ++kk) { const int k = k0 + 4 * kk + kq; const f32x4 wv = *(const f32x4*)(wcol + (size_t)k * NMOD);
#pragma unroll
            for (int i = 0; i <= NB; ++i) acc[i] += sc[i * D + k] * wv; }
#pragma unroll
        for (int i = 0; i <= NB; ++i) {
#pragma unroll
            for (int e = 0; e < 4; ++e) { float v = acc[i][e]; v += __shfl_xor(v, 16); v += __shfl_xor(v, 32); acc[i][e] = v; }
            if (kq == 0) *(LAS f32x4*)(pt + (c.wave * (NB + 1) + i) * 64 + n4) = acc[i]; }
        __syncthreads();
        if (c.tid < (NB + 1) * 64) { const int r = c.tid >> 6, nn = c.tid & 63; float s = bm[(size_t)l * NMOD + (u % (NMOD / 64)) * 64 + nn];
#pragma unroll
            for (int w = 0; w < 8; ++w) s += pt[(w * (NB + 1) + r) * 64 + nn];
            mod[((size_t)l * (NB + 1) + r) * NMOD + (u % (NMOD / 64)) * 64 + nn] = s; }
        __syncthreads();
    }
}

namespace sc0 {
constexpr int NCT = CTX / 64 + SEQ / 64, NCC = CTX / 64;
__device__ __forceinline__ size_t chunk_row0(int b, int gch) { return gch < NCC ? (size_t)ML + (size_t)b * CTX + (size_t)gch * 64 : (size_t)b * SEQ + (size_t)(gch - NCC) * 64; }
__device__ __forceinline__ bf16_t* tctx_ptr(unsigned char* ws) { return (bf16_t*)(ws + WS_WA + 4 * MiB); }
__device__ __forceinline__ float* ssdv_row(unsigned char* ws, size_t row) { return row < (size_t)ML ? (float*)(ws + WS_CTXRES) + row * 64 : (float*)(ws + WS_GATES + 5 * MiB / 4) + (row - ML) * 64; }
__device__ __forceinline__ float* glaf_ptr(unsigned char* ws) { return (float*)(ws + WS_GATES); }
__device__ __forceinline__ bf16_t* halo_ptr(unsigned char* ws) { return (bf16_t*)(ws + WS_WB); }
static_assert((size_t)MC * 2048 * 2 <= 8 * MiB && (size_t)ML * 64 * 4 <= 4 * MiB && (size_t)NB * 8 * NCT * 128 * 4 <= 5 * MiB / 4 && (size_t)MC * 64 * 4 <= MiB / 4 && (size_t)NB * NCT * 2 * 1536 * 2 <= 6 * MiB, "layer-0 scan scratch");

constexpr int LQ = 136, LT = 72;
__device__ __forceinline__ bf16x8 frag(const LAS unsigned char* lds, int off, int ld, int row, int k) { return *(const LAS bf16x8*)(lds + off + (row * ld + k) * 2); }
__device__ __forceinline__ bf16x8 tr_frag(const LAS unsigned char* lds, int off, int ld, int k0, int n0, int fr, int fq) {
    typedef short v4i16_t __attribute__((ext_vector_type(4)));
    const LAS unsigned char* p0 = lds + off + ((k0 + 8 * fq + (fr >> 2)) * ld + n0 + 4 * (fr & 3)) * 2;
    const v4i16_t a = __builtin_amdgcn_ds_read_tr16_b64_v4i16((LAS v4i16_t*)p0), b = __builtin_amdgcn_ds_read_tr16_b64_v4i16((LAS v4i16_t*)(p0 + 4 * ld * 2));
    return (bf16x8){a[0], a[1], a[2], a[3], b[0], b[1], b[2], b[3]};
}

__device__ __forceinline__ void phase_prep0a(const Ctx& c, const Params& P) {
    const bf16_t* P0 = (const bf16_t*)(gmem(P.ws_()) + WS_BIG); bf16_t* HL = halo_ptr(gmem(P.ws_()));
    const int n = NB * NCT * 2 * (1536 / 8);
    for (int i = c.bid * NTHREADS + c.tid; i < n; i += c.G * NTHREADS) { const int piece = i % 192, which = (i / 192) & 1, u = i / 384, b = u / NCT, gch = u % NCT;
        const size_t row = chunk_row0(b, gch) + (which ? 63 : 0);
        *(u32x4*)(HL + (size_t)(u * 2 + which) * 1536 + piece * 8) = *(const u32x4*)(P0 + row * NP0 + C_XS + piece * 8); }
}
constexpr int PB_T = 0;
constexpr int PB_W = 66 * 776 * 2;
static_assert(PB_W + 4 * 768 * 4 <= PARAM_LDS_OFF, "prep0 LDS");
__device__ __forceinline__ void prep_ssd_unit(const Ctx& c, const Params& P, int b, int gch) {
    LAS unsigned char* lds = c.lds; const int tid = c.tid, lane = c.lane, w = c.wave;
    bf16_t* P0 = (bf16_t*)(gmem(P.ws_()) + WS_BIG); const bf16_t* HL = halo_ptr(gmem(P.ws_()));
    const size_t row0 = chunk_row0(b, gch); const int isctx = gch < NCC; const int u = b * NCT + gch;
    const bool hasprev = gch != 0 && gch != NCC, hasnext = gch != NCC - 1 && gch != NCT - 1;
    LAS float* cwl = (LAS float*)(lds + PB_W);
    for (int half = 0; half < 2; ++half) {
        const int col0 = half * 768;
        { float wreg[6];
#pragma unroll
          for (int k = 0; k < 6; ++k) { const int i = tid + k * NTHREADS, tap = i / 768, cc = i % 768; wreg[k] = tap < 3 ? gmem(P.in_(I_ACW))[tap * 1536 + col0 + cc] : gmem(P.in_(I_ACB))[col0 + cc]; }
          u32x4 treg[13];
#pragma unroll
          for (int k = 0; k < 13; ++k) { const int i = tid + k * NTHREADS, r = i / 96, pc = i % 96; u32x4 v = (u32x4){0u, 0u, 0u, 0u};
              if (i < 66 * 96) {
                  if (r == 0) { if (hasprev) v = *(const u32x4*)(HL + (size_t)((u - 1) * 2 + 1) * 1536 + col0 + pc * 8); }
                  else if (r == 65) { if (hasnext) v = *(const u32x4*)(HL + (size_t)((u + 1) * 2 + 0) * 1536 + col0 + pc * 8); }
                  else v = *(const u32x4*)(P0 + (row0 + r - 1) * NP0 + C_XS + col0 + pc * 8); }
              treg[k] = v; }
#pragma unroll
          for (int k = 0; k < 6; ++k) cwl[tid + k * NTHREADS] = wreg[k];
#pragma unroll
          for (int k = 0; k < 13; ++k) { const int i = tid + k * NTHREADS, r = i / 96, pc = i % 96; if (i < 66 * 96) *(LAS u32x4*)(lds + PB_T + (r * 776 + pc * 8) * 2) = treg[k]; } }
        __syncthreads();
#pragma unroll 4
        for (int i = tid; i < 64 * 96; i += NTHREADS) { const int r = i / 96, pc = i % 96;
            const u32x4 a = *(const LAS u32x4*)(lds + PB_T + (r * 776 + pc * 8) * 2), m = *(const LAS u32x4*)(lds + PB_T + ((r + 1) * 776 + pc * 8) * 2), n = *(const LAS u32x4*)(lds + PB_T + ((r + 2) * 776 + pc * 8) * 2);
            const unsigned aw[4] = {a.x, a.y, a.z, a.w}, mw[4] = {m.x, m.y, m.z, m.w}, nw[4] = {n.x, n.y, n.z, n.w}; unsigned o[4];
            const LAS f32x4* cw4 = (const LAS f32x4*)(cwl + pc * 8);
            const f32x4 t0[2] = {cw4[0], cw4[1]}, t1[2] = {cw4[192], cw4[193]}, t2[2] = {cw4[384], cw4[385]}, tb[2] = {cw4[576], cw4[577]};
#pragma unroll
            for (int e = 0; e < 4; ++e) { const int hh = e >> 1, j = 2 * (e & 1);
                const float y0 = siluf_(t0[hh][j] * bflo(aw[e]) + t1[hh][j] * bflo(mw[e]) + t2[hh][j] * bflo(nw[e]) + tb[hh][j]);
                const float y1 = siluf_(t0[hh][j + 1] * bfhi(aw[e]) + t1[hh][j + 1] * bfhi(mw[e]) + t2[hh][j + 1] * bfhi(nw[e]) + tb[hh][j + 1]);
                o[e] = pk2(y0, y1); }
            *(u32x4*)(P0 + (row0 + r) * NP0 + C_XS + col0 + pc * 8) = (u32x4){o[0], o[1], o[2], o[3]}; }
        __syncthreads();
    }
#pragma unroll
    for (int q = 0; q < 4; ++q) { const int dh = w * 4 + q, dir = dh >> 4, h = dh & 15; const size_t row = row0 + (dir ? 63 - lane : lane);
        const float dt = softplusf_(bf2f(P0[row * NP0 + C_DT + dh]) + gmem(P.in_(I_ADTB))[dh]); float v = -dt * __expf(gmem(P.in_(I_AALOG))[dh]);
#pragma unroll
        for (int o = 1; o < 64; o <<= 1) { const float uu = __shfl(v, lane >= o ? lane - o : lane); if (lane >= o) v += uu; }
        *(f32x2*)(ssdv_row(gmem(P.ws_()), row) + dh * 2) = (f32x2){dt, v}; (void)h; }
    (void)isctx;
}
constexpr int PG_LA = 0;
constexpr int PG_PART = PG_LA + 64 * 128 * 4;
constexpr int PG_R = PG_PART + 4 * 128 * 4;
constexpr int PG_WG = PG_R + 64 * 40 * 2;
constexpr int PG_BG = PG_WG + 128 * 40 * 2;
constexpr int PG_DIR = PG_BG + 128 * 4;
static_assert(2 * PG_DIR <= PARAM_LDS_OFF && PG_DIR % 16 == 0, "prep0 GLA LDS");
__device__ __forceinline__ void prep_gla_unit(const Ctx& c, const Params& P, int b, int gch, int h) {
    LAS unsigned char* lds = c.lds; const int tid = c.tid, lane = c.lane, w = c.wave, fr = lane & 15, fq = lane >> 4, ti_ = tid >> 3, seg = tid & 7;
    bf16_t* P0 = (bf16_t*)(gmem(P.ws_()) + WS_BIG); float* GF = glaf_ptr(gmem(P.ws_()));
    const size_t row0 = chunk_row0(b, gch);
    { const bf16_t* wg0 = (const bf16_t*)(gmem(P.ws_()) + WS_GATES + 7 * MiB / 4) + (size_t)h * 128 * 32;
      int tq = tid; OPAQUE_V(tq);
#pragma unroll
      for (int dir = 0; dir < 2; ++dir)
          *(LAS u32x4*)(lds + dir * PG_DIR + PG_WG + ((tq >> 2) * 40 + (tq & 3) * 8) * 2) = *(const u32x4*)(wg0 + (size_t)dir * 4 * 128 * 32 + (tq >> 2) * 32 + (tq & 3) * 8);
      if (tid < 256) { const int dir = tid >> 7, kk = tid & 127; ((LAS float*)(lds + dir * PG_DIR + PG_BG))[kk] = gmem(P.in_(I_AGB))[dir * 512 + h * 128 + kk]; }
      { const int dir = seg >> 2, s4 = seg & 3; u32x4 v = (u32x4){0u, 0u, 0u, 0u};
        if (s4 < 2) { const size_t rr = row0 + (dir ? 63 - ti_ : ti_); v = *(const u32x4*)(P0 + rr * NP0 + C_R + dir * 16 + s4 * 8); }
        *(LAS u32x4*)(lds + dir * PG_DIR + PG_R + (ti_ * 40 + s4 * 8) * 2) = v; } }
    __syncthreads();
    { const int ti = w >> 1;
#pragma unroll
      for (int dir = 0; dir < 2; ++dir) { const int dof = dir * PG_DIR; LAS float* la = (LAS float*)(lds + dof + PG_LA); const LAS float* bgl = (const LAS float*)(lds + dof + PG_BG);
          const bf16x8 a = frag(lds, dof + PG_R, 40, ti * 16 + fr, 8 * fq);
#pragma unroll
          for (int q = 0; q < 4; ++q) { const int tk = 4 * (w & 1) + q; const bf16x8 bb = frag(lds, dof + PG_WG, 40, tk * 16 + fr, 8 * fq);
              f32x4 acc = (f32x4){0.f, 0.f, 0.f, 0.f}; acc = __builtin_amdgcn_mfma_f32_16x16x32_bf16(a, bb, acc, 0, 0, 0);
              const float bg = bgl[tk * 16 + fr];
#pragma unroll
              for (int r = 0; r < 4; ++r) la[(ti * 16 + 4 * fq + r) * 128 + tk * 16 + fr] = log_sigmoidf_(acc[r] + bg) * (1.0f / 16.0f); } } }
    __syncthreads();
    const bf16_t* prow = P0 + (row0 + ti_) * NP0;
    const u32x4 q0 = *(const u32x4*)(prow + C_Q + h * 128 + seg * 16), q1 = *(const u32x4*)(prow + C_Q + h * 128 + seg * 16 + 8);
    const u32x4 k0 = *(const u32x4*)(prow + C_K + h * 128 + seg * 16), k1 = *(const u32x4*)(prow + C_K + h * 128 + seg * 16 + 8);
    const unsigned qw[8] = {q0.x, q0.y, q0.z, q0.w, q1.x, q1.y, q1.z, q1.w}, kw[8] = {k0.x, k0.y, k0.z, k0.w, k1.x, k1.y, k1.z, k1.w};
    { const int kk = tid & 127, qd = tid >> 7;
#pragma unroll
      for (int dir = 0; dir < 2; ++dir) { LAS float* la = (LAS float*)(lds + dir * PG_DIR + PG_LA); float run = 0.f;
#pragma unroll
          for (int r = 0; r < 16; ++r) { run += la[(qd * 16 + r) * 128 + kk]; la[(qd * 16 + r) * 128 + kk] = run; }
          ((LAS float*)(lds + dir * PG_DIR + PG_PART))[qd * 128 + kk] = run; } }
    __syncthreads();
    { const int kk = tid & 127, qd = tid >> 7;
      if (qd > 0) {
#pragma unroll
          for (int dir = 0; dir < 2; ++dir) { LAS float* la = (LAS float*)(lds + dir * PG_DIR + PG_LA); const LAS float* part = (const LAS float*)(lds + dir * PG_DIR + PG_PART); float offv = 0.f;
              for (int q = 0; q < qd; ++q) offv += part[q * 128 + kk];
#pragma unroll
              for (int r = 0; r < 16; ++r) la[(qd * 16 + r) * 128 + kk] += offv; } } }
    __syncthreads();
#pragma nounroll
    for (int dir = 0; dir < 2; ++dir) { const LAS float* la = (const LAS float*)(lds + dir * PG_DIR + PG_LA);
        const int li = dir ? 63 - ti_ : ti_; unsigned qo[8], ko[8];
#pragma unroll
        for (int e = 0; e < 8; ++e) { const float g0 = la[li * 128 + seg * 16 + 2 * e], g1 = la[li * 128 + seg * 16 + 2 * e + 1]; const float e0 = __expf(g0), e1 = __expf(g1);
            qo[e] = pk2(bflo(qw[e]) * e0 * 0.08838834764831845f, bfhi(qw[e]) * e1 * 0.08838834764831845f); ko[e] = pk2(bflo(kw[e]) * __expf(-g0), bfhi(kw[e]) * __expf(-g1)); }
        bf16_t* qd_ = P0 + (row0 + ti_) * NP0 + (dir ? C_Q : 0) + h * 128 + seg * 16;
        bf16_t* kd_ = P0 + (row0 + ti_) * NP0 + (dir ? C_K : 512) + h * 128 + seg * 16;
        *(u32x4*)qd_ = (u32x4){qo[0], qo[1], qo[2], qo[3]}; *(u32x4*)(qd_ + 8) = (u32x4){qo[4], qo[5], qo[6], qo[7]};
        *(u32x4*)kd_ = (u32x4){ko[0], ko[1], ko[2], ko[3]}; *(u32x4*)(kd_ + 8) = (u32x4){ko[4], ko[5], ko[6], ko[7]}; }
    if (tid < 256) { const int dir = tid >> 7, kk = tid & 127; GF[((size_t)((b * 4 + h) * 2 + dir) * NCT + gch) * 128 + kk] = __expf(((const LAS float*)(lds + dir * PG_DIR + PG_LA))[63 * 128 + kk]); }
    __syncthreads();
}
__device__ __forceinline__ void phase_prep0b(const Ctx& c, const Params& P) {
    const int nssd = NB * NCT, nu = nssd * 5;
    unsigned* ctr = (unsigned*)(gmem(P.ws_()) + WS_CTL + 16384);
    volatile LAS unsigned* slot = (volatile LAS unsigned*)(c.lds + PARAM_LDS_OFF + 384);
    for (;;) {
        if (c.tid == 0) *slot = atomicAdd(ctr, 1u);
        __syncthreads();
        const int q = (int)__builtin_amdgcn_readfirstlane(*slot);
        __syncthreads();
        if (q >= nu) break;
        if (q < nssd) prep_ssd_unit(c, P, q / NCT, q % NCT);
        else { const int g = q - nssd, bc = g >> 2; prep_gla_unit(c, P, bc / NCT, bc % NCT, g & 3); }
    }
}

constexpr int O_Q = 0;
constexpr int O_K = O_Q + 64 * LQ * 2;
constexpr int O_V = O_K + 64 * LQ * 2;
constexpr int O_VW = O_V + 64 * LT * 2;
constexpr int O_S = O_VW + 64 * LT * 2;
constexpr int O_ST = O_S + 64 * LT * 2;
constexpr int O_OST = O_ST + 64 * LQ * 2;
constexpr int O_VEC = O_OST + 64 * 68 * 4;
constexpr int O_END = O_VEC + 320 * 4;
static_assert(O_END <= PARAM_LDS_OFF, "scan0 LDS");

template <bool SSD>
__device__ __forceinline__ void chain(const Ctx& c, const Params& P, int dir, int b, int h, int vb) {
    const int tid = c.tid, lane = c.lane, w = c.wave, fr = lane & 15, fq = lane >> 4, ti_ = tid >> 3, seg = tid & 7;
    unsigned char* wsb = gmem(P.ws_());
    const bf16_t* P0 = (const bf16_t*)(wsb + WS_BIG); const float* GF = glaf_ptr(wsb);
    bf16_t* T_lat = (bf16_t*)gmem(P.out_()); bf16_t* T_ctx = tctx_ptr(wsb);
    const int vcol = SSD ? C_XS + h * 64 : C_V + h * 256 + vb * 64, tcol = SSD ? 1024 + h * 64 : h * 256 + vb * 64, dh = dir * 16 + h;
    f32x4 st[4];
#pragma unroll
    for (int t = 0; t < 4; ++t) st[t] = (f32x4){0.f, 0.f, 0.f, 0.f};
    for (int i = tid; i < 64 * LQ / 2; i += NTHREADS) ((LAS unsigned*)(c.lds + O_ST))[i] = 0u;
    __syncthreads();
    u32x4 pa0, pa1, pb0, pb1, pvv, ptt = (u32x4){0u, 0u, 0u, 0u}; f32x2 pdg = (f32x2){0.f, 0.f}; float pgl = 0.f, pgf = 0.f;
#define SC0_GCH(ci_) (dir ? ((ci_) < NCC ? NCC - 1 - (ci_) : NCT - 1 - ((ci_) - NCC)) : (ci_))
#define SC0_PREFETCH(ci_) do { const int g_ = SC0_GCH(ci_); const size_t r0_ = chunk_row0(b, g_), row_ = r0_ + (dir ? 63 - ti_ : ti_); \
        const bf16_t* qs_ = P0 + row_ * NP0 + (SSD ? C_C + (h >> 3) * 128 : (dir ? C_Q : 0) + h * 128); \
        const bf16_t* ks_ = P0 + row_ * NP0 + (SSD ? C_B + (h >> 3) * 128 : (dir ? C_K : 512) + h * 128); \
        pa0 = *(const u32x4*)(qs_ + seg * 16); pa1 = *(const u32x4*)(qs_ + seg * 16 + 8); pb0 = *(const u32x4*)(ks_ + seg * 16); pb1 = *(const u32x4*)(ks_ + seg * 16 + 8); \
        pvv = *(const u32x4*)(P0 + row_ * NP0 + vcol + seg * 8); \
        if (SSD) { pdg = *(const f32x2*)(ssdv_row(wsb, row_) + dh * 2); pgl = ssdv_row(wsb, r0_ + (dir ? 0 : 63))[dh * 2 + 1]; } \
        else if (tid < 128) pgf = GF[((size_t)((b * 4 + h) * 2 + dir) * NCT + g_) * 128 + tid]; \
        if (dir) ptt = *(const u32x4*)((g_ < NCC ? T_ctx + (row_ - ML) * 2048 : T_lat + row_ * 2048) + tcol + seg * 8); } while (0)
    SC0_PREFETCH(0);
    for (int ci = 0; ci < NCT; ++ci) {
        LAS unsigned char* lds = c.lds; LAS float* vec = (LAS float*)(lds + O_VEC);
        const int gch = SC0_GCH(ci);
        const int isctx = gch < NCC;
        const size_t row0 = chunk_row0(b, gch), row = row0 + (dir ? 63 - ti_ : ti_);
        const u32x4 cur_t = ptt;
        { *(LAS u32x4*)(lds + O_Q + (ti_ * LQ + seg * 16) * 2) = pa0; *(LAS u32x4*)(lds + O_Q + (ti_ * LQ + seg * 16 + 8) * 2) = pa1;
          *(LAS u32x4*)(lds + O_K + (ti_ * LQ + seg * 16) * 2) = pb0; *(LAS u32x4*)(lds + O_K + (ti_ * LQ + seg * 16 + 8) * 2) = pb1;
          *(LAS u32x4*)(lds + O_V + (ti_ * LT + seg * 8) * 2) = pvv;
          if (SSD) { const float kf = pdg[0] * __expf(pgl - pdg[1]); const u32x4 vv = pvv;
              u32x4 xw; xw.x = pk2(bflo(vv.x) * kf, bfhi(vv.x) * kf); xw.y = pk2(bflo(vv.y) * kf, bfhi(vv.y) * kf); xw.z = pk2(bflo(vv.z) * kf, bfhi(vv.z) * kf); xw.w = pk2(bflo(vv.w) * kf, bfhi(vv.w) * kf);
              *(LAS u32x4*)(lds + O_VW + (ti_ * LT + seg * 8) * 2) = xw;
              if (seg == 0) { vec[128 + ti_] = pdg[1]; vec[192 + ti_] = pdg[0]; vec[256 + ti_] = __expf(pdg[1]); } }
          else if (tid < 128) vec[tid] = pgf; }
        if (ci + 1 < NCT) SC0_PREFETCH(ci + 1);
        LDS_BARRIER();
        typedef short v4i16_t __attribute__((ext_vector_type(4)));
#define SC0_TR(p_, off_, ld_) ({ const v4i16_t t0_ = __builtin_amdgcn_ds_read_tr16_b64_v4i16((LAS v4i16_t*)((p_) + (off_))), t1_ = __builtin_amdgcn_ds_read_tr16_b64_v4i16((LAS v4i16_t*)((p_) + (off_) + 4 * (ld_) * 2)); \
        (bf16x8){t0_[0], t0_[1], t0_[2], t0_[3], t1_[0], t1_[1], t1_[2], t1_[3]}; })
        const int ti = w >> 1, hb = w & 1;
        bf16x8 qa[4];
        { bf16x8 kf[2][4];
          const LAS unsigned char* pq = lds + O_Q + ((ti * 16 + fr) * LQ + 8 * fq) * 2; const LAS unsigned char* pk = lds + O_K + ((hb * 32 + fr) * LQ + 8 * fq) * 2;
#pragma unroll
          for (int kq = 0; kq < 4; ++kq) qa[kq] = *(const LAS bf16x8*)(pq + kq * 64);
#pragma unroll
          for (int q = 0; q < 2; ++q)
#pragma unroll
              for (int kq = 0; kq < 4; ++kq) kf[q][kq] = *(const LAS bf16x8*)(pk + q * 16 * LQ * 2 + kq * 64);
          SCHED_FENCE();
#pragma unroll
          for (int q = 0; q < 2; ++q) { const int tj = 2 * hb + q; f32x4 acc = (f32x4){0.f, 0.f, 0.f, 0.f};
              if (tj <= ti) {
#pragma unroll
                  for (int kq = 0; kq < 4; ++kq) acc = __builtin_amdgcn_mfma_f32_16x16x32_bf16(kf[q][kq], qa[kq], acc, 0, 0, 0); }
              const int i = ti * 16 + fr; float s4[4];
#pragma unroll
              for (int r = 0; r < 4; ++r) { const int j = tj * 16 + 4 * fq + r; float s = (j <= i) ? acc[r] : 0.f;
                  if (SSD) s *= vec[192 + j] * __expf(fminf(vec[128 + i] - vec[128 + j], 0.f));
                  s4[r] = s; }
              *(LAS u32x2*)(lds + O_S + (i * LT + tj * 16 + 4 * fq) * 2) = (u32x2){pk2(s4[0], s4[1]), pk2(s4[2], s4[3])}; } }
        LDS_BARRIER();
        f32x4 U[4];
        { bf16x8 sa[2], vt[2][2], stf[2][4], ka[2], vu[4][2];
          const LAS unsigned char* ps = lds + O_S + ((ti * 16 + fr) * LT + 8 * fq) * 2;
          const LAS unsigned char* pvt = lds + O_V + ((8 * fq + (fr >> 2)) * LT + hb * 32 + 4 * (fr & 3)) * 2;
          const LAS unsigned char* pst = lds + O_ST + ((hb * 32 + fr) * LQ + 8 * fq) * 2;
          const LAS unsigned char* pkt = lds + O_K + ((8 * fq + (fr >> 2)) * LQ + w * 16 + 4 * (fr & 3)) * 2;
          const LAS unsigned char* pvu = lds + (SSD ? O_VW : O_V) + ((8 * fq + (fr >> 2)) * LT + 4 * (fr & 3)) * 2;
#pragma unroll
          for (int kq = 0; kq < 2; ++kq) sa[kq] = *(const LAS bf16x8*)(ps + kq * 64);
#pragma unroll
          for (int q = 0; q < 2; ++q) {
#pragma unroll
              for (int kq = 0; kq < 2; ++kq) vt[q][kq] = SC0_TR(pvt, kq * 32 * LT * 2 + q * 32, LT);
#pragma unroll
              for (int kq = 0; kq < 4; ++kq) stf[q][kq] = *(const LAS bf16x8*)(pst + q * 16 * LQ * 2 + kq * 64); }
#pragma unroll
          for (int kq = 0; kq < 2; ++kq) ka[kq] = SC0_TR(pkt, kq * 32 * LQ * 2, LQ);
#pragma unroll
          for (int t = 0; t < 4; ++t)
#pragma unroll
              for (int kq = 0; kq < 2; ++kq) vu[t][kq] = SC0_TR(pvu, kq * 32 * LT * 2 + t * 32, LT);
          SCHED_FENCE();
          LAS float* ost = (LAS float*)(lds + O_OST);
#pragma unroll
          for (int q = 0; q < 2; ++q) { const int tv = 2 * hb + q; f32x4 a1 = (f32x4){0.f, 0.f, 0.f, 0.f}, a2 = (f32x4){0.f, 0.f, 0.f, 0.f};
#pragma unroll
              for (int kq = 0; kq < 2; ++kq) a1 = __builtin_amdgcn_mfma_f32_16x16x32_bf16(sa[kq], vt[q][kq], a1, 0, 0, 0);
#pragma unroll
              for (int kq = 0; kq < 4; ++kq) a2 = __builtin_amdgcn_mfma_f32_16x16x32_bf16(qa[kq], stf[q][kq], a2, 0, 0, 0);
#pragma unroll
              for (int r = 0; r < 4; ++r) { const int i = ti * 16 + 4 * fq + r; ost[i * 68 + tv * 16 + fr] = a1[r] + (SSD ? vec[256 + i] : 1.f) * a2[r]; } }
#pragma unroll
          for (int t = 0; t < 4; ++t) { f32x4 u = (f32x4){0.f, 0.f, 0.f, 0.f};
#pragma unroll
              for (int kq = 0; kq < 2; ++kq) u = __builtin_amdgcn_mfma_f32_16x16x32_bf16(ka[kq], vu[t][kq], u, 0, 0, 0);
              U[t] = u; } }
#undef SC0_TR
        float fk[4];
#pragma unroll
        for (int r = 0; r < 4; ++r) fk[r] = SSD ? vec[256 + 63] : vec[w * 16 + 4 * fq + r];
        LDS_BARRIER();
#pragma unroll
        for (int t = 0; t < 4; ++t) {
#pragma unroll
            for (int r = 0; r < 4; ++r) st[t][r] = SSD ? fk[r] * st[t][r] + U[t][r] : fk[r] * (st[t][r] + U[t][r]);
            *(LAS u32x2*)(lds + O_ST + ((t * 16 + fr) * LQ + w * 16 + 4 * fq) * 2) = (u32x2){pk2(st[t][0], st[t][1]), pk2(st[t][2], st[t][3])}; }
        { bf16_t* T = isctx ? T_ctx + (row - ML) * 2048 : T_lat + row * 2048; bf16_t* tp = T + tcol + seg * 8;
          const LAS float* ost = (const LAS float*)(lds + O_OST) + ti_ * 68 + seg * 8; float o[8];
#pragma unroll
          for (int e = 0; e < 8; ++e) o[e] = ost[e];
          if (dir) { const u32x4 pv = cur_t; o[0] += bflo(pv.x); o[1] += bfhi(pv.x); o[2] += bflo(pv.y); o[3] += bfhi(pv.y); o[4] += bflo(pv.z); o[5] += bfhi(pv.z); o[6] += bflo(pv.w); o[7] += bfhi(pv.w); }
          *(u32x4*)tp = (u32x4){pk2(o[0], o[1]), pk2(o[2], o[3]), pk2(o[4], o[5]), pk2(o[6], o[7])}; }
    }
    __syncthreads();
#undef SC0_GCH
#undef SC0_PREFETCH
}
}

__device__ __forceinline__ void phase_scan0(const Ctx& c, const Params& P, int dir, int nblk) {
    const int nitems = NB * 32;
    for (int it = c.bid; it < nitems; it += nblk) {
        const int b = it / 32, r = it % 32;
        if (r < 16) sc0::chain<false>(c, P, dir, b, r >> 2, r & 3);
        else sc0::chain<true>(c, P, dir, b, r - 16, 0);
        __syncthreads();
    }
}

__device__ __forceinline__ void phase_post0(const Ctx& c, const Params& P) {
    bf16_t* P0 = (bf16_t*)(gmem(P.ws_()) + WS_BIG);
    const bf16_t* T_lat = (const bf16_t*)gmem(P.out_()); const bf16_t* T_ctx = sc0::tctx_ptr(gmem(P.ws_()));
    const int gw = c.bid * NWAVES + c.wave, NGW = c.G * NWAVES, lane = c.lane;
    const float* gn = gmem(P.in_(I_AGN)); const float* sn = gmem(P.in_(I_ASN));
    const float dsk = gmem(P.in_(I_AD))[lane >> 2];
    f32x4 gnv[4], snv[4];
#pragma unroll
    for (int q = 0; q < 4; ++q) { gnv[q] = *(const f32x4*)(gn + ((16 * lane) & 255) + 4 * q); snv[q] = *(const f32x4*)(sn + 16 * lane + 4 * q); }
    for (int row = gw; row < MT; row += NGW) {
        const bool isctx = row >= ML;
        const bf16_t* T = isctx ? T_ctx + (size_t)(row - ML) * 2048 : T_lat + (size_t)row * 2048;
        bf16_t* pr = P0 + (size_t)row * NP0;
        {   const u32x4 t0 = *(const u32x4*)(T + 16 * lane), t1 = *(const u32x4*)(T + 16 * lane + 8);
            const u32x4 g0 = *(const u32x4*)(pr + C_G + 16 * lane), g1 = *(const u32x4*)(pr + C_G + 16 * lane + 8);
            const unsigned tw[8] = {t0.x, t0.y, t0.z, t0.w, t1.x, t1.y, t1.z, t1.w}, gq[8] = {g0.x, g0.y, g0.z, g0.w, g1.x, g1.y, g1.z, g1.w};
            float tv[16], ss = 0.f;
#pragma unroll
            for (int e = 0; e < 8; ++e) { tv[2 * e] = bflo(tw[e]); tv[2 * e + 1] = bfhi(tw[e]); ss += tv[2 * e] * tv[2 * e] + tv[2 * e + 1] * tv[2 * e + 1]; }
            ss += __shfl_xor(ss, 1); ss += __shfl_xor(ss, 2); ss += __shfl_xor(ss, 4); ss += __shfl_xor(ss, 8);
            const float rs = 1.0f / sqrtf(ss * (1.0f / 256.0f) + EPS);
            unsigned o[8];
#pragma unroll
            for (int e = 0; e < 8; ++e) o[e] = pk2(tv[2 * e] * rs * gnv[e >> 1][2 * (e & 1)] * siluf_(bflo(gq[e])), tv[2 * e + 1] * rs * gnv[e >> 1][2 * (e & 1) + 1] * siluf_(bfhi(gq[e])));
            *(u32x4*)(pr + C_G + 16 * lane) = (u32x4){o[0], o[1], o[2], o[3]}; *(u32x4*)(pr + C_G + 16 * lane + 8) = (u32x4){o[4], o[5], o[6], o[7]}; }
        {   const u32x4 t0 = *(const u32x4*)(T + 1024 + 16 * lane), t1 = *(const u32x4*)(T + 1024 + 16 * lane + 8);
            const u32x4 z0 = *(const u32x4*)(pr + C_Z + 16 * lane), z1 = *(const u32x4*)(pr + C_Z + 16 * lane + 8);
            const u32x4 b0 = *(const u32x4*)(pr + C_XS + 16 * lane), b1 = *(const u32x4*)(pr + C_XS + 16 * lane + 8);
            const unsigned tw[8] = {t0.x, t0.y, t0.z, t0.w, t1.x, t1.y, t1.z, t1.w}, zq[8] = {z0.x, z0.y, z0.z, z0.w, z1.x, z1.y, z1.z, z1.w};
            const unsigned a_[8] = {b0.x, b0.y, b0.z, b0.w, b1.x, b1.y, b1.z, b1.w};
            float y[16], ss = 0.f;
#pragma unroll
            for (int e = 0; e < 16; ++e) { const int wi = e >> 1; const bool hi = e & 1;
                const float xs = hi ? bfhi(a_[wi]) : bflo(a_[wi]);
                const float tvv = hi ? bfhi(tw[wi]) : bflo(tw[wi]), zv = hi ? bfhi(zq[wi]) : bflo(zq[wi]);
                y[e] = (tvv + xs * dsk) * siluf_(zv); ss += y[e] * y[e]; }
            ss += __shfl_xor(ss, 1); ss += __shfl_xor(ss, 2); ss += __shfl_xor(ss, 4); ss += __shfl_xor(ss, 8); ss += __shfl_xor(ss, 16);
            const float rs = 1.0f / sqrtf(ss * (1.0f / 512.0f) + EPS);
            unsigned o[8];
#pragma unroll
            for (int e = 0; e < 8; ++e) o[e] = pk2(y[2 * e] * rs * snv[e >> 1][2 * (e & 1)], y[2 * e + 1] * rs * snv[e >> 1][2 * (e & 1) + 1]);
            *(u32x4*)(pr + C_Z + 16 * lane) = (u32x4){o[0], o[1], o[2], o[3]}; *(u32x4*)(pr + C_Z + 16 * lane + 8) = (u32x4){o[4], o[5], o[6], o[7]}; }
    }
}

__device__ __forceinline__ int row_of(int isctx, int b, int p) { return isctx ? ML + b * CTX + p : b * SEQ + (p % GROWS) * GW + p / GROWS; }

__device__ __forceinline__ void build_gate_weights(const Ctx& c, const Params& P, bf16_t* WG) {
    const float* wq = gmem(P.in_(I_BWQ)); const float* wk = gmem(P.in_(I_BWK)); const float* wv = gmem(P.in_(I_BWV)); const float* wif = gmem(P.in_(I_BWIF));
    for (int idx = c.bid * NTHREADS + c.tid; idx < 256 * 4096; idx += c.G * NTHREADS) {
        const int g = idx >> 12, cc = idx & 4095; float v = 0.f;
        if (g < 16) { const int dir = g >> 3, gi = g & 7; const float* wd = wif + (size_t)dir * 6144 * 8;
            if (cc < 2048) { const int n = cc >> 2, dp = cc & 3;
#pragma unroll
                for (int e = 0; e < 4; ++e) v += wv[n * 16 + dp * 4 + e] * wd[(size_t)(4096 + 4 * n + e) * 8 + gi]; }
            else { const int c2 = cc - 2048, n = c2 >> 2, dp = c2 & 3;
#pragma unroll
                for (int e = 0; e < 4; ++e) v += wq[n * 16 + dp * 4 + e] * wd[(size_t)(4 * n + e) * 8 + gi] + wk[n * 16 + dp * 4 + e] * wd[(size_t)(2048 + 4 * n + e) * 8 + gi]; } }
        WG[idx] = (bf16_t)f2bf(v);
    }
}
__device__ __forceinline__ void build_mblocks(const Ctx& c, const Params& P, float* MB) {
    const float* wq = gmem(P.in_(I_BWQ)); const float* wk = gmem(P.in_(I_BWK));
    for (int idx = c.bid * NTHREADS + c.tid; idx < 512 * 16; idx += c.G * NTHREADS) { const int n = idx >> 4, dp = (idx >> 2) & 3, e = idx & 3; float v = 0.f;
#pragma unroll
        for (int x = 0; x < 4; ++x) v += wq[n * 16 + dp * 4 + x] * wk[n * 16 + e * 4 + x];
        MB[idx] = v * 0.04419417382415922f; }
}
constexpr int GATE_NSL = 3;
__device__ __forceinline__ float* gates_ptr(unsigned char* ws) { return (float*)(ws + WS_H + 26 * MiB); }
static_assert(26 * MiB + (size_t)GATE_NSL * MT * 64 <= 34 * MiB, "gate partial slabs");
struct EpiGates {
    static constexpr bool PERM = false;
    float* G;
    __device__ __forceinline__ void operator()(const f32x4 (&acc)[2][2][4][2], const pg8::Unit& u, int wr, int wc, int fr, int fq) const {
        if (wc != 0 || u.pn != 0) return;
        float* Gs = G + (size_t)(u.sl < 0 ? 0 : u.sl) * MT * 16;
#pragma unroll
        for (int ai = 0; ai < 2; ++ai)
#pragma unroll
            for (int m = 0; m < 4; ++m) { const int row = u.pm * 256 + ai * 128 + wr * 64 + m * 16 + fr; *(f32x4*)(Gs + (size_t)row * 16 + 4 * fq) = acc[ai][0][m][0]; }
    }
};
__device__ __forceinline__ void phase_prep1(const Ctx& c, const Params& P) {
    bf16_t* XMC = (bf16_t*)(gmem(P.ws_()) + WS_BIG);
    const float* cw = gmem(P.in_(I_BCW)); const float* cb = gmem(P.in_(I_BCB));
    const int gw = c.bid * NWAVES + c.wave, NGW = c.G * NWAVES, lane = c.lane;
    f32x4 w0[8], w1[8], w2[8], wb[8];
#pragma unroll
    for (int q = 0; q < 8; ++q) { w0[q] = *(const f32x4*)(cw + 32 * lane + 4 * q); w1[q] = *(const f32x4*)(cw + 2048 + 32 * lane + 4 * q); w2[q] = *(const f32x4*)(cw + 4096 + 32 * lane + 4 * q); wb[q] = *(const f32x4*)(cb + 32 * lane + 4 * q); }
    constexpr int RPW_DEN = 1;
    const int rpw = (MT + NGW - 1) / NGW, s0 = gw * rpw, s1 = (s0 + rpw < MT) ? s0 + rpw : MT; (void)RPW_DEN;
    auto rowof = [](int s_, int& row_, bool& first_, bool& last_) { if (s_ < ML) { const int b = s_ / SEQ, p = s_ % SEQ; row_ = b * SEQ + (p % GROWS) * GW + p / GROWS; first_ = p == 0; last_ = p == SEQ - 1; }
                                                                  else { const int p = (s_ - ML) % CTX; row_ = s_; first_ = p == 0; last_ = p == CTX - 1; } };
    u32x4 pv[4], cv[4], nv[4];
    if (s0 < s1) { int r0, rm; bool f0, l0, fm, lm; rowof(s0, r0, f0, l0);
#pragma unroll
        for (int q = 0; q < 4; ++q) cv[q] = *(const u32x4*)(XMC + (size_t)r0 * 4096 + 32 * lane + 8 * q);
        if (!f0) { rowof(s0 - 1, rm, fm, lm);
#pragma unroll
            for (int q = 0; q < 4; ++q) pv[q] = *(const u32x4*)(XMC + (size_t)rm * 4096 + 32 * lane + 8 * q); }
        else {
#pragma unroll
            for (int q = 0; q < 4; ++q) pv[q] = (u32x4){0u, 0u, 0u, 0u}; } }
    for (int sidx = s0; sidx < s1; ++sidx) {
        int row, rn; bool first, last, fn_, ln_; rowof(sidx, row, first, last);
        if (!last) { rowof(sidx + 1, rn, fn_, ln_);
#pragma unroll
            for (int q = 0; q < 4; ++q) nv[q] = *(const u32x4*)(XMC + (size_t)rn * 4096 + 32 * lane + 8 * q); }
        else {
#pragma unroll
            for (int q = 0; q < 4; ++q) nv[q] = (u32x4){0u, 0u, 0u, 0u}; }
#pragma unroll
        for (int q = 0; q < 4; ++q) { const int ch = 32 * lane + 8 * q;
            const unsigned aw[4] = {pv[q].x, pv[q].y, pv[q].z, pv[q].w}, bw[4] = {cv[q].x, cv[q].y, cv[q].z, cv[q].w}, dw[4] = {nv[q].x, nv[q].y, nv[q].z, nv[q].w}; unsigned o[4];
#pragma unroll
            for (int e = 0; e < 4; ++e) { const int qq = 2 * q + (e >> 1), j = 2 * (e & 1);
                const float y0 = siluf_(w0[qq][j] * bflo(aw[e]) + w1[qq][j] * bflo(bw[e]) + w2[qq][j] * bflo(dw[e]) + wb[qq][j]);
                const float y1 = siluf_(w0[qq][j + 1] * bfhi(aw[e]) + w1[qq][j + 1] * bfhi(bw[e]) + w2[qq][j + 1] * bfhi(dw[e]) + wb[qq][j + 1]);
                o[e] = pk2(y0, y1); }
            *(u32x4*)(XMC + (size_t)row * 4096 + 2048 + ch) = (u32x4){o[0], o[1], o[2], o[3]}; }
#pragma unroll
        for (int q = 0; q < 4; ++q) { pv[q] = last ? (u32x4){0u, 0u, 0u, 0u} : cv[q]; cv[q] = nv[q]; }
        if (last && sidx + 1 < s1) { int r1; bool f1, l1; rowof(sidx + 1, r1, f1, l1);
#pragma unroll
            for (int q = 0; q < 4; ++q) cv[q] = *(const u32x4*)(XMC + (size_t)r1 * 4096 + 32 * lane + 8 * q); }
    }
}

namespace sc1 {
constexpr int EB = 32, LX = 520, LV = 48, LS = 72, NCL = SEQ / 64, NCC = CTX / 64, NCT = NCC + NCL, ET = 48;
constexpr int O_XC = 0;
constexpr int O_CT = O_XC + 64 * LX * 2;
constexpr int O_OST = O_CT + 33 * LX * 2;
constexpr int O_V = O_OST + 2 * 64 * 34 * 4;
constexpr int O_VW = O_V + 64 * LV * 2;
constexpr int O_S = O_VW + 64 * LV * 2;
constexpr int O_M = O_S + 64 * LS * 2;
constexpr int O_VEC = O_M + 128 * 16 * 2;
constexpr int O_DUMP = O_VEC + 256 * 4;
constexpr int O_END = O_DUMP + 512;
constexpr int IPD = 2;
constexpr int SC_M = O_XC + 2 * 64 * LX * 2;
static_assert(O_END <= PARAM_LDS_OFF && SC_M + 128 * 16 * 4 <= PARAM_LDS_OFF && O_CT + ET * LX * 2 <= O_V && O_V % 16 == 0, "scan1 LDS");
__device__ __forceinline__ bf16_t* sraw_ptr(unsigned char* ws) { return (bf16_t*)(ws + WS_H); }
__device__ __forceinline__ bf16_t* sdec_ptr(unsigned char* ws) { return (bf16_t*)(ws + WS_H) + (size_t)NB * 4 * NCL * 4096; }
__device__ __forceinline__ float* gv_ptr(unsigned char* ws) { return (float*)(ws + WS_WA + 8 * MiB); }
static_assert((size_t)NB * 4 * NCL * 4096 * 2 * 3 <= 26 * MiB && (size_t)NB * 4 * NCL * 4096 * 2 * 3 <= (size_t)MT * D * 2 && (size_t)NB * 8 * NCT * 384 * 4 <= 4 * MiB, "layer-1 scan scratch");
__device__ __forceinline__ bf16x8 frag(const LAS unsigned char* lds, int off, int ld, int row, int k) { return *(const LAS bf16x8*)(lds + off + (row * ld + k) * 2); }
__device__ __forceinline__ bf16x8 tr_frag(const LAS unsigned char* lds, int off, int ld, int k0, int n0, int fr, int fq) {
    typedef short v4i16_t __attribute__((ext_vector_type(4)));
    const LAS unsigned char* p0 = lds + off + ((k0 + 8 * fq + (fr >> 2)) * ld + n0 + 4 * (fr & 3)) * 2;
    const v4i16_t a = __builtin_amdgcn_ds_read_tr16_b64_v4i16((LAS v4i16_t*)p0), b = __builtin_amdgcn_ds_read_tr16_b64_v4i16((LAS v4i16_t*)(p0 + 4 * ld * 2));
    return (bf16x8){a[0], a[1], a[2], a[3], b[0], b[1], b[2], b[3]};
}
static_assert(64 % GROWS == 0, "a 64-token chunk covers whole grid columns");
__device__ __forceinline__ int chunk_rb(int isctx, int b, int ch) { return isctx ? ML + b * CTX + ch * 64 : b * SEQ + ch * (64 / GROWS); }
__device__ __forceinline__ int lat_off(int ip) { return (ip % GROWS) * GW + ip / GROWS; }
template <int R0 = 0, int R1 = 8>
__device__ __forceinline__ void stage_xc(const Ctx& c, LAS unsigned char* lds, const bf16_t* XMC, int isctx, int b, int ch, int h, int dir) {
    const bf16_t* base = XMC + (size_t)chunk_rb(isctx, b, ch) * 4096 + 2048 + h * 512 + c.lane * 8;
#pragma unroll
    for (int r = R0; r < R1; ++r) { const int i = 8 * c.wave + r, ip = dir ? 63 - i : i; const int off = (isctx ? ip : lat_off(ip)) * 4096;
        __builtin_amdgcn_global_load_lds((const unsigned*)(base + off), (LAS unsigned*)(lds + O_XC + i * LX * 2), 16, 0, 0); }
}
__device__ __forceinline__ void score_unit(const Ctx& c, const Params& P, int b, int h, int ch, bf16_t* SB) {
    LAS unsigned char* lds = c.lds; const int tid = c.tid, lane = c.lane, w = c.wave, fr = lane & 15, fq = lane >> 4, ti_ = tid >> 3, seg = tid & 7;
    const bf16_t* XMC = (const bf16_t*)(gmem(P.ws_()) + WS_BIG);
    const float* MB = (const float*)(gmem(P.ws_()) + WS_GATES + 3 * MiB / 2) + (size_t)h * 128 * 16;
    stage_xc(c, lds, XMC, 0, b, ch, h, 0);
    LAS float* ml = (LAS float*)(lds + SC_M);
    for (int i = tid; i < 128 * 16; i += NTHREADS) ml[i] = MB[i];
    ASM_VMCNT(0); __syncthreads();
    { const int tt = w >> 1; const f32x4 zero4 = {0.f, 0.f, 0.f, 0.f};
#pragma unroll 2
      for (int wi = 0; wi < 8; ++wi) { const int win = 8 * (w & 1) + wi; const bf16x8 xb = frag(lds, O_XC, LX, tt * 16 + fr, win * 32 + 8 * fq);
#pragma unroll
          for (int half = 0; half < 2; ++half) {
              const LAS float* mb = ml + (win * 8 + half * 4 + (fr >> 2)) * 16 + (fr & 3);
              const unsigned m01 = pk2(mb[0], mb[4]), m23 = pk2(mb[8], mb[12]); const bool on = fq == half * 2 + (fr >> 3); const bool hi4 = (fr >> 2) & 1;
              const bf16x8 ma = __builtin_bit_cast(bf16x8, (u32x4){on && !hi4 ? m01 : 0u, on && !hi4 ? m23 : 0u, on && hi4 ? m01 : 0u, on && hi4 ? m23 : 0u});
              const f32x4 pt = __builtin_amdgcn_mfma_f32_16x16x32_bf16(ma, xb, zero4, 0, 0, 0);
              *(LAS u32x2*)(lds + O_CT + ((tt * 16 + fr) * LX + (2 * win + half) * 16 + 4 * fq) * 2) = (u32x2){pk2(pt[0], pt[1]), pk2(pt[2], pt[3])}; } } }
    __syncthreads();
    { const int ti = w >> 1; f32x4 acc[2] = {(f32x4){0.f, 0.f, 0.f, 0.f}, (f32x4){0.f, 0.f, 0.f, 0.f}};
#pragma unroll 4
      for (int kq = 0; kq < 16; ++kq) { const bf16x8 pb = frag(lds, O_CT, LX, ti * 16 + fr, kq * 32 + 8 * fq);
#pragma unroll
          for (int q = 0; q < 2; ++q) acc[q] = __builtin_amdgcn_mfma_f32_16x16x32_bf16(frag(lds, O_XC, LX, (2 * (w & 1) + q) * 16 + fr, kq * 32 + 8 * fq), pb, acc[q], 0, 0, 0); }
#pragma unroll
      for (int q = 0; q < 2; ++q) { const int j0 = (2 * (w & 1) + q) * 16 + 4 * fq, i = ti * 16 + fr;
          *(u32x2*)(SB + (size_t)i * 64 + j0) = (u32x2){pk2(acc[q][0], acc[q][1]), pk2(acc[q][2], acc[q][3])}; } }
    __syncthreads();
}
__device__ __forceinline__ void gv_chain(const Ctx& c, const Params& P, int chain) {
    const int b = chain >> 3, h = (chain >> 1) & 3, dir = chain & 1, lane = c.lane, w = c.wave;
    const float* GT = gates_ptr(gmem(P.ws_())); float* GV = gv_ptr(gmem(P.ws_())) + (size_t)chain * NCT * 384;
    const float bi = gmem(P.in_(I_BBIF))[dir * 8 + h], bf = gmem(P.in_(I_BBIF))[dir * 8 + 4 + h];
    LAS float* cm = (LAS float*)c.lds;
    constexpr int NPW = (NCT + NWAVES - 1) / NWAVES;
    float bcr[NPW], ar[NPW], pmr[NPW], igr[NPW];
#pragma unroll
    for (int k = 0; k < NPW; ++k) { const int ci = w + k * NWAVES;
        bcr[k] = 0.f; ar[k] = 0.f; pmr[k] = 0.f; igr[k] = 0.f;
        if (ci < NCT) {
            const int isctx = ci < NCC; const int ch = isctx ? (dir ? NCC - 1 - ci : ci) : (dir ? NCT - 1 - ci : ci - NCC);
            const int rl = row_of(isctx, b, ch * 64 + (dir ? 63 - lane : lane));
            float ig = bi, fg = bf;
#pragma unroll
            for (int sl = 0; sl < GATE_NSL; ++sl) { const float* gr = GT + ((size_t)sl * MT + rl) * 16 + dir * 8 + h; ig += gr[0]; fg += gr[4]; }
            float bc = log_sigmoidf_(fg);
#pragma unroll
            for (int o = 1; o < 64; o <<= 1) { const float u = __shfl(bc, lane >= o ? lane - o : lane); if (lane >= o) bc += u; }
            const float a = ig - bc; float pm = a;
#pragma unroll
            for (int o = 1; o < 64; o <<= 1) { const float u = __shfl(pm, lane >= o ? lane - o : lane); if (lane >= o) pm = fmaxf(pm, u); }
            bcr[k] = bc; ar[k] = a; pmr[k] = pm; igr[k] = ig;
            if (lane == 63) { cm[2 * ci] = pm; cm[2 * ci + 1] = bc; } } }
    __syncthreads();
    if (c.tid == 0) { float m0 = -1e30f;
        for (int ci = 0; ci < NCT; ++ci) { const float pm63 = cm[2 * ci], b63 = cm[2 * ci + 1]; const float mn = b63 + fmaxf(m0, pm63); cm[2 * ci] = m0; cm[2 * ci + 1] = mn; m0 = mn; } }
    __syncthreads();
#pragma unroll
    for (int k = 0; k < NPW; ++k) { const int ci = w + k * NWAVES;
        if (ci < NCT) {
            const int isctx = ci < NCC; const int ch = isctx ? (dir ? NCC - 1 - ci : ci) : (dir ? NCT - 1 - ci : ci - NCC); const int gch = isctx ? ch : NCC + ch;
            const float m0 = cm[2 * ci], mnew = cm[2 * ci + 1], bc = bcr[k], a = ar[k], ig = igr[k];
            const float mrow = bc + fmaxf(m0, pmr[k]); const float b63 = __shfl(bc, 63);
            float* g = GV + (size_t)gch * 384;
            g[lane] = bc - mrow; g[64 + lane] = a; g[128 + lane] = __expf(bc + m0 - mrow); g[192 + lane] = __expf(b63 - bc + ig - mnew); g[256 + lane] = __expf(-mrow);
            g[320 + lane] = __expf(b63 + m0 - mnew); } }
    __syncthreads();
}
__device__ __forceinline__ void phase_score1(const Ctx& c, const Params& P) {
    bf16_t* SB = sraw_ptr(gmem(P.ws_()));
    const bool split = c.G > 64; const int nsb = split ? c.G - 32 : c.G;
    if (!split || c.bid < nsb)
        for (int u = c.bid; u < NB * 4 * NCL; u += nsb) { const int b = u / (4 * NCL), h = (u / NCL) % 4, ch = u % NCL; score_unit(c, P, b, h, ch, SB + (size_t)u * 4096); }
    if (split) { if (c.bid >= nsb) for (int ch = c.bid - nsb; ch < NB * 8; ch += 32) gv_chain(c, P, ch); }
    else for (int ch = c.bid; ch < NB * 8; ch += c.G) gv_chain(c, P, ch);
}
__device__ __forceinline__ void phase_score2(const Ctx& c, const Params& P) {
    const bf16_t* SB = sraw_ptr(gmem(P.ws_())); bf16_t* SD = sdec_ptr(gmem(P.ws_())); const float* GV = gv_ptr(gmem(P.ws_()));
    const int ti_ = c.tid >> 3, seg = c.tid & 7;
    for (int u = c.bid; u < NB * 8 * NCL; u += c.G) { const int chain = u / NCL, ch = u % NCL, dir = chain & 1;
        const bf16_t* sb = SB + (size_t)((chain >> 1) * NCL + ch) * 4096; const float* g = GV + ((size_t)chain * NCT + NCC + ch) * 384;
        const u32x4 sv = dir ? *(const u32x4*)(sb + (63 - ti_) * 64 + 56 - 8 * seg) : *(const u32x4*)(sb + ti_ * 64 + 8 * seg);
        const float ui = g[ti_]; const f32x4 a0 = *(const f32x4*)(g + 64 + 8 * seg), a1 = *(const f32x4*)(g + 64 + 8 * seg + 4);
        const unsigned sw[4] = {sv.x, sv.y, sv.z, sv.w}; float s8[8];
#pragma unroll
        for (int e = 0; e < 8; ++e) { const int fe = dir ? 7 - e : e; const float raw = (fe & 1) ? bfhi(sw[fe >> 1]) : bflo(sw[fe >> 1]); const int j = 8 * seg + e;
            s8[e] = (j <= ti_) ? raw * __expf(fminf(ui + (e < 4 ? a0[e] : a1[e - 4]), 0.f)) : 0.f; }
        *(u32x4*)(SD + (size_t)u * 4096 + ti_ * 64 + 8 * seg) = (u32x4){pk2(s8[0], s8[1]), pk2(s8[2], s8[3]), pk2(s8[4], s8[5]), pk2(s8[6], s8[7])}; }
}

__device__ __forceinline__ void chain(const Ctx& c, const Params& P, int dir, int b, int h, int eb) {
    const int tid = c.tid, lane = c.lane, w = c.wave, fr = lane & 15, fq = lane >> 4;
    unsigned char* wsg = gmem(P.ws_());
    const bf16_t* XMC = (const bf16_t*)(wsg + WS_BIG);
    bf16_t* O = (bf16_t*)(wsg + WS_BIG + (size_t)MT * 4096 * 2);
    const int chainid = (b * 4 + h) * 2 + dir;
    const bf16_t* SD = sdec_ptr(wsg) + (size_t)chainid * NCL * 4096; const float* GV = gv_ptr(wsg) + (size_t)chainid * NCT * 384;
    const int ti_ = tid >> 3, seg = tid & 7;
    const int ip_ = dir ? 63 - ti_ : ti_, roff_l = lat_off(ip_);
    { LAS unsigned char* lds = c.lds; LAS bf16_t* ml = (LAS bf16_t*)(lds + O_M); const float* MB = (const float*)(P.ws_() + WS_GATES + 3 * MiB / 2) + (size_t)h * 128 * 16;
      for (int i = tid; i < 128 * 16; i += NTHREADS) ml[i] = (bf16_t)f2bf(MB[i]);
      for (int i = tid; i < 33 * LX / 2; i += NTHREADS) ((LAS unsigned*)(lds + O_CT))[i] = 0u;
    }
    f32x4 cst[12];
#pragma unroll
    for (int t = 0; t < 12; ++t) cst[t] = (f32x4){0.f, 0.f, 0.f, 0.f};
    __syncthreads();
    const int ti = w >> 1, te = w & 1;
#define SC1_CHUNK(ci_, isctx_, ch_) const int isctx_ = (ci_) < NCC; const int ch_ = isctx_ ? (dir ? NCC - 1 - (ci_) : (ci_)) : (dir ? NCT - 1 - (ci_) : (ci_) - NCC);
    u32x4 pf_s = (u32x4){0u, 0u, 0u, 0u}, pf_v = pf_s, pf_o = pf_s; float pf_g = 0.f, pf_wk = 0.f;
#define SC1_PREFETCH(ci_) do { SC1_CHUNK(ci_, ic_, ch_) const int row_ = chunk_rb(ic_, b, ch_) + (ic_ ? ip_ : roff_l); const float* g_ = GV + (size_t)(ic_ ? ch_ : NCC + ch_) * 384; \
        stage_xc<0, 8>(c, c.lds, XMC, ic_, b, ch_, h, dir); \
        if (seg < 4) pf_v = *(const u32x4*)(XMC + (size_t)row_ * 4096 + h * 512 + eb * EB + seg * 8); \
        if (!ic_) { pf_s = *(const u32x4*)(SD + (size_t)ch_ * 4096 + ti_ * 64 + 8 * seg); \
            if (dir && seg < 4) pf_o = *(const u32x4*)(O + (size_t)row_ * 2048 + h * 512 + eb * EB + seg * 8); } \
        pf_wk = g_[192 + ti_]; if (tid < 193) pf_g = g_[tid < 192 ? 128 + tid : 320]; } while (0)
#define SC1_ROWS() do { if (lat_p && seg < 4) { \
            const LAS float* ost = (const LAS float*)(c.lds + O_OST) + ti_ * 34; const LAS float* ost2 = ost + 64 * 34; \
            const float rdn = 1.0f / fmaxf(fabsf(ost[32] + ost2[32]), emr_p); float o[8]; \
            _Pragma("unroll") for (int e = 0; e < 8; ++e) o[e] = (ost[seg * 8 + e] + ost2[seg * 8 + e]) * rdn; \
            bf16_t* op = O + (size_t)row_p * 2048 + h * 512 + eb * EB + seg * 8; \
            if (dir) { const u32x4 pv = o_p; o[0] += bflo(pv.x); o[1] += bfhi(pv.x); o[2] += bflo(pv.y); o[3] += bfhi(pv.y); o[4] += bflo(pv.z); o[5] += bfhi(pv.z); o[6] += bflo(pv.w); o[7] += bfhi(pv.w); } \
            *(u32x4*)op = (u32x4){pk2(o[0], o[1]), pk2(o[2], o[3]), pk2(o[4], o[5]), pk2(o[6], o[7])}; } } while (0)
    bool lat_p = false; int row_p = 0; float emr_p = 1.f; u32x4 o_p = (u32x4){0u, 0u, 0u, 0u};
    SC1_PREFETCH(0);
    for (int ci = 0; ci < NCT; ++ci) {
        LAS unsigned char* lds = c.lds; LAS float* vec = (LAS float*)(lds + O_VEC);
        SC1_CHUNK(ci, isctx, ch)
        const int row = chunk_rb(isctx, b, ch) + (isctx ? ip_ : roff_l);
        if (tid < 193) vec[tid] = pf_g;
        if (seg < 6) { const float wkj = pf_wk; u32x4 xv = pf_v, wv;
            if (seg >= 4) { xv = (u32x4){seg == 4 ? 0x3f80u : 0u, 0u, 0u, 0u}; }
            wv.x = pk2(bflo(xv.x) * wkj, bfhi(xv.x) * wkj); wv.y = pk2(bflo(xv.y) * wkj, bfhi(xv.y) * wkj); wv.z = pk2(bflo(xv.z) * wkj, bfhi(xv.z) * wkj); wv.w = pk2(bflo(xv.w) * wkj, bfhi(xv.w) * wkj);
            *(LAS u32x4*)(lds + O_V + (ti_ * LV + seg * 8) * 2) = xv; *(LAS u32x4*)(lds + O_VW + (ti_ * LV + seg * 8) * 2) = wv; }
        if (!isctx) *(LAS u32x4*)(lds + O_S + (ti_ * LS + 8 * seg) * 2) = pf_s;
        SC1_ROWS();
        if (lat_p) ASM_VMCNT(1); else ASM_VMCNT(0);
        LDS_BARRIER();
        const float decay0 = vec[192];
        f32x4 U[12];
        if (!isctx) {
            LAS float* ost = (LAS float*)(lds + O_OST);
            { const int t2 = w & 3, kh = w >> 2; f32x4 aT[3], a1 = (f32x4){0.f, 0.f, 0.f, 0.f}, a1o = (f32x4){0.f, 0.f, 0.f, 0.f};
              LAS float* osth = ost + kh * 64 * 34;
#pragma unroll
              for (int q = 0; q < 3; ++q) aT[q] = (f32x4){0.f, 0.f, 0.f, 0.f};
              typedef short v4i16_t __attribute__((ext_vector_type(4)));
              bf16x8 sa_[2], va_[2];
              const bf16x8 vones = __builtin_bit_cast(bf16x8, fr == 0 ? (u32x4){0x3f803f80u, 0x3f803f80u, 0x3f803f80u, 0x3f803f80u} : (u32x4){0u, 0u, 0u, 0u});
              const LAS unsigned char* px = lds + O_XC + ((t2 * 16 + fr) * LX + kh * 256 + 8 * fq) * 2;
              const LAS unsigned char* pc = lds + O_CT + (fr * LX + kh * 256 + 8 * fq) * 2;
              bf16x8 xa_[IPD + 1], cb_[IPD + 1][3];
#define SC1_LOADB(k_) do { xa_[(k_) % (IPD + 1)] = *(const LAS bf16x8*)(px + (k_) * 64); \
                  _Pragma("unroll") for (int q = 0; q < 3; ++q) cb_[(k_) % (IPD + 1)][q] = *(const LAS bf16x8*)(pc + q * 16 * LX * 2 + (k_) * 64); } while (0)
#pragma unroll
              for (int k = 0; k < IPD; ++k) SC1_LOADB(k);
#pragma unroll
              for (int k = 0; k < 8; ++k) {
                  if (k + IPD < 8) SC1_LOADB(k + IPD);
                  if (k == 8 - 1 - IPD) {
              { const LAS unsigned char* ps = lds + O_S + ((t2 * 16 + fr) * LS + 8 * fq) * 2; const LAS unsigned char* pv = lds + O_V + ((8 * fq + (fr >> 2)) * LV + 4 * (fr & 3)) * 2;
#pragma unroll
                for (int kq = 0; kq < 2; ++kq) { sa_[kq] = *(const LAS bf16x8*)(ps + kq * 64);
                    const v4i16_t t0 = __builtin_amdgcn_ds_read_tr16_b64_v4i16((LAS v4i16_t*)(pv + kq * 32 * LV * 2 + kh * 32)), t1 = __builtin_amdgcn_ds_read_tr16_b64_v4i16((LAS v4i16_t*)(pv + kq * 32 * LV * 2 + kh * 32 + 4 * LV * 2));
                    va_[kq] = (bf16x8){t0[0], t0[1], t0[2], t0[3], t1[0], t1[1], t1[2], t1[3]};
                    } }
                  }
                  SCHED_FENCE();
#pragma unroll
                  for (int q = 0; q < 3; ++q) aT[q] = __builtin_amdgcn_mfma_f32_16x16x32_bf16(xa_[k % (IPD + 1)], cb_[k % (IPD + 1)][q], aT[q], 0, 0, 0);
                  SCHED_FENCE(); }
#undef SC1_LOADB
#pragma unroll
              for (int kq = 0; kq < 2; ++kq) { a1 = __builtin_amdgcn_mfma_f32_16x16x32_bf16(sa_[kq], va_[kq], a1, 0, 0, 0);
                  if (kh == 0) a1o = __builtin_amdgcn_mfma_f32_16x16x32_bf16(sa_[kq], vones, a1o, 0, 0, 0); }
#pragma unroll
              for (int r = 0; r < 4; ++r) { const int i = t2 * 16 + 4 * fq + r; const float wi = vec[i];
                  osth[i * 34 + fr] = wi * aT[0][r] + (kh == 0 ? a1[r] : 0.f);
                  osth[i * 34 + 16 + fr] = wi * aT[1][r] + (kh == 1 ? a1[r] : 0.f);
                  LAS float* dst = fr == 0 ? osth + i * 34 + 32 : (LAS float*)(lds + O_DUMP) + lane;
                  *dst = wi * aT[2][r] + a1o[r]; } }
        }
        { typedef short v4i16_t __attribute__((ext_vector_type(4)));
          bf16x8 vb[2][3], xa[4][2];
          const LAS unsigned char* pv = lds + O_VW + ((8 * fq + (fr >> 2)) * LV + 4 * (fr & 3)) * 2; const LAS unsigned char* pxt = lds + O_XC + ((8 * fq + (fr >> 2)) * LX + 64 * w + 4 * (fr & 3)) * 2;
#pragma unroll
          for (int kq = 0; kq < 2; ++kq)
#pragma unroll
              for (int e2 = 0; e2 < 3; ++e2) { const v4i16_t t0 = __builtin_amdgcn_ds_read_tr16_b64_v4i16((LAS v4i16_t*)(pv + kq * 32 * LV * 2 + e2 * 32)), t1 = __builtin_amdgcn_ds_read_tr16_b64_v4i16((LAS v4i16_t*)(pv + kq * 32 * LV * 2 + e2 * 32 + 4 * LV * 2));
                  vb[kq][e2] = (bf16x8){t0[0], t0[1], t0[2], t0[3], t1[0], t1[1], t1[2], t1[3]}; }
#pragma unroll
          for (int dt = 0; dt < 4; ++dt)
#pragma unroll
              for (int kq = 0; kq < 2; ++kq) { const v4i16_t t0 = __builtin_amdgcn_ds_read_tr16_b64_v4i16((LAS v4i16_t*)(pxt + kq * 32 * LX * 2 + dt * 32)), t1 = __builtin_amdgcn_ds_read_tr16_b64_v4i16((LAS v4i16_t*)(pxt + kq * 32 * LX * 2 + dt * 32 + 4 * LX * 2));
                  xa[dt][kq] = (bf16x8){t0[0], t0[1], t0[2], t0[3], t1[0], t1[1], t1[2], t1[3]}; }
          SCHED_FENCE();
#pragma unroll
          for (int dt = 0; dt < 4; ++dt)
#pragma unroll
              for (int e2 = 0; e2 < 3; ++e2) { f32x4 u = (f32x4){0.f, 0.f, 0.f, 0.f};
#pragma unroll
                  for (int kq = 0; kq < 2; ++kq) u = __builtin_amdgcn_mfma_f32_16x16x32_bf16(xa[dt][kq], vb[kq][e2], u, 0, 0, 0);
                  U[dt * 3 + e2] = u; } }
        const float emr_i = vec[128 + ti_];
        __syncthreads();
        lat_p = !isctx; row_p = row; emr_p = emr_i; o_p = pf_o;
        if (ci + 1 < NCT) SC1_PREFETCH(ci + 1);
        bf16x8 mA[4];
#pragma unroll
        for (int dt = 0; dt < 4; ++dt) { const u32x2 mrow = *(const LAS u32x2*)(lds + O_M + (((4 * w + dt) * 4 + fq) * 16 + (fr & 3) * 4) * 2);
            mA[dt] = __builtin_bit_cast(bf16x8, (fq == (fr >> 2)) ? (u32x4){mrow.x, mrow.y, 0u, 0u} : (u32x4){0u, 0u, 0u, 0u}); }
#pragma unroll
        for (int t = 0; t < 12; ++t) { const int td = 4 * w + t / 3, e2 = t % 3;
#pragma unroll
            for (int r = 0; r < 4; ++r) cst[t][r] = decay0 * cst[t][r] + U[t][r];
            const bf16x8 cb = __builtin_bit_cast(bf16x8, (u32x4){pk2(cst[t][0], cst[t][1]), pk2(cst[t][2], cst[t][3]), 0u, 0u});
            const f32x4 zero4 = {0.f, 0.f, 0.f, 0.f};
            const f32x4 o = __builtin_amdgcn_mfma_f32_16x16x32_bf16(mA[t / 3], cb, zero4, 0, 0, 0);
            const int ctoff = O_CT + ((e2 * 16 + fr) * LX + td * 16 + 4 * fq) * 2;
            *(LAS u32x2*)(lds + ((e2 < 2 || fr == 0) ? ctoff : O_DUMP + lane * 8)) = (u32x2){pk2(o[0], o[1]), pk2(o[2], o[3])};
        }
    }
    SC1_ROWS();
    __syncthreads();
#undef SC1_ROWS
#undef SC1_CHUNK
#undef SC1_PREFETCH
}
}
__device__ __forceinline__ void phase_scan1(const Ctx& c, const Params& P, int dir) {
    const int nitems = NB * 64;
    for (int it = c.bid; it < nitems; it += c.G) { sc1::chain(c, P, dir, it / 64, (it % 64) >> 4, it & 15); __syncthreads(); }
}
__device__ __forceinline__ void phase_post1(const Ctx& c, const Params& P) {
    const bf16_t* XMC = (const bf16_t*)(P.ws_() + WS_BIG); bf16_t* O = (bf16_t*)(P.ws_() + WS_BIG + (size_t)MT * 4096 * 2);
    const float* mh = P.in_(I_BMHN); const float* sk = P.in_(I_BSKIP); const float* wv = P.in_(I_BWV);
    const int gw = c.bid * NWAVES + c.wave, NGW = c.G * NWAVES, lane = c.lane;
    LAS float* wl = (LAS float*)c.lds; LAS float* ml = wl + 32 * 64 * 4; LAS float* sl = ml + 8 * 64 * 4;
    for (int i = c.tid; i < 512 * 16; i += NTHREADS) { const int n = i >> 4, dp = (i >> 2) & 3, e = i & 3; wl[(((n & 7) * 4 + dp) * 64 + (n >> 3)) * 4 + e] = wv[i]; }
    for (int i = c.tid; i < 2048; i += NTHREADS) { const int ln = i >> 5, q = (i >> 2) & 7, e = i & 3; ml[(q * 64 + ln) * 4 + e] = mh[i]; sl[(q * 64 + ln) * 4 + e] = sk[i]; }
    __syncthreads();
    for (int row = gw; row < ML; row += NGW) {
        float hv[32]; float s = 0.f;
#pragma unroll
        for (int q = 0; q < 4; ++q) { const u32x4 a = *(const u32x4*)(O + (size_t)row * 2048 + 32 * lane + 8 * q); const unsigned aw[4] = {a.x, a.y, a.z, a.w};
            float raw[8];
#pragma unroll
            for (int e = 0; e < 4; ++e) { raw[2 * e] = bflo(aw[e]); raw[2 * e + 1] = bfhi(aw[e]); }
#pragma unroll
            for (int bl = 0; bl < 2; ++bl) { const LAS float* wb = wl + ((2 * q + bl) * 4 * 64 + lane) * 4;
                const f32x4 r0 = *(const LAS f32x4*)wb, r1 = *(const LAS f32x4*)(wb + 256), r2 = *(const LAS f32x4*)(wb + 512), r3 = *(const LAS f32x4*)(wb + 768);
#pragma unroll
                for (int e = 0; e < 4; ++e) { const float v = raw[bl * 4] * r0[e] + raw[bl * 4 + 1] * r1[e] + raw[bl * 4 + 2] * r2[e] + raw[bl * 4 + 3] * r3[e]; hv[q * 8 + bl * 4 + e] = v; s += v; } } }
        s += __shfl_xor(s, 1); s += __shfl_xor(s, 2); s += __shfl_xor(s, 4); s += __shfl_xor(s, 8);
        const float mu = s * (1.0f / 512.0f); float v = 0.f;
#pragma unroll
        for (int e = 0; e < 32; ++e) { hv[e] -= mu; v += hv[e] * hv[e]; }
        v += __shfl_xor(v, 1); v += __shfl_xor(v, 2); v += __shfl_xor(v, 4); v += __shfl_xor(v, 8);
        const float rs = 1.0f / sqrtf(v * (1.0f / 512.0f) + EPS);
#pragma unroll
        for (int q = 0; q < 4; ++q) { const int ch = 32 * lane + 8 * q;
            const u32x4 xc = *(const u32x4*)(XMC + (size_t)row * 4096 + 2048 + ch), z = *(const u32x4*)(XMC + (size_t)row * 4096 + ch);
            const unsigned xw[4] = {xc.x, xc.y, xc.z, xc.w}, zw[4] = {z.x, z.y, z.z, z.w}; unsigned o[4];
            const f32x4 mh0 = *(const LAS f32x4*)(ml + ((2 * q) * 64 + lane) * 4), mh1 = *(const LAS f32x4*)(ml + ((2 * q + 1) * 64 + lane) * 4);
            const f32x4 sk0 = *(const LAS f32x4*)(sl + ((2 * q) * 64 + lane) * 4), sk1 = *(const LAS f32x4*)(sl + ((2 * q + 1) * 64 + lane) * 4);
#pragma unroll
            for (int e = 0; e < 4; ++e) { const int j = 2 * (e & 1); const f32x4 mm_ = e < 2 ? mh0 : mh1, ss_ = e < 2 ? sk0 : sk1;
                const float f0 = (hv[q * 8 + 2 * e] * rs * mm_[j] + ss_[j] * bflo(xw[e])) * siluf_(bflo(zw[e]));
                const float f1 = (hv[q * 8 + 2 * e + 1] * rs * mm_[j + 1] + ss_[j + 1] * bfhi(xw[e])) * siluf_(bfhi(zw[e]));
                o[e] = pk2(f0, f1); }
            *(u32x4*)(O + (size_t)row * 2048 + ch) = (u32x4){o[0], o[1], o[2], o[3]}; }
    }
    __syncthreads();
}
__device__ __forceinline__ void phase_final(const Ctx& c, const Params& P) {
    const float* w = P.in_(I_FNORM); const int gw = c.bid * NWAVES + c.wave, NGW = c.G * NWAVES;
    f32x4 wv[4];
#pragma unroll
    for (int j = 0; j < 4; ++j) wv[j] = *(const f32x4*)(w + 4 * c.lane + 256 * j);
    f32x4 nv[4];
    if (gw < ML) {
#pragma unroll
        for (int j = 0; j < 4; ++j) nv[j] = *(const f32x4*)(P.out_() + (size_t)gw * D + 4 * c.lane + 256 * j); }
    for (int row = gw; row < ML; row += NGW) { float* xr = P.out_() + (size_t)row * D; f32x4 v[4]; float s = 0.f;
#pragma unroll
        for (int j = 0; j < 4; ++j) v[j] = nv[j];
        if (row + NGW < ML) {
#pragma unroll
            for (int j = 0; j < 4; ++j) nv[j] = *(const f32x4*)(xr + (size_t)NGW * D + 4 * c.lane + 256 * j); }
#pragma unroll
        for (int j = 0; j < 4; ++j) s += (v[j].x * v[j].x + v[j].y * v[j].y) + (v[j].z * v[j].z + v[j].w * v[j].w);
        const float rs = 1.0f / sqrtf(wave_sum(s) * (1.0f / D) + EPS);
#pragma unroll
        for (int j = 0; j < 4; ++j) *(f32x4*)(xr + 4 * c.lane + 256 * j) = v[j] * rs * wv[j]; }
}

enum { PH_PRO = 0, PH_H0, PH_G0, PH_PREP0A, PH_PREP0B, PH_S0F, PH_S0B, PH_POST0, PH_G1, PH_H1, PH_G2, PH_G3, PH_H2, PH_G4, PH_PREP1, PH_GG, PH_SCORE1, PH_SCORE2, PH_S1F, PH_S1B, PH_H2B, PH_G5, PH_POST1, PH_G6, PH_H3, PH_G7, PH_G8, PH_FIN, PH_COUNT };

__device__ __forceinline__ void run_phase(int ph, const Params& P, LAS unsigned char* lds, int bid, int G, int tid) {
    Ctx c; c.lds = lds; c.tid = tid; c.lane = c.tid & 63; c.wave = __builtin_amdgcn_readfirstlane(c.tid >> 6); c.bid = bid; c.G = G;
    unsigned char* ws = P.ws_();
    float* mod = (float*)(ws + WS_MOD); float* mod1 = mod + (size_t)(NB + 1) * NMOD;
    bf16_t* WA = (bf16_t*)(ws + WS_WA); bf16_t* WB = (bf16_t*)(ws + WS_WB);
    bf16_t* H = (bf16_t*)(ws + WS_H); bf16_t* BIG = (bf16_t*)(ws + WS_BIG);
    float* ctxres = (float*)(ws + WS_CTXRES);
    switch (ph) {
    case PH_PRO: {
        phase_mods(c, P);
        int base = 0; const float* W = gmem(P.in_(I_AWIN));
        cvt_seg(c, W, A_IN, D, 2048, 1024, WA, C_G, base);
        cvt_seg(c, W, A_IN, D, 3104, 1024, WA, C_Z, base);
        cvt_seg(c, W, A_IN, D, 0, 512, WA, C_Q, base);
        cvt_seg(c, W, A_IN, D, 512, 512, WA, C_K, base);
        cvt_seg(c, W, A_IN, D, 1024, 1024, WA, C_V, base);
        cvt_seg(c, W, A_IN, D, 4128, 1536, WA, C_XS, base);
        cvt_seg(c, W, A_IN, D, 3072, 32, WA, C_R, base);
        cvt_seg(c, W, A_IN, D, 5664, 32, WA, C_DT, base);
        { bf16_t* wgt = (bf16_t*)(ws + WS_GATES + 7 * MiB / 4); const float* wg = gmem(P.in_(I_AGW));
          for (int i = c.bid * NTHREADS + c.tid; i < 8 * 128 * 32; i += c.G * NTHREADS) { const int r = i & 31, kk = (i >> 5) & 127, dhh = i >> 12, dir = dhh >> 2, h = dhh & 3;
              wgt[i] = r < 16 ? (bf16_t)f2bf(wg[(size_t)dir * 16 * 512 + r * 512 + h * 128 + kk]) : (bf16_t)0; } }
        for (int i = c.bid * NTHREADS + c.tid; i < (NP0 - A_IN) * D / 8; i += c.G * NTHREADS) *(u32x4*)(WA + (size_t)A_IN * D + (size_t)i * 8) = (u32x4){0u, 0u, 0u, 0u};
    } break;
    case PH_H0:
        phase_hnorm(c, gmem(P.in_(I_X)), gmem(P.in_(I_CTX)), gmem(P.in_(I_NMIX)), mod, 0, 1, H, 0, MT);
        break;
    case PH_G0: {
        pg8::Gemm g{H, WA + (size_t)2048 * D, MT, NP0 - 2048, D, D}; pg8::StaticOrder S; S.init(MT, NP0 - 2048, D, G, bid);
        EpiStoreBf16 E{BIG + 2048, NP0};
        pg8::gemm_phase(lds, g, S, E, c.tid);
    } break;
    case PH_PREP0A: sc0::phase_prep0a(c, P); break;
    case PH_PREP0B: sc0::phase_prep0b(c, P); break;
    case PH_S0F: case PH_S0B: {
        const int dir = ph == PH_S0B, nsc = G >= 2 ? G / 2 : G;
        if (bid < nsc) phase_scan0(c, P, dir, nsc);
        if (G < 2 || bid >= nsc) {
            const int cofs = dir ? C_G : C_Z;
            pg8::Gemm g{H, WA + (size_t)cofs * D, MT, 1024, D, D}; pg8::StaticOrder S; S.init(MT, 1024, D, G >= 2 ? G - nsc : 1, G >= 2 ? bid - nsc : 0);
            EpiStoreBf16 E{BIG + cofs, NP0};
            pg8::gemm_phase(lds, g, S, E, c.tid);
        }
    } break;
    case PH_POST0: {
        phase_post0(c, P);
        int base = 0; cvt_seg(c, gmem(P.in_(I_AWOUT)), D, 2048, 0, 1024, WB, 0, base);
    } break;
    case PH_G1: {
        pg8::Gemm g{BIG, WB, MT, D, 2048, NP0}; pg8::StaticOrderT<MC / 256, G1_NSL> S; S.init(ML, D, 2048, G, bid);
        EpiResid E{gmem(P.in_(I_X)), gmem(P.in_(I_CTX)), gmem(P.out_()), ctxres, mod + 2 * D, (float*)(BIG + 2048), NP0 / 2};
        pg8::gemm_phase(lds, g, S, E, c.tid);
    } break;
    case PH_H1: {
        phase_hnorm(c, gmem(P.out_()), gmem(P.in_(I_CTX)), gmem(P.in_(I_NFFN)), mod, 3, 4, H, 0, MT, CtxFix{(const float*)(BIG + 2048), NP0 / 2, G1_NSL, mod + (size_t)NB * NMOD + 2 * D, ctxres});
        int base = 0;
        for (int pn = 0; pn < DFF / 128; ++pn) { cvt_seg(c, gmem(P.in_(I_W1)), DFF, D, 128 * pn, 128, WA, 256 * pn, base); cvt_seg(c, gmem(P.in_(I_W3)), DFF, D, 128 * pn, 128, WA, 256 * pn + 128, base); }
        cvt_seg(c, gmem(P.in_(I_W2)), D, DFF, 0, 1024, WB, 0, base);
    } break;
    case PH_G2: {
        pg8::Gemm g{H, WA, MT, 2 * DFF, D, D}; pg8::StaticOrder S; S.init(MT, 2 * DFF, D, G, bid);
        EpiSwiGLU E{BIG, DFF};
        pg8::gemm_phase(lds, g, S, E, c.tid);
    } break;
    case PH_G3: {
        pg8::Gemm g{BIG, WB, MT, D, DFF, DFF}; pg8::StaticOrderT<MC / 256, G3_NSL> S; S.init(ML, D, DFF, G, bid);
        EpiResid E{gmem(P.out_()), ctxres, gmem(P.out_()), ctxres, mod + 5 * D, (float*)(BIG + (size_t)MT * DFF), D};
        pg8::gemm_phase(lds, g, S, E, c.tid);
    } break;
    case PH_H2: {
        phase_hnorm(c, gmem(P.out_()), ctxres, gmem(P.in_(I_NMIX)) + D, mod1, 0, 1, H, 0, MT, CtxFix{(const float*)(BIG + (size_t)MT * DFF), D, G3_NSL, mod + (size_t)NB * NMOD + 5 * D, ctxres});
        int base = 0;
        cvt_seg(c, gmem(P.in_(I_BWUP)), 4096, D, 0, 2048, WA, 0, base);
        cvt_seg(c, gmem(P.in_(I_BWUP)), 4096, D, 2048, 2048, WB, 0, base);
        build_gate_weights(c, P, WA + (size_t)5 * MiB / 2);
        build_mblocks(c, P, (float*)(ws + WS_GATES + 3 * MiB / 2));
    } break;
    case PH_G4: {
        pg8::Gemm g{H, WA, MT, 2048, D, D}; pg8::StaticOrder S; S.init(MT, 2048, D, G, bid);
        EpiStoreBf16 E{BIG, 4096};
        pg8::gemm_phase(lds, g, S, E, c.tid);
    } break;
    case PH_PREP1: phase_prep1(c, P); break;
    case PH_GG: {
        pg8::Gemm g{BIG, WA + (size_t)5 * MiB / 2, MT, 256, 4096, 4096}; pg8::StaticOrderT<MT / 256, GATE_NSL> S; S.init(0, 256, 4096, G, bid);
        EpiGates E{gates_ptr(ws)};
        pg8::gemm_phase(lds, g, S, E, c.tid);
    } break;
    case PH_SCORE1: sc1::phase_score1(c, P); break;
    case PH_SCORE2: sc1::phase_score2(c, P); break;
    case PH_S1F: phase_scan1(c, P, 0); break;
    case PH_S1B: phase_scan1(c, P, 1); break;
    case PH_H2B: phase_hnorm(c, gmem(P.out_()), ctxres, gmem(P.in_(I_NMIX)) + D, mod1, 0, 1, H, 0, ML); break;
    case PH_G5: {
        pg8::Gemm g{H, WB, ML, 2048, D, D}; pg8::StaticOrder S; S.init(ML, 2048, D, G, bid);
        EpiStoreBf16 E{BIG, 4096};
        pg8::gemm_phase(lds, g, S, E, c.tid);
    } break;
    case PH_POST1: {
        phase_post1(c, P);
        int base = 0; cvt_seg(c, gmem(P.in_(I_BWDOWN)), D, 2048, 0, 1024, WB, 0, base);
    } break;
    case PH_G6: {
        pg8::Gemm g{BIG + (size_t)MT * 4096, WB, ML, D, 2048, 2048}; pg8::StaticOrder S; S.init(ML, D, 2048, G, bid);
        EpiResid E{gmem(P.out_()), ctxres, gmem(P.out_()), ctxres, mod1 + 2 * D, nullptr, 0};
        pg8::gemm_phase(lds, g, S, E, c.tid);
    } break;
    case PH_H3: {
        phase_hnorm(c, gmem(P.out_()), ctxres, gmem(P.in_(I_NFFN)) + D, mod1, 3, 4, H, 0, ML);
        int base = 0; const float* w1 = gmem(P.in_(I_W1)) + (size_t)D * DFF; const float* w3 = gmem(P.in_(I_W3)) + (size_t)D * DFF;
        for (int pn = 0; pn < DFF / 128; ++pn) { cvt_seg(c, w1, DFF, D, 128 * pn, 128, WA, 256 * pn, base); cvt_seg(c, w3, DFF, D, 128 * pn, 128, WA, 256 * pn + 128, base); }
        cvt_seg(c, gmem(P.in_(I_W2)) + (size_t)DFF * D, D, DFF, 0, 1024, WB, 0, base);
    } break;
    case PH_G7: {
        pg8::Gemm g{H, WA, ML, 2 * DFF, D, D}; pg8::StaticOrder S; S.init(ML, 2 * DFF, D, G, bid);
        EpiSwiGLU E{BIG, DFF};
        pg8::gemm_phase(lds, g, S, E, c.tid);
    } break;
    case PH_G8: {
        pg8::Gemm g{BIG, WB, ML, D, DFF, DFF}; pg8::StaticOrder S; S.init(ML, D, DFF, G, bid);
        EpiResid E{gmem(P.out_()), ctxres, gmem(P.out_()), ctxres, mod1 + 5 * D, nullptr, 0};
        pg8::gemm_phase(lds, g, S, E, c.tid);
    } break;
    case PH_FIN: phase_final(c, P); break;
    default: break;
    }
}

#ifndef EMU
#include <hip/hip_cooperative_groups.h>
namespace cg = cooperative_groups;
constexpr int LDS_BYTES = 147456;
#define XB_TMO      128
#define XB_XCNT(j)  (256  + 64 * (j))
#define XB_XSUB(j)  (1280 + 64 * (j))
#define XB_XGEN(j)  (2304 + 64 * (j))
#define XB_TOP      3328
#define XB_TOPGEN   3392
#define XCD_BAR_WORDS 3456
#define XB_SPIN_CAP (1u << 20)
__device__ __forceinline__ unsigned xb_ld(unsigned* p)              { return __hip_atomic_load(p, __ATOMIC_RELAXED, __HIP_MEMORY_SCOPE_AGENT); }
__device__ __forceinline__ unsigned xb_add(unsigned* p, unsigned v) { return __hip_atomic_fetch_add(p, v, __ATOMIC_RELAXED, __HIP_MEMORY_SCOPE_AGENT); }
__device__ __forceinline__ unsigned xb_xcc_id() { return (unsigned)__builtin_amdgcn_s_getreg((3 << 11) | 20) & 0xFu; }
#define XB_SPIN(cond, bar) do { unsigned _sp = 0; while (cond) { __builtin_amdgcn_s_sleep(1); \
    if ((++_sp & 255u) == 0u) { if (xb_ld(&(bar)[XB_TMO])) break; if (_sp > XB_SPIN_CAP) { atomicAdd(&(bar)[XB_TMO], 1u); break; } } } } while (0)
struct XcdBarrier { unsigned* bar; unsigned x; volatile LAS unsigned* st; };
__device__ __forceinline__ XcdBarrier xcd_barrier_post(unsigned* bar, volatile LAS unsigned* st) {
    XcdBarrier b; b.bar = bar; b.x = xb_xcc_id(); b.st = st;
    if (threadIdx.x == 0) (void)xb_add(&bar[XB_XCNT(b.x)], 1u);
    return b;
}
__device__ __forceinline__ void xcd_barrier_complete(unsigned* bar, unsigned x, unsigned& nloc, unsigned& nx) {
    const unsigned G = gridDim.x * gridDim.y * gridDim.z;
    unsigned sum, cnt, mine, sp = 0u;
    for (;;) {
        sum = 0u; cnt = 0u; mine = 0u;
#pragma unroll
        for (unsigned j = 0; j < 16; ++j) { const unsigned c = xb_ld(&bar[XB_XCNT(j)]); sum += c; cnt += (c > 0u) ? 1u : 0u; mine = (j == x) ? c : mine; }
        if (sum == G) break;
        __builtin_amdgcn_s_sleep(1);
        if ((++sp & 255u) == 0u) { if (xb_ld(&bar[XB_TMO])) break; if (sp > XB_SPIN_CAP) { atomicAdd(&bar[XB_TMO], 1u); break; } }
    }
    nloc = mine > 0u ? mine : 1u; nx = cnt > 0u ? cnt : 1u;
}
__device__ __forceinline__ void xcd_barrier(const XcdBarrier& b) {
    asm volatile("s_waitcnt vmcnt(0)" ::: "memory");
    __syncthreads();
    if (threadIdx.x == 0) {
        unsigned* bar = b.bar;
        __builtin_amdgcn_s_waitcnt(0);
        unsigned nloc = b.st[0], nx = b.st[1];
        if (nloc == 0u) { xcd_barrier_complete(bar, b.x, nloc, nx); b.st[0] = nloc; b.st[1] = nx; }
        const unsigned old = xb_add(&bar[XB_XSUB(b.x)], 1u);
        const unsigned gen = old / nloc;
        if (old + 1u == (gen + 1u) * nloc) {
            __builtin_amdgcn_fence(__ATOMIC_RELEASE, "agent");
            asm volatile("s_waitcnt vmcnt(0)" ::: "memory");
            const unsigned og = xb_add(&bar[XB_TOP], 1u);
            const unsigned tg = og / nx;
            if (og + 1u == (tg + 1u) * nx) xb_add(&bar[XB_TOPGEN], 1u);
            else XB_SPIN(xb_ld(&bar[XB_TOPGEN]) == tg, bar);
            __builtin_amdgcn_fence(__ATOMIC_ACQUIRE, "agent");
            xb_add(&bar[XB_XGEN(b.x)], 1u);
            asm volatile("s_waitcnt vmcnt(0)" ::: "memory");
        } else {
            XB_SPIN(xb_ld(&bar[XB_XGEN(b.x)]) == gen, bar);
            __builtin_amdgcn_fence(__ATOMIC_ACQUIRE, "agent");
            asm volatile("s_waitcnt vmcnt(0)" ::: "memory");
        }
    }
    __syncthreads();
}

__global__ void __launch_bounds__(NTHREADS, 2) fwd_megakernel(ParamsK K) {
    extern __shared__ __attribute__((aligned(16))) unsigned char lds[];
    cg::grid_group grid = cg::this_grid();
    LAS unsigned long long* pl = (LAS unsigned long long*)((LAS unsigned char*)lds + PARAM_LDS_OFF);
    volatile LAS unsigned* bst = (volatile LAS unsigned*)((LAS unsigned char*)lds + PARAM_LDS_OFF + 320);
    if (threadIdx.x == 0) {
#pragma unroll
        for (int i = 0; i < 34; ++i) pl[i] = (unsigned long long)K.in[i];
        pl[34] = (unsigned long long)K.out; pl[35] = (unsigned long long)K.ws;
        bst[0] = 0u; bst[1] = 0u;
    }
    __syncthreads();
    (void)xcd_barrier_post((unsigned*)(K.ws + WS_CTL), bst);
#pragma nounroll
    for (int ph = 0; ph < PH_COUNT; ++ph) {
        int phv = ph, bid = blockIdx.x, G = gridDim.x, tid = threadIdx.x; unsigned lo = 0;
        asm volatile("" : "+s"(phv), "+s"(bid), "+s"(G), "+s"(lo), "+v"(tid));
        Params P; P.pl = (const LAS unsigned long long*)((LAS unsigned char*)lds + PARAM_LDS_OFF + lo);
        run_phase(phv, P, (LAS unsigned char*)lds + lo, bid, G, tid);
#ifdef DUP_MASK
        if ((DUP_MASK >> ph) & 1u) {
            XcdBarrier bar; bar.bar = (unsigned*)(P.ws_() + WS_CTL); bar.x = xb_xcc_id(); bar.st = (volatile LAS unsigned*)((LAS unsigned char*)lds + lo + PARAM_LDS_OFF + 320);
            if (ph != 0) { xcd_barrier(bar); run_phase(phv, P, (LAS unsigned char*)lds + lo, bid, G, tid); } }
#endif
        if (ph == 0) grid.sync();
        else if (ph + 1 < PH_COUNT) {
            XcdBarrier bar; bar.bar = (unsigned*)(P.ws_() + WS_CTL); bar.x = xb_xcc_id(); bar.st = (volatile LAS unsigned*)((LAS unsigned char*)lds + lo + PARAM_LDS_OFF + 320);
            xcd_barrier(bar); }
    }
}
extern "C" void kernel_launch(void* const* d_in, const int* in_sizes, int n_in, void* d_out, int out_size, void* d_ws, size_t ws_size, hipStream_t stream) {
    static int grid = 0;
    if (grid == 0) {
        int dev = 0, cus = 0, per_cu = 0;
        (void)hipGetDevice(&dev); (void)hipDeviceGetAttribute(&cus, hipDeviceAttributeMultiprocessorCount, dev);
        (void)hipFuncSetAttribute((const void*)fwd_megakernel, hipFuncAttributeMaxDynamicSharedMemorySize, LDS_BYTES);
        if (hipOccupancyMaxActiveBlocksPerMultiprocessor(&per_cu, (const void*)fwd_megakernel, NTHREADS, LDS_BYTES) != hipSuccess || per_cu < 1) per_cu = 1;
        if (per_cu > 1) per_cu = 1;
        grid = (cus > 0 ? cus : 256) * per_cu;
        if (ws_size < WS_END) fprintf(stderr, "kernel_launch: workspace too small: %zu < %zu\n", ws_size, (size_t)WS_END);
    }
    ParamsK P{};
    for (int i = 0; i < 34; ++i) P.in[i] = (const float*)d_in[i];
    P.out = (float*)d_out; P.ws = (unsigned char*)d_ws;
    (void)hipMemsetAsync((char*)d_ws + WS_CTL, 0, CTL_ZERO_BYTES, stream);
    void* args[] = {&P};
    hipError_t e = hipLaunchCooperativeKernel((const void*)fwd_megakernel, dim3(grid), dim3(NTHREADS), args, LDS_BYTES, stream);
    if (e != hipSuccess) fprintf(stderr, "cooperative launch failed: %s (grid %d)\n", hipGetErrorString(e), grid);
}
#endif
```

```cpp
#ifndef EMU
#include <hip/hip_runtime.h>
#include <cstdio>
#include <cstdint>
#endif

#ifndef CFG_BATCH
#define CFG_BATCH 4
#define CFG_SEQ 4096
#define CFG_CTX 256
#define CFG_GW 64
#endif
constexpr int D = 1024, NB = CFG_BATCH, SEQ = CFG_SEQ, CTX = CFG_CTX, GW = CFG_GW, GROWS = SEQ / GW, CHUNK = 64;
constexpr int ML = NB * SEQ, MC = NB * CTX, MT = ML + MC;
static_assert(ML % 256 == 0 && MT % 256 == 0 && SEQ % 64 == 0 && CTX % 64 == 0, "row tiling");
constexpr int NMOD = 6 * D;
constexpr int DFF = 2816;
constexpr int A_IN = 5696, NP0 = 5888;
constexpr int C_G = 0, C_Z = 1024, C_Q = 2048, C_K = 2560, C_V = 3072, C_XS = 4096, C_B = 5120, C_C = 5376, C_R = 5632, C_DT = 5664;
constexpr float EPS = 1e-6f;
constexpr int NTHREADS = 512, NWAVES = 8;
constexpr int G1_NSL = 3, G3_NSL = ((size_t)MT * (NP0 - DFF) * 2 >= (size_t)11 * MC * D * 4) ? 11 : 4;

#ifdef EMU
#define LAS
#define GAS
#define GAS
#define ASM_VMCNT(n) do {} while (0)
#define ASM_LGKMCNT(n) do {} while (0)
#define ASM_FENCE() do {} while (0)
#define WAVE_LDS_SYNC() emu::wave_sync()
#define LDS_BARRIER() __syncthreads()
#define SCHED_FENCE() do {} while (0)
#define OPAQUE_V(x) do {} while (0)
#else
#define LAS __attribute__((address_space(3)))
#define GAS __attribute__((address_space(1)))
#define GAS __attribute__((address_space(1)))
#define ASM_VMCNT(n) asm volatile("s_waitcnt vmcnt(" #n ")" ::: "memory")
#define ASM_LGKMCNT(n) asm volatile("s_waitcnt lgkmcnt(" #n ")" ::: "memory")
#define ASM_FENCE() asm volatile("" ::: "memory")
#define LDS_BARRIER() asm volatile("s_waitcnt lgkmcnt(0)\n\ts_barrier" ::: "memory")
#define SCHED_FENCE() do { asm volatile("" ::: "memory"); __builtin_amdgcn_sched_barrier(0); } while (0)
#define OPAQUE_V(x) asm volatile("" : "+v"(x))
#define WAVE_LDS_SYNC() do { asm volatile("s_waitcnt lgkmcnt(0)" ::: "memory"); } while (0)
#endif

typedef unsigned short bf16_t;
typedef short bf16x8 __attribute__((ext_vector_type(8)));
typedef short bf16x4 __attribute__((ext_vector_type(4)));
typedef float f32x4 __attribute__((ext_vector_type(4)));
typedef float f32x2 __attribute__((ext_vector_type(2)));
typedef unsigned u32x4 __attribute__((ext_vector_type(4)));
typedef unsigned u32x2 __attribute__((ext_vector_type(2)));

__device__ __forceinline__ unsigned f2bf(float f) { unsigned u = __builtin_bit_cast(unsigned, f); return (u + 0x7fffu + ((u >> 16) & 1u)) >> 16; }
#ifdef EMU
__device__ __forceinline__ unsigned pk2(float lo, float hi) { return f2bf(lo) | (f2bf(hi) << 16); }
#else
typedef __bf16 hwbf16x2 __attribute__((ext_vector_type(2)));
__device__ __forceinline__ unsigned pk2(float lo, float hi) { const f32x2 v = {lo, hi}; return __builtin_bit_cast(unsigned, __builtin_convertvector(v, hwbf16x2)); }
#endif
#ifdef EMU
__device__ __forceinline__ float dot2bf(unsigned a, unsigned b, float c) { return emu_fdot2_bf16(a, b, c); }
#else
__device__ __forceinline__ float dot2bf(unsigned a, unsigned b, float c) { return __builtin_amdgcn_fdot2_f32_bf16(__builtin_bit_cast(hwbf16x2, a), __builtin_bit_cast(hwbf16x2, b), c, false); }
#endif
__device__ __forceinline__ float bf2f(unsigned h) { return __builtin_bit_cast(float, (h & 0xffffu) << 16); }
__device__ __forceinline__ float bflo(unsigned w) { return __builtin_bit_cast(float, w << 16); }
__device__ __forceinline__ float bfhi(unsigned w) { return __builtin_bit_cast(float, w & 0xffff0000u); }
__device__ __forceinline__ float sigmoidf_(float x) { return __builtin_amdgcn_rcpf(1.0f + __expf(-x)); }
__device__ __forceinline__ float siluf_(float x) { return x * __builtin_amdgcn_rcpf(1.0f + __expf(-x)); }
__device__ __forceinline__ float log1pexp_(float ax) { return __logf(1.0f + __expf(-ax)); }
__device__ __forceinline__ float log_sigmoidf_(float x) { return fminf(x, 0.f) - log1pexp_(fabsf(x)); }
__device__ __forceinline__ float softplusf_(float x) { return fmaxf(x, 0.f) + log1pexp_(fabsf(x)); }
__device__ __forceinline__ float wave_sum(float v) {
#pragma unroll
    for (int o = 1; o < 64; o <<= 1) v += __shfl_xor(v, o);
    return v;
}

constexpr size_t MiB = 1u << 20;
constexpr size_t WS_CTL = 0;
constexpr size_t WS_MOD = 64 * 1024;
constexpr size_t MOD_BYTES = (size_t)2 * (NB + 1) * NMOD * 4;
constexpr size_t CTL_ZERO_BYTES = 512 * 1024;
static_assert(WS_MOD + MOD_BYTES <= CTL_ZERO_BYTES && 3456 * 4 <= WS_MOD, "mods and barrier words inside the memset region");
constexpr size_t WS_GATES = 1 * MiB;
constexpr size_t WS_WB = 3 * MiB;
constexpr size_t WS_CTXRES = 9 * MiB;
constexpr size_t WS_H = 13 * MiB;
constexpr size_t WS_BIG = 47 * MiB;
constexpr size_t BIG_BYTES = (size_t)MT * NP0 * 2;
constexpr size_t WS_WA = WS_BIG + ((BIG_BYTES + 255) & ~(size_t)255);
constexpr size_t WS_END = WS_WA + 12 * MiB;
static_assert((size_t)MT * DFF * 2 + (size_t)G3_NSL * MC * D * 4 <= BIG_BYTES, "FFN-down partial slabs fit behind the hidden activations");
static_assert(WS_CTXRES + (size_t)MC * D * 4 <= WS_H && WS_H + (size_t)MT * D * 2 <= WS_BIG, "workspace map");
static_assert((size_t)MT * 4096 * 2 + (size_t)ML * 2048 * 2 <= BIG_BYTES + 5 * MiB, "layer-1 O spills at most 5 MiB into WA");
static_assert(WS_END <= 256 * MiB, "workspace fits 256 MiB");

struct ParamsK {
    const float* in[34];
    float* out;
    unsigned char* ws;
};
constexpr int PARAM_LDS_OFF = 147456 - 512;
struct Params {
    const LAS unsigned long long* pl;
    __device__ __forceinline__ unsigned long long ld(int i) const {
#ifdef EMU
        return pl[i];
#else
        const unsigned long long v = pl[i]; const unsigned lo = __builtin_amdgcn_readfirstlane((unsigned)v), hi = __builtin_amdgcn_readfirstlane((unsigned)(v >> 32));
        return ((unsigned long long)hi << 32) | lo;
#endif
    }
    __device__ __forceinline__ const float* in_(int i) const { return (const float*)ld(i); }
    __device__ __forceinline__ float* out_() const { return (float*)ld(34); }
    __device__ __forceinline__ unsigned char* ws_() const { return (unsigned char*)ld(35); }
};
#ifdef EMU
template <class T> __device__ __forceinline__ T* gmem(T* p) { return p; }
#else
template <class T> __device__ __forceinline__ T* gmem(T* p) { return (T*)(GAS T*)(unsigned long long)p; }
#endif
enum { I_X = 0, I_C, I_CTX, I_CCTX, I_WMOD, I_BMOD, I_NMIX, I_NFFN, I_W1, I_W3, I_W2, I_AWIN, I_AGW, I_AGB, I_AGN, I_ACW, I_ACB, I_AALOG, I_ADTB, I_AD, I_ASN, I_AWOUT,
       I_BWUP, I_BCW, I_BCB, I_BWQ, I_BWK, I_BWV, I_BWIF, I_BBIF, I_BMHN, I_BSKIP, I_BWDOWN, I_FNORM };

namespace pg8 {
constexpr int BM = 256, BK = 64, HALF = 128, HTB = HALF * BK * 2, STAGE_BYTES = 8 * HTB, NXCD = 8, WGM = 8;
__host__ __device__ __forceinline__ int lds_byte(int r, int c) { const int st = (r >> 4) * 2 + (c >> 5), rr = r & 15, cc = c & 31, ob = rr * 64 + cc * 2; return st * 1024 + (ob ^ (((ob >> 9) & 1) << 5)); }
__host__ __device__ __forceinline__ void stage_rc(int b, int& R, int& C) { const int st = b / 1024, sb = b % 1024, swz = sb ^ (((sb >> 9) & 1) << 5); R = (st >> 1) * 16 + swz / 64; C = (st & 1) * 32 + (swz % 64) / 2; }
__host__ __device__ __forceinline__ int perm32(int rho) { const int n = rho >> 4, i = rho & 15; return 8 * (i >> 2) + 4 * n + (i & 3); }
struct Unit { int pm, pn, k0, nt, sl; };
struct Gemm { const bf16_t* A; const bf16_t* Bt; int M, N, K, lda; };
template <int NXM = 0, int NSL = 1>
struct StaticOrderT {
    int nM, nN, G, c, ntK;
    __host__ __device__ void init(int M, int N, int K, int G_, int c_) { nM = M / BM; nN = N / BM; G = G_; c = c_; ntK = K / BK; }
    __host__ __device__ bool next(int i, Unit& u) const {
        const int nwg = nM * nN; const int L = i * G + c;
        int pm = 0, pn = 0, k0 = 0, nt = ntK, sl = -1; bool ok = false;
        if (L < nwg) {
            int wgid = L; { const int q = nwg / NXCD, r = nwg % NXCD, xcd = wgid % NXCD, off = wgid / NXCD; wgid = (xcd < r ? xcd * (q + 1) : r * (q + 1) + (xcd - r) * q) + off; }
            const int nig = WGM * nN, gid = wgid / nig, fm = gid * WGM, gsz = (nM - fm) < WGM ? (nM - fm) : WGM;
            pm = fm + ((wgid % nig) % gsz); pn = (wgid % nig) / gsz; ok = true; }
        else if (NXM != 0) {
            const int xunits = NXM * nN * NSL, nmain = (nwg - c + G - 1) / G;
            const int j = (i - nmain) * G + c;
            if (j < xunits) { sl = j % NSL; const int t = j / NSL; pn = t % nN; pm = nM + t / nN;
                const int base = (ntK / NSL) & ~1; k0 = sl * base; nt = (sl == NSL - 1) ? ntK - base * (NSL - 1) : base; ok = true; }
        }
        u.pm = pm; u.pn = pn; u.k0 = k0; u.nt = nt; u.sl = sl; return ok;
    }
};
typedef StaticOrderT<0, 1> StaticOrder;
template <class Epi, class Order>
__device__ __forceinline__ void gemm_phase(LAS unsigned char* lds, const Gemm g, const Order& S, const Epi& E, const int tid) {
    const int wid = __builtin_amdgcn_readfirstlane(tid >> 6), lane = tid & 63, wr = wid >> 2, wc = wid & 3, fr = lane & 15, fq = lane >> 4;
    const int K = g.K, lda = g.lda;
    unsigned voffA[2], voffB[2];
#pragma unroll
    for (int i = 0; i < 2; ++i) { int R, C; stage_rc(tid * 16 + i * 8192, R, C); const int Rb = Epi::PERM ? ((R & ~31) + perm32(R & 31)) : R;
        voffA[i] = (unsigned)(R * lda + C) * 2u; voffB[i] = (unsigned)(Rb * K + C) * 2u; }
    const size_t kstep = (size_t)(BK * 2);
    const size_t hstepA = (size_t)HALF * lda * 2, hstepB = (size_t)HALF * K * 2;
    const size_t tstepA = 2 * hstepA, tstepB = 2 * hstepB;
    const unsigned ldsw = (unsigned)wid * 1024u;
    const int aoff = lds_byte(wr * 64 + fr, fq * 8), boff = lds_byte(wc * 32 + fr, fq * 8);
#define PG8_SA(b, h) (((b) * 2 + (h)) * HTB)
#define PG8_SB(b, h) ((4 + (b) * 2 + (h)) * HTB)
#define PG8_STAGE(bufoff, gbase, voff) do { _Pragma("unroll") for (int _i = 0; _i < 2; ++_i) \
        __builtin_amdgcn_global_load_lds((const unsigned*)((const char*)(gbase) + (voff)[_i]), (LAS unsigned*)(lds + (bufoff) + ldsw + _i * 8192), 16, 0, 0); } while (0)
#define PG8_LDA(dst, b, h) do { _Pragma("unroll") for (int m = 0; m < 4; ++m) _Pragma("unroll") for (int k = 0; k < 2; ++k) dst[m][k] = *(const LAS bf16x8*)(lds + PG8_SA(b, h) + aoff + m * 2048 + k * 1024); } while (0)
#define PG8_LDB(dst, b, h) do { _Pragma("unroll") for (int n = 0; n < 2; ++n) _Pragma("unroll") for (int k = 0; k < 2; ++k) dst[n][k] = *(const LAS bf16x8*)(lds + PG8_SB(b, h) + boff + n * 2048 + k * 1024); } while (0)
#define PG8_MMA(ai, bj, At, Bt) do { __builtin_amdgcn_s_setprio(1); _Pragma("unroll") for (int m = 0; m < 4; ++m) _Pragma("unroll") for (int n = 0; n < 2; ++n) _Pragma("unroll") for (int k = 0; k < 2; ++k) \
        acc[ai][bj][m][n] = __builtin_amdgcn_mfma_f32_16x16x32_bf16(Bt[n][k], At[m][k], acc[ai][bj][m][n], 0, 0, 0); __builtin_amdgcn_s_setprio(0); } while (0)
#define PG8_BAR __builtin_amdgcn_s_barrier()
#define PG8_SCHED __builtin_amdgcn_sched_barrier(0)
    Unit cur, nxt; int ui = 0;
    if (!S.next(0, cur)) return;
    f32x4 acc[2][2][4][2];
#pragma unroll
    for (int a = 0; a < 2; ++a)
#pragma unroll
        for (int b = 0; b < 2; ++b)
#pragma unroll
            for (int m = 0; m < 4; ++m)
#pragma unroll
                for (int n = 0; n < 2; ++n) acc[a][b][m][n] = (f32x4){0.f, 0.f, 0.f, 0.f};
    bf16x8 At[4][2], B0[2][2], B1[2][2];
    const char* cA = (const char*)g.A + (size_t)cur.pm * tstepA + (size_t)cur.k0 * kstep; const char* cB = (const char*)g.Bt + (size_t)cur.pn * tstepB + (size_t)cur.k0 * kstep;
    PG8_STAGE(PG8_SB(0, 0), cB, voffB); PG8_STAGE(PG8_SB(0, 1), cB + hstepB, voffB); PG8_STAGE(PG8_SA(0, 0), cA, voffA); PG8_STAGE(PG8_SA(0, 1), cA + hstepA, voffA);
    if (wr == 1) PG8_BAR;
    ASM_VMCNT(2); PG8_BAR;
    PG8_STAGE(PG8_SB(1, 0), cB + kstep, voffB); PG8_STAGE(PG8_SA(1, 0), cA + kstep, voffA); PG8_STAGE(PG8_SB(1, 1), cB + hstepB + kstep, voffB);
    ASM_VMCNT(6); PG8_BAR;
    for (;;) {
        const bool has_next = S.next(ui + 1, nxt);
        const char* nA = has_next ? (const char*)g.A + (size_t)nxt.pm * tstepA + (size_t)nxt.k0 * kstep : cA; const char* nB = has_next ? (const char*)g.Bt + (size_t)nxt.pn * tstepB + (size_t)nxt.k0 * kstep : cB;
        const int nt = cur.nt;
        for (int t = 0; t < nt; t += 2) {
            const bool last = (t == nt - 2);
            const char* a1 = cA + (size_t)(t + 1) * kstep;
            const char* a2 = last ? nA : cA + (size_t)(t + 2) * kstep; const char* b2 = last ? nB : cB + (size_t)(t + 2) * kstep;
            const char* a3 = a2 + kstep; const char* b3 = b2 + kstep;
            PG8_LDB(B0, 0, 0); PG8_LDB(B1, 0, 1); PG8_SCHED; PG8_LDA(At, 0, 0); PG8_STAGE(PG8_SA(1, 1), a1 + hstepA, voffA);
            ASM_VMCNT(8); ASM_LGKMCNT(0); PG8_BAR; PG8_MMA(0, 0, At, B0); PG8_MMA(0, 1, At, B1); PG8_BAR; PG8_SCHED;
            PG8_LDA(At, 0, 1); PG8_STAGE(PG8_SB(0, 0), b2, voffB); PG8_STAGE(PG8_SB(0, 1), b2 + hstepB, voffB); PG8_STAGE(PG8_SA(0, 0), a2, voffA);
            ASM_VMCNT(8); ASM_LGKMCNT(0); PG8_BAR; PG8_MMA(1, 0, At, B0); PG8_MMA(1, 1, At, B1); PG8_BAR; PG8_SCHED;
            PG8_LDB(B0, 1, 0); PG8_LDB(B1, 1, 1); PG8_SCHED; PG8_LDA(At, 1, 0); PG8_STAGE(PG8_SA(0, 1), a2 + hstepA, voffA);
            ASM_VMCNT(8); ASM_LGKMCNT(0); PG8_BAR; PG8_MMA(0, 0, At, B0); PG8_MMA(0, 1, At, B1); PG8_BAR; PG8_SCHED;
            PG8_LDA(At, 1, 1); PG8_STAGE(PG8_SB(1, 0), b3, voffB); PG8_STAGE(PG8_SB(1, 1), b3 + hstepB, voffB); PG8_STAGE(PG8_SA(1, 0), a3, voffA);
            ASM_VMCNT(8); ASM_LGKMCNT(0); PG8_BAR; PG8_MMA(1, 0, At, B0); PG8_MMA(1, 1, At, B1); PG8_BAR; PG8_SCHED;
        }
        if (wr == 0) PG8_BAR;
        E(acc, cur, wr, wc, fr, fq);
        if (!has_next) break;
#pragma unroll
        for (int a = 0; a < 2; ++a)
#pragma unroll
            for (int b = 0; b < 2; ++b)
#pragma unroll
                for (int m = 0; m < 4; ++m)
#pragma unroll
                    for (int n = 0; n < 2; ++n) acc[a][b][m][n] = (f32x4){0.f, 0.f, 0.f, 0.f};
        cur = nxt; cA = nA; cB = nB; ++ui;
        if (wr == 1) PG8_BAR;
    }
    ASM_VMCNT(0);
    PG8_BAR;
#undef PG8_SA
#undef PG8_SB
#undef PG8_STAGE
#undef PG8_LDA
#undef PG8_LDB
#undef PG8_MMA
#undef PG8_BAR
#undef PG8_SCHED
}
}

struct EpiStoreBf16 {
    static constexpr bool PERM = true;
    bf16_t* O; int ldc;
    __device__ __forceinline__ void operator()(const f32x4 (&acc)[2][2][4][2], const pg8::Unit& u, int wr, int wc, int fr, int fq) const {
        const int row0 = u.pm * 256 + wr * 64 + fr, col0 = u.pn * 256 + wc * 32 + 8 * fq;
#pragma unroll
        for (int ai = 0; ai < 2; ++ai)
#pragma unroll
            for (int m = 0; m < 4; ++m) { bf16_t* rowp = O + (size_t)(row0 + ai * 128 + m * 16) * ldc + col0;
#pragma unroll
                for (int bj = 0; bj < 2; ++bj) { const f32x4 v0 = acc[ai][bj][m][0], v1 = acc[ai][bj][m][1];
                    u32x4 w; w.x = pk2(v0[0], v0[1]); w.y = pk2(v0[2], v0[3]); w.z = pk2(v1[0], v1[1]); w.w = pk2(v1[2], v1[3]);
                    *(u32x4*)(rowp + bj * 128) = w; } }
    }
};
struct EpiSwiGLU {
    static constexpr bool PERM = true;
    bf16_t* O; int ldc;
    __device__ __forceinline__ void operator()(const f32x4 (&acc)[2][2][4][2], const pg8::Unit& u, int wr, int wc, int fr, int fq) const {
        const int row0 = u.pm * 256 + wr * 64 + fr, col0 = u.pn * 128 + wc * 32 + 8 * fq;
#pragma unroll
        for (int ai = 0; ai < 2; ++ai)
#pragma unroll
            for (int m = 0; m < 4; ++m) { bf16_t* rowp = O + (size_t)(row0 + ai * 128 + m * 16) * ldc + col0;
                float r[8];
#pragma unroll
                for (int n = 0; n < 2; ++n)
#pragma unroll
                    for (int i = 0; i < 4; ++i) r[n * 4 + i] = siluf_(acc[ai][0][m][n][i]) * acc[ai][1][m][n][i];
                u32x4 w; w.x = pk2(r[0], r[1]); w.y = pk2(r[2], r[3]); w.z = pk2(r[4], r[5]); w.w = pk2(r[6], r[7]);
                *(u32x4*)rowp = w; }
    }
};
struct EpiResid {
    static constexpr bool PERM = false;
    const float* xin_lat; const float* xin_ctx; float* xout_lat; float* xout_ctx; const float* gate;
    float* part; int prs;
    __device__ __forceinline__ void operator()(const f32x4 (&acc)[2][2][4][2], const pg8::Unit& u, int wr, int wc, int fr, int fq) const {
        if (u.sl >= 0) { const int col0 = u.pn * 256 + wc * 32 + 4 * fq;
#pragma unroll
            for (int ai = 0; ai < 2; ++ai)
#pragma unroll
                for (int m = 0; m < 4; ++m) { float* pr = part + (size_t)(u.sl * MC + u.pm * 256 - ML + ai * 128 + wr * 64 + m * 16 + fr) * prs + col0;
#pragma unroll
                    for (int bj = 0; bj < 2; ++bj)
#pragma unroll
                        for (int n = 0; n < 2; ++n) *(f32x4*)(pr + bj * 128 + n * 16) = acc[ai][bj][m][n]; }
            return; }
        const int rbase = u.pm * 256;
        const bool isctx = rbase >= ML;
        const float* xin = isctx ? xin_ctx - (size_t)ML * D : xin_lat; float* xout = isctx ? xout_ctx - (size_t)ML * D : xout_lat;
        const float* gp = gate + (size_t)(isctx ? NB : rbase / SEQ) * NMOD;
        const int col0 = u.pn * 256 + wc * 32 + 4 * fq;
        f32x4 gv[2][2];
#pragma unroll
        for (int bj = 0; bj < 2; ++bj)
#pragma unroll
            for (int n = 0; n < 2; ++n) gv[bj][n] = *(const f32x4*)(gp + col0 + bj * 128 + n * 16);
#pragma unroll
        for (int ai = 0; ai < 2; ++ai)
#pragma unroll
            for (int m = 0; m < 4; ++m) { const size_t off = (size_t)(rbase + ai * 128 + wr * 64 + m * 16 + fr) * D + col0;
#pragma unroll
                for (int bj = 0; bj < 2; ++bj)
#pragma unroll
                    for (int n = 0; n < 2; ++n) { const f32x4 xi = *(const f32x4*)(xin + off + bj * 128 + n * 16);
                        *(f32x4*)(xout + off + bj * 128 + n * 16) = xi + gv[bj][n] * acc[ai][bj][m][n]; } }
    }
};

struct Ctx {
    LAS unsigned char* lds; int tid, lane, wave, bid, G;
};
__device__ __forceinline__ void cvt_item(const float* W, int ldw, int K, int c0, bf16_t* WT, int r0, LAS float* scr, int item, int nblk, int lane) {
    const int kb = item / nblk, nb = item % nblk, k0 = 64 * kb, n0 = 32 * nb;
#pragma unroll
    for (int i = 0; i < 8; ++i) { const int kk = 8 * i + (lane >> 3), c4 = (lane & 7) * 4; const f32x4 v = *(const f32x4*)(W + (size_t)(k0 + kk) * ldw + c0 + n0 + c4);
        LAS float* d = scr + kk * 33 + c4; d[0] = v[0]; d[1] = v[1]; d[2] = v[2]; d[3] = v[3]; }
    WAVE_LDS_SYNC();
    const int c = lane & 7;
#pragma unroll
    for (int j = 0; j < 4; ++j) { const int n = (lane >> 3) + 8 * j; const LAS float* s = scr + (8 * c) * 33 + n;
        u32x4 o; o.x = pk2(s[0 * 33], s[1 * 33]); o.y = pk2(s[2 * 33], s[3 * 33]); o.z = pk2(s[4 * 33], s[5 * 33]); o.w = pk2(s[6 * 33], s[7 * 33]);
        *(u32x4*)(WT + (size_t)(r0 + n0 + n) * K + k0 + 8 * c) = o; }
    WAVE_LDS_SYNC();
}
__device__ __forceinline__ void cvt_seg(const Ctx& c, const float* W, int ldw, int K, int c0, int ncols, bf16_t* WT, int r0, int& base) {
    LAS float* scr = (LAS float*)(c.lds + c.wave * 16384);
    const int nblk = ncols / 32, nitems = (K / 64) * nblk, NGW = c.G * NWAVES, gw = c.bid * NWAVES + c.wave;
    int first = (gw - base) % NGW; if (first < 0) first += NGW;
    for (int it = first; it < nitems; it += NGW) cvt_item(W, ldw, K, c0, WT, r0, scr, it, nblk, c.lane);
    base = (base + nitems) % NGW;
}

struct CtxFix { const float* part; int prs, nsl; const float* gate; float* ctx_out; };
__device__ __forceinline__ void phase_hnorm(const Ctx& c, const float* xlat, const float* xctx, const float* w, const float* mod, int shift_blk, int scale_blk, bf16_t* H, int row_lo, int row_hi, const CtxFix fx = CtxFix{nullptr, 0, 0, nullptr, nullptr}) {
    const int gw = c.bid * NWAVES + c.wave, NGW = c.G * NWAVES;
    f32x4 wv[4];
#pragma unroll
    for (int j = 0; j < 4; ++j) wv[j] = *(const f32x4*)(w + 4 * c.lane + 256 * j);
    f32x4 nv[4];
    { const int r0 = row_lo + gw; if (r0 < row_hi) { const float* xr = r0 >= ML ? xctx + (size_t)(r0 - ML) * D : xlat + (size_t)r0 * D;
#pragma unroll
        for (int j = 0; j < 4; ++j) nv[j] = *(const f32x4*)(xr + 4 * c.lane + 256 * j); } }
    for (int row = row_lo + gw; row < row_hi; row += NGW) {
        const bool isctx = row >= ML;
        const float* mp = mod + (size_t)(isctx ? NB : row / SEQ) * NMOD;
        f32x4 v[4]; float s = 0.f;
#pragma unroll
        for (int j = 0; j < 4; ++j) v[j] = nv[j];
        { const int r1 = row + NGW; if (r1 < row_hi) { const float* xr = r1 >= ML ? xctx + (size_t)(r1 - ML) * D : xlat + (size_t)r1 * D;
#pragma unroll
            for (int j = 0; j < 4; ++j) nv[j] = *(const f32x4*)(xr + 4 * c.lane + 256 * j); } }
#pragma unroll
        for (int j = 0; j < 4; ++j) {
            if (isctx && fx.part) { f32x4 a = (f32x4){0.f, 0.f, 0.f, 0.f};
                for (int sl = 0; sl < fx.nsl; ++sl) a += *(const f32x4*)(fx.part + (size_t)(sl * MC + row - ML) * fx.prs + 4 * c.lane + 256 * j);
                v[j] += *(const f32x4*)(fx.gate + 4 * c.lane + 256 * j) * a;
                *(f32x4*)(fx.ctx_out + (size_t)(row - ML) * D + 4 * c.lane + 256 * j) = v[j]; }
            s += (v[j].x * v[j].x + v[j].y * v[j].y) + (v[j].z * v[j].z + v[j].w * v[j].w); }
        const float rs = 1.0f / sqrtf(wave_sum(s) * (1.0f / D) + EPS);
#pragma unroll
        for (int j = 0; j < 4; ++j) {
            const f32x4 sh = *(const f32x4*)(mp + shift_blk * D + 4 * c.lane + 256 * j), sc = *(const f32x4*)(mp + scale_blk * D + 4 * c.lane + 256 * j);
            const f32x4 o = v[j] * rs * wv[j] * (1.0f + sc) + sh;
            u32x2 pw; pw.x = pk2(o.x, o.y); pw.y = pk2(o.z, o.w);
            *(u32x2*)(H + (size_t)row * D + 4 * c.lane + 256 * j) = pw;
        }
    }
}

__device__ __forceinline__ void phase_mods(const Ctx& c, const Params& P) {
    float* mod = (float*)(gmem(P.ws_()) + WS_MOD);
    const float* cv = gmem(P.in_(I_C)); const float* cc = gmem(P.in_(I_CCTX)); const float* wm = gmem(P.in_(I_WMOD)); const float* bm = gmem(P.in_(I_BMOD));
    LAS float* sc = (LAS float*)c.lds;
    LAS float* pt = sc + (NB + 1) * D;
    for (int i = c.tid; i < (NB + 1) * D; i += NTHREADS) { const int r = i / D, k = i % D; sc[i] = siluf_(r < NB ? cv[r * D + k] : cc[k]); }
    __syncthreads();
    constexpr int NU = 2 * (NMOD / 64);
    for (int u = c.bid; u < NU; u += c.G) {
        const int l = u / (NMOD / 64), kq = c.lane >> 4, n4 = (c.lane & 15) * 4, k0 = c.wave * 128;
        const float* wcol = wm + (size_t)l * D * NMOD + (u % (NMOD / 64)) * 64 + n4;
        f32x4 acc[NB + 1];
#pragma unroll
        for (int i = 0; i <= NB; ++i) acc[i] = (f32x4){0.f, 0.f, 0.f, 0.f};
#pragma unroll 8
        for (int kk = 0; kk < 32; ++kk) { const int k = k0 + 4 * kk + kq; const f32x4 wv = *(const f32x4*)(wcol + (size_t)k * NMOD);
#pragma unroll
            for (int i = 0; i <= NB; ++i) acc[i] += sc[i * D + k] * wv; }
#pragma unroll
        for (int i = 0; i <= NB; ++i) {
#pragma unroll
            for (int e = 0; e < 4; ++e) { float v = acc[i][e]; v += __shfl_xor(v, 16); v += __shfl_xor(v, 32); acc[i][e] = v; }
            if (kq == 0) *(LAS f32x4*)(pt + (c.wave * (NB + 1) + i) * 64 + n4) = acc[i]; }
        __syncthreads();
        if (c.tid < (NB + 1) * 64) { const int r = c.tid >> 6, nn = c.tid & 63; float s = bm[(size_t)l * NMOD + (u % (NMOD / 64)) * 64 + nn];
#pragma unroll
            for (int w = 0; w < 8; ++w) s += pt[(w * (NB + 1) + r) * 64 + nn];
            mod[((size_t)l * (NB + 1) + r) * NMOD + (u % (NMOD / 64)) * 64 + nn] = s; }
        __syncthreads();
    }
}

namespace sc0 {
constexpr int NCT = CTX / 64 + SEQ / 64, NCC = CTX / 64;
__device__ __forceinline__ size_t chunk_row0(int b, int gch) { return gch < NCC ? (size_t)ML + (size_t)b * CTX + (size_t)gch * 64 : (size_t)b * SEQ + (size_t)(gch - NCC) * 64; }
__device__ __forceinline__ bf16_t* tctx_ptr(unsigned char* ws) { return (bf16_t*)(ws + WS_WA + 4 * MiB); }
__device__ __forceinline__ float* ssdv_row(unsigned char* ws, size_t row) { return row < (size_t)ML ? (float*)(ws + WS_CTXRES) + row * 64 : (float*)(ws + WS_GATES + 5 * MiB / 4) + (row - ML) * 64; }
__device__ __forceinline__ float* glaf_ptr(unsigned char* ws) { return (float*)(ws + WS_GATES); }
__device__ __forceinline__ bf16_t* halo_ptr(unsigned char* ws) { return (bf16_t*)(ws + WS_WB); }
static_assert((size_t)MC * 2048 * 2 <= 8 * MiB && (size_t)ML * 64 * 4 <= 4 * MiB && (size_t)NB * 8 * NCT * 128 * 4 <= 5 * MiB / 4 && (size_t)MC * 64 * 4 <= MiB / 4 && (size_t)NB * NCT * 2 * 1536 * 2 <= 6 * MiB, "layer-0 scan scratch");

constexpr int LQ = 136, LT = 72;
__device__ __forceinline__ bf16x8 frag(const LAS unsigned char* lds, int off, int ld, int row, int k) { return *(const LAS bf16x8*)(lds + off + (row * ld + k) * 2); }
__device__ __forceinline__ bf16x8 tr_frag(const LAS unsigned char* lds, int off, int ld, int k0, int n0, int fr, int fq) {
    typedef short v4i16_t __attribute__((ext_vector_type(4)));
    const LAS unsigned char* p0 = lds + off + ((k0 + 8 * fq + (fr >> 2)) * ld + n0 + 4 * (fr & 3)) * 2;
    const v4i16_t a = __builtin_amdgcn_ds_read_tr16_b64_v4i16((LAS v4i16_t*)p0), b = __builtin_amdgcn_ds_read_tr16_b64_v4i16((LAS v4i16_t*)(p0 + 4 * ld * 2));
    return (bf16x8){a[0], a[1], a[2], a[3], b[0], b[1], b[2], b[3]};
}

__device__ __forceinline__ void phase_prep0a(const Ctx& c, const Params& P) {
    const bf16_t* P0 = (const bf16_t*)(gmem(P.ws_()) + WS_BIG); bf16_t* HL = halo_ptr(gmem(P.ws_()));
    const int n = NB * NCT * 2 * (1536 / 8);
    for (int i = c.bid * NTHREADS + c.tid; i < n; i += c.G * NTHREADS) { const int piece = i % 192, which = (i / 192) & 1, u = i / 384, b = u / NCT, gch = u % NCT;
        const size_t row = chunk_row0(b, gch) + (which ? 63 : 0);
        *(u32x4*)(HL + (size_t)(u * 2 + which) * 1536 + piece * 8) = *(const u32x4*)(P0 + row * NP0 + C_XS + piece * 8); }
}
constexpr int PB_T = 0;
constexpr int PB_W = 66 * 776 * 2;
static_assert(PB_W + 4 * 768 * 4 <= PARAM_LDS_OFF, "prep0 LDS");
__device__ __forceinline__ void prep_ssd_unit(const Ctx& c, const Params& P, int b, int gch) {
    LAS unsigned char* lds = c.lds; const int tid = c.tid, lane = c.lane, w = c.wave;
    bf16_t* P0 = (bf16_t*)(gmem(P.ws_()) + WS_BIG); const bf16_t* HL = halo_ptr(gmem(P.ws_()));
    const size_t row0 = chunk_row0(b, gch); const int isctx = gch < NCC; const int u = b * NCT + gch;
    const bool hasprev = gch != 0 && gch != NCC, hasnext = gch != NCC - 1 && gch != NCT - 1;
    LAS float* cwl = (LAS float*)(lds + PB_W);
    for (int half = 0; half < 2; ++half) {
        const int col0 = half * 768;
        { float wreg[6];
#pragma unroll
          for (int k = 0; k < 6; ++k) { const int i = tid + k * NTHREADS, tap = i / 768, cc = i % 768; wreg[k] = tap < 3 ? gmem(P.in_(I_ACW))[tap * 1536 + col0 + cc] : gmem(P.in_(I_ACB))[col0 + cc]; }
          u32x4 treg[13];
#pragma unroll
          for (int k = 0; k < 13; ++k) { const int i = tid + k * NTHREADS, r = i / 96, pc = i % 96; u32x4 v = (u32x4){0u, 0u, 0u, 0u};
              if (i < 66 * 96) {
                  if (r == 0) { if (hasprev) v = *(const u32x4*)(HL + (size_t)((u - 1) * 2 + 1) * 1536 + col0 + pc * 8); }
                  else if (r == 65) { if (hasnext) v = *(const u32x4*)(HL + (size_t)((u + 1) * 2 + 0) * 1536 + col0 + pc * 8); }
                  else v = *(const u32x4*)(P0 + (row0 + r - 1) * NP0 + C_XS + col0 + pc * 8); }
              treg[k] = v; }
#pragma unroll
          for (int k = 0; k < 6; ++k) cwl[tid + k * NTHREADS] = wreg[k];
#pragma unroll
          for (int k = 0; k < 13; ++k) { const int i = tid + k * NTHREADS, r = i / 96, pc = i % 96; if (i < 66 * 96) *(LAS u32x4*)(lds + PB_T + (r * 776 + pc * 8) * 2) = treg[k]; } }
        __syncthreads();
#pragma unroll 4
        for (int i = tid; i < 64 * 96; i += NTHREADS) { const int r = i / 96, pc = i % 96;
            const u32x4 a = *(const LAS u32x4*)(lds + PB_T + (r * 776 + pc * 8) * 2), m = *(const LAS u32x4*)(lds + PB_T + ((r + 1) * 776 + pc * 8) * 2), n = *(const LAS u32x4*)(lds + PB_T + ((r + 2) * 776 + pc * 8) * 2);
            const unsigned aw[4] = {a.x, a.y, a.z, a.w}, mw[4] = {m.x, m.y, m.z, m.w}, nw[4] = {n.x, n.y, n.z, n.w}; unsigned o[4];
            const LAS f32x4* cw4 = (const LAS f32x4*)(cwl + pc * 8);
            const f32x4 t0[2] = {cw4[0], cw4[1]}, t1[2] = {cw4[192], cw4[193]}, t2[2] = {cw4[384], cw4[385]}, tb[2] = {cw4[576], cw4[577]};
#pragma unroll
            for (int e = 0; e < 4; ++e) { const int hh = e >> 1, j = 2 * (e & 1);
                const float y0 = siluf_(t0[hh][j] * bflo(aw[e]) + t1[hh][j] * bflo(mw[e]) + t2[hh][j] * bflo(nw[e]) + tb[hh][j]);
                const float y1 = siluf_(t0[hh][j + 1] * bfhi(aw[e]) + t1[hh][j + 1] * bfhi(mw[e]) + t2[hh][j + 1] * bfhi(nw[e]) + tb[hh][j + 1]);
                o[e] = pk2(y0, y1); }
            *(u32x4*)(P0 + (row0 + r) * NP0 + C_XS + col0 + pc * 8) = (u32x4){o[0], o[1], o[2], o[3]}; }
        __syncthreads();
    }
#pragma unroll
    for (int q = 0; q < 4; ++q) { const int dh = w * 4 + q, dir = dh >> 4, h = dh & 15; const size_t row = row0 + (dir ? 63 - lane : lane);
        const float dt = softplusf_(bf2f(P0[row * NP0 + C_DT + dh]) + gmem(P.in_(I_ADTB))[dh]); float v = -dt * __expf(gmem(P.in_(I_AALOG))[dh]);
#pragma unroll
        for (int o = 1; o < 64; o <<= 1) { const float uu = __shfl(v, lane >= o ? lane - o : lane); if (lane >= o) v += uu; }
        *(f32x2*)(ssdv_row(gmem(P.ws_()), row) + dh * 2) = (f32x2){dt, v}; (void)h; }
    (void)isctx;
}
constexpr int PG_LA = 0;
constexpr int PG_PART = PG_LA + 64 * 128 * 4;
constexpr int PG_R = PG_PART + 4 * 128 * 4;
constexpr int PG_WG = PG_R + 64 * 40 * 2;
constexpr int PG_BG = PG_WG + 128 * 40 * 2;
constexpr int PG_DIR = PG_BG + 128 * 4;
static_assert(2 * PG_DIR <= PARAM_LDS_OFF && PG_DIR % 16 == 0, "prep0 GLA LDS");
__device__ __forceinline__ void prep_gla_unit(const Ctx& c, const Params& P, int b, int gch, int h) {
    LAS unsigned char* lds = c.lds; const int tid = c.tid, lane = c.lane, w = c.wave, fr = lane & 15, fq = lane >> 4, ti_ = tid >> 3, seg = tid & 7;
    bf16_t* P0 = (bf16_t*)(gmem(P.ws_()) + WS_BIG); float* GF = glaf_ptr(gmem(P.ws_()));
    const size_t row0 = chunk_row0(b, gch);
    { const bf16_t* wg0 = (const bf16_t*)(gmem(P.ws_()) + WS_GATES + 7 * MiB / 4) + (size_t)h * 128 * 32;
      int tq = tid; OPAQUE_V(tq);
#pragma unroll
      for (int dir = 0; dir < 2; ++dir)
          *(LAS u32x4*)(lds + dir * PG_DIR + PG_WG + ((tq >> 2) * 40 + (tq & 3) * 8) * 2) = *(const u32x4*)(wg0 + (size_t)dir * 4 * 128 * 32 + (tq >> 2) * 32 + (tq & 3) * 8);
      if (tid < 256) { const int dir = tid >> 7, kk = tid & 127; ((LAS float*)(lds + dir * PG_DIR + PG_BG))[kk] = gmem(P.in_(I_AGB))[dir * 512 + h * 128 + kk]; }
      { const int dir = seg >> 2, s4 = seg & 3; u32x4 v = (u32x4){0u, 0u, 0u, 0u};
        if (s4 < 2) { const size_t rr = row0 + (dir ? 63 - ti_ : ti_); v = *(const u32x4*)(P0 + rr * NP0 + C_R + dir * 16 + s4 * 8); }
        *(LAS u32x4*)(lds + dir * PG_DIR + PG_R + (ti_ * 40 + s4 * 8) * 2) = v; } }
    __syncthreads();
    { const int ti = w >> 1;
#pragma unroll
      for (int dir = 0; dir < 2; ++dir) { const int dof = dir * PG_DIR; LAS float* la = (LAS float*)(lds + dof + PG_LA); const LAS float* bgl = (const LAS float*)(lds + dof + PG_BG);
          const bf16x8 a = frag(lds, dof + PG_R, 40, ti * 16 + fr, 8 * fq);
#pragma unroll
          for (int q = 0; q < 4; ++q) { const int tk = 4 * (w & 1) + q; const bf16x8 bb = frag(lds, dof + PG_WG, 40, tk * 16 + fr, 8 * fq);
              f32x4 acc = (f32x4){0.f, 0.f, 0.f, 0.f}; acc = __builtin_amdgcn_mfma_f32_16x16x32_bf16(a, bb, acc, 0, 0, 0);
              const float bg = bgl[tk * 16 + fr];
#pragma unroll
              for (int r = 0; r < 4; ++r) la[(ti * 16 + 4 * fq + r) * 128 + tk * 16 + fr] = log_sigmoidf_(acc[r] + bg) * (1.0f / 16.0f); } } }
    __syncthreads();
    const bf16_t* prow = P0 + (row0 + ti_) * NP0;
    const u32x4 q0 = *(const u32x4*)(prow + C_Q + h * 128 + seg * 16), q1 = *(const u32x4*)(prow + C_Q + h * 128 + seg * 16 + 8);
    const u32x4 k0 = *(const u32x4*)(prow + C_K + h * 128 + seg * 16), k1 = *(const u32x4*)(prow + C_K + h * 128 + seg * 16 + 8);
    const unsigned qw[8] = {q0.x, q0.y, q0.z, q0.w, q1.x, q1.y, q1.z, q1.w}, kw[8] = {k0.x, k0.y, k0.z, k0.w, k1.x, k1.y, k1.z, k1.w};
    { const int kk = tid & 127, qd = tid >> 7;
#pragma unroll
      for (int dir = 0; dir < 2; ++dir) { LAS float* la = (LAS float*)(lds + dir * PG_DIR + PG_LA); float run = 0.f;
#pragma unroll
          for (int r = 0; r < 16; ++r) { run += la[(qd * 16 + r) * 128 + kk]; la[(qd * 16 + r) * 128 + kk] = run; }
          ((LAS float*)(lds + dir * PG_DIR + PG_PART))[qd * 128 + kk] = run; } }
    __syncthreads();
    { const int kk = tid & 127, qd = tid >> 7;
      if (qd > 0) {
#pragma unroll
          for (int dir = 0; dir < 2; ++dir) { LAS float* la = (LAS float*)(lds + dir * PG_DIR + PG_LA); const LAS float* part = (const LAS float*)(lds + dir * PG_DIR + PG_PART); float offv = 0.f;
              for (int q = 0; q < qd; ++q) offv += part[q * 128 + kk];
#pragma unroll
              for (int r = 0; r < 16; ++r) la[(qd * 16 + r) * 128 + kk] += offv; } } }
    __syncthreads();
#pragma nounroll
    for (int dir = 0; dir < 2; ++dir) { const LAS float* la = (const LAS float*)(lds + dir * PG_DIR + PG_LA);
        const int li = dir ? 63 - ti_ : ti_; unsigned qo[8], ko[8];
#pragma unroll
        for (int e = 0; e < 8; ++e) { const float g0 = la[li * 128 + seg * 16 + 2 * e], g1 = la[li * 128 + seg * 16 + 2 * e + 1]; const float e0 = __expf(g0), e1 = __expf(g1);
            qo[e] = pk2(bflo(qw[e]) * e0 * 0.08838834764831845f, bfhi(qw[e]) * e1 * 0.08838834764831845f); ko[e] = pk2(bflo(kw[e]) * __expf(-g0), bfhi(kw[e]) * __expf(-g1)); }
        bf16_t* qd_ = P0 + (row0 + ti_) * NP0 + (dir ? C_Q : 0) + h * 128 + seg * 16;
        bf16_t* kd_ = P0 + (row0 + ti_) * NP0 + (dir ? C_K : 512) + h * 128 + seg * 16;
        *(u32x4*)qd_ = (u32x4){qo[0], qo[1], qo[2], qo[3]}; *(u32x4*)(qd_ + 8) = (u32x4){qo[4], qo[5], qo[6], qo[7]};
        *(u32x4*)kd_ = (u32x4){ko[0], ko[1], ko[2], ko[3]}; *(u32x4*)(kd_ + 8) = (u32x4){ko[4], ko[5], ko[6], ko[7]}; }
    if (tid < 256) { const int dir = tid >> 7, kk = tid & 127; GF[((size_t)((b * 4 + h) * 2 + dir) * NCT + gch) * 128 + kk] = __expf(((const LAS float*)(lds + dir * PG_DIR + PG_LA))[63 * 128 + kk]); }
    __syncthreads();
}
__device__ __forceinline__ void phase_prep0b(const Ctx& c, const Params& P) {
    const int nssd = NB * NCT, nu = nssd * 5;
    unsigned* ctr = (unsigned*)(gmem(P.ws_()) + WS_CTL + 16384);
    volatile LAS unsigned* slot = (volatile LAS unsigned*)(c.lds + PARAM_LDS_OFF + 384);
    for (;;) {
        if (c.tid == 0) *slot = atomicAdd(ctr, 1u);
        __syncthreads();
        const int q = (int)__builtin_amdgcn_readfirstlane(*slot);
        __syncthreads();
        if (q >= nu) break;
        if (q < nssd) prep_ssd_unit(c, P, q / NCT, q % NCT);
        else { const int g = q - nssd, bc = g >> 2; prep_gla_unit(c, P, bc / NCT, bc % NCT, g & 3); }
    }
}

constexpr int O_Q = 0;
constexpr int O_K = O_Q + 64 * LQ * 2;
constexpr int O_V = O_K + 64 * LQ * 2;
constexpr int O_VW = O_V + 64 * LT * 2;
constexpr int O_S = O_VW + 64 * LT * 2;
constexpr int O_ST = O_S + 64 * LT * 2;
constexpr int O_OST = O_ST + 64 * LQ * 2;
constexpr int O_VEC = O_OST + 64 * 68 * 4;
constexpr int O_END = O_VEC + 320 * 4;
static_assert(O_END <= PARAM_LDS_OFF, "scan0 LDS");

template <bool SSD>
__device__ __forceinline__ void chain(const Ctx& c, const Params& P, int dir, int b, int h, int vb) {
    const int tid = c.tid, lane = c.lane, w = c.wave, fr = lane & 15, fq = lane >> 4, ti_ = tid >> 3, seg = tid & 7;
    unsigned char* wsb = gmem(P.ws_());
    const bf16_t* P0 = (const bf16_t*)(wsb + WS_BIG); const float* GF = glaf_ptr(wsb);
    bf16_t* T_lat = (bf16_t*)gmem(P.out_()); bf16_t* T_ctx = tctx_ptr(wsb);
    const int vcol = SSD ? C_XS + h * 64 : C_V + h * 256 + vb * 64, tcol = SSD ? 1024 + h * 64 : h * 256 + vb * 64, dh = dir * 16 + h;
    f32x4 st[4];
#pragma unroll
    for (int t = 0; t < 4; ++t) st[t] = (f32x4){0.f, 0.f, 0.f, 0.f};
    for (int i = tid; i < 64 * LQ / 2; i += NTHREADS) ((LAS unsigned*)(c.lds + O_ST))[i] = 0u;
    __syncthreads();
    u32x4 pa0, pa1, pb0, pb1, pvv, ptt = (u32x4){0u, 0u, 0u, 0u}; f32x2 pdg = (f32x2){0.f, 0.f}; float pgl = 0.f, pgf = 0.f;
#define SC0_GCH(ci_) (dir ? ((ci_) < NCC ? NCC - 1 - (ci_) : NCT - 1 - ((ci_) - NCC)) : (ci_))
#define SC0_PREFETCH(ci_) do { const int g_ = SC0_GCH(ci_); const size_t r0_ = chunk_row0(b, g_), row_ = r0_ + (dir ? 63 - ti_ : ti_); \
        const bf16_t* qs_ = P0 + row_ * NP0 + (SSD ? C_C + (h >> 3) * 128 : (dir ? C_Q : 0) + h * 128); \
        const bf16_t* ks_ = P0 + row_ * NP0 + (SSD ? C_B + (h >> 3) * 128 : (dir ? C_K : 512) + h * 128); \
        pa0 = *(const u32x4*)(qs_ + seg * 16); pa1 = *(const u32x4*)(qs_ + seg * 16 + 8); pb0 = *(const u32x4*)(ks_ + seg * 16); pb1 = *(const u32x4*)(ks_ + seg * 16 + 8); \
        pvv = *(const u32x4*)(P0 + row_ * NP0 + vcol + seg * 8); \
        if (SSD) { pdg = *(const f32x2*)(ssdv_row(wsb, row_) + dh * 2); pgl = ssdv_row(wsb, r0_ + (dir ? 0 : 63))[dh * 2 + 1]; } \
        else if (tid < 128) pgf = GF[((size_t)((b * 4 + h) * 2 + dir) * NCT + g_) * 128 + tid]; \
        if (dir) ptt = *(const u32x4*)((g_ < NCC ? T_ctx + (row_ - ML) * 2048 : T_lat + row_ * 2048) + tcol + seg * 8); } while (0)
    SC0_PREFETCH(0);
    for (int ci = 0; ci < NCT; ++ci) {
        LAS unsigned char* lds = c.lds; LAS float* vec = (LAS float*)(lds + O_VEC);
        const int gch = SC0_GCH(ci);
        const int isctx = gch < NCC;
        const size_t row0 = chunk_row0(b, gch), row = row0 + (dir ? 63 - ti_ : ti_);
        const u32x4 cur_t = ptt;
        { *(LAS u32x4*)(lds + O_Q + (ti_ * LQ + seg * 16) * 2) = pa0; *(LAS u32x4*)(lds + O_Q + (ti_ * LQ + seg * 16 + 8) * 2) = pa1;
          *(LAS u32x4*)(lds + O_K + (ti_ * LQ + seg * 16) * 2) = pb0; *(LAS u32x4*)(lds + O_K + (ti_ * LQ + seg * 16 + 8) * 2) = pb1;
          *(LAS u32x4*)(lds + O_V + (ti_ * LT + seg * 8) * 2) = pvv;
          if (SSD) { const float kf = pdg[0] * __expf(pgl - pdg[1]); const u32x4 vv = pvv;
              u32x4 xw; xw.x = pk2(bflo(vv.x) * kf, bfhi(vv.x) * kf); xw.y = pk2(bflo(vv.y) * kf, bfhi(vv.y) * kf); xw.z = pk2(bflo(vv.z) * kf, bfhi(vv.z) * kf); xw.w = pk2(bflo(vv.w) * kf, bfhi(vv.w) * kf);
              *(LAS u32x4*)(lds + O_VW + (ti_ * LT + seg * 8) * 2) = xw;
              if (seg == 0) { vec[128 + ti_] = pdg[1]; vec[192 + ti_] = pdg[0]; vec[256 + ti_] = __expf(pdg[1]); } }
          else if (tid < 128) vec[tid] = pgf; }
        if (ci + 1 < NCT) SC0_PREFETCH(ci + 1);
        LDS_BARRIER();
        typedef short v4i16_t __attribute__((ext_vector_type(4)));
#define SC0_TR(p_, off_, ld_) ({ const v4i16_t t0_ = __builtin_amdgcn_ds_read_tr16_b64_v4i16((LAS v4i16_t*)((p_) + (off_))), t1_ = __builtin_amdgcn_ds_read_tr16_b64_v4i16((LAS v4i16_t*)((p_) + (off_) + 4 * (ld_) * 2)); \
        (bf16x8){t0_[0], t0_[1], t0_[2], t0_[3], t1_[0], t1_[1], t1_[2], t1_[3]}; })
        const int ti = w >> 1, hb = w & 1;
        bf16x8 qa[4];
        { bf16x8 kf[2][4];
          const LAS unsigned char* pq = lds + O_Q + ((ti * 16 + fr) * LQ + 8 * fq) * 2; const LAS unsigned char* pk = lds + O_K + ((hb * 32 + fr) * LQ + 8 * fq) * 2;
#pragma unroll
          for (int kq = 0; kq < 4; ++kq) qa[kq] = *(const LAS bf16x8*)(pq + kq * 64);
#pragma unroll
          for (int q = 0; q < 2; ++q)
#pragma unroll
              for (int kq = 0; kq < 4; ++kq) kf[q][kq] = *(const LAS bf16x8*)(pk + q * 16 * LQ * 2 + kq * 64);
          SCHED_FENCE();
#pragma unroll
          for (int q = 0; q < 2; ++q) { const int tj = 2 * hb + q; f32x4 acc = (f32x4){0.f, 0.f, 0.f, 0.f};
              if (tj <= ti) {
#pragma unroll
                  for (int kq = 0; kq < 4; ++kq) acc = __builtin_amdgcn_mfma_f32_16x16x32_bf16(kf[q][kq], qa[kq], acc, 0, 0, 0); }
              const int i = ti * 16 + fr; float s4[4];
#pragma unroll
              for (int r = 0; r < 4; ++r) { const int j = tj * 16 + 4 * fq + r; float s = (j <= i) ? acc[r] : 0.f;
                  if (SSD) s *= vec[192 + j] * __expf(fminf(vec[128 + i] - vec[128 + j], 0.f));
                  s4[r] = s; }
              *(LAS u32x2*)(lds + O_S + (i * LT + tj * 16 + 4 * fq) * 2) = (u32x2){pk2(s4[0], s4[1]), pk2(s4[2], s4[3])}; } }
        LDS_BARRIER();
        f32x4 U[4];
        { bf16x8 sa[2], vt[2][2], stf[2][4], ka[2], vu[4][2];
          const LAS unsigned char* ps = lds + O_S + ((ti * 16 + fr) * LT + 8 * fq) * 2;
          const LAS unsigned char* pvt = lds + O_V + ((8 * fq + (fr >> 2)) * LT + hb * 32 + 4 * (fr & 3)) * 2;
          const LAS unsigned char* pst = lds + O_ST + ((hb * 32 + fr) * LQ + 8 * fq) * 2;
          const LAS unsigned char* pkt = lds + O_K + ((8 * fq + (fr >> 2)) * LQ + w * 16 + 4 * (fr & 3)) * 2;
          const LAS unsigned char* pvu = lds + (SSD ? O_VW : O_V) + ((8 * fq + (fr >> 2)) * LT + 4 * (fr & 3)) * 2;
#pragma unroll
          for (int kq = 0; kq < 2; ++kq) sa[kq] = *(const LAS bf16x8*)(ps + kq * 64);
#pragma unroll
          for (int q = 0; q < 2; ++q) {
#pragma unroll
              for (int kq = 0; kq < 2; ++kq) vt[q][kq] = SC0_TR(pvt, kq * 32 * LT * 2 + q * 32, LT);
#pragma unroll
              for (int kq = 0; kq < 4; ++kq) stf[q][kq] = *(const LAS bf16x8*)(pst + q * 16 * LQ * 2 + kq * 64); }
#pragma unroll
          for (int kq = 0; kq < 2; ++kq) ka[kq] = SC0_TR(pkt, kq * 32 * LQ * 2, LQ);
#pragma unroll
          for (int t = 0; t < 4; ++t)
#pragma unroll
              for (int kq = 0; kq < 2; ++kq) vu[t][kq] = SC0_TR(pvu, kq * 32 * LT * 2 + t * 32, LT);
          SCHED_FENCE();
          LAS float* ost = (LAS float*)(lds + O_OST);
#pragma unroll
          for (int q = 0; q < 2; ++q) { const int tv = 2 * hb + q; f32x4 a1 = (f32x4){0.f, 0.f, 0.f, 0.f}, a2 = (f32x4){0.f, 0.f, 0.f, 0.f};
#pragma unroll
              for (int kq = 0; kq < 2; ++kq) a1 = __builtin_amdgcn_mfma_f32_16x16x32_bf16(sa[kq], vt[q][kq], a1, 0, 0, 0);
#pragma unroll
              for (int kq = 0; kq < 4; ++kq) a2 = __builtin_amdgcn_mfma_f32_16x16x32_bf16(qa[kq], stf[q][kq], a2, 0, 0, 0);
#pragma unroll
              for (int r = 0; r < 4; ++r) { const int i = ti * 16 + 4 * fq + r; ost[i * 68 + tv * 16 + fr] = a1[r] + (SSD ? vec[256 + i] : 1.f) * a2[r]; } }
#pragma unroll
          for (int t = 0; t < 4; ++t) { f32x4 u = (f32x4){0.f, 0.f, 0.f, 0.f};
#pragma unroll
              for (int kq = 0; kq < 2; ++kq) u = __builtin_amdgcn_mfma_f32_16x16x32_bf16(ka[kq], vu[t][kq], u, 0, 0, 0);
              U[t] = u; } }
#undef SC0_TR
        float fk[4];
#pragma unroll
        for (int r = 0; r < 4; ++r) fk[r] = SSD ? vec[256 + 63] : vec[w * 16 + 4 * fq + r];
        LDS_BARRIER();
#pragma unroll
        for (int t = 0; t < 4; ++t) {
#pragma unroll
            for (int r = 0; r < 4; ++r) st[t][r] = SSD ? fk[r] * st[t][r] + U[t][r] : fk[r] * (st[t][r] + U[t][r]);
            *(LAS u32x2*)(lds + O_ST + ((t * 16 + fr) * LQ + w * 16 + 4 * fq) * 2) = (u32x2){pk2(st[t][0], st[t][1]), pk2(st[t][2], st[t][3])}; }
        { bf16_t* T = isctx ? T_ctx + (row - ML) * 2048 : T_lat + row * 2048; bf16_t* tp = T + tcol + seg * 8;
          const LAS float* ost = (const LAS float*)(lds + O_OST) + ti_ * 68 + seg * 8; float o[8];
#pragma unroll
          for (int e = 0; e < 8; ++e) o[e] = ost[e];
          if (dir) { const u32x4 pv = cur_t; o[0] += bflo(pv.x); o[1] += bfhi(pv.x); o[2] += bflo(pv.y); o[3] += bfhi(pv.y); o[4] += bflo(pv.z); o[5] += bfhi(pv.z); o[6] += bflo(pv.w); o[7] += bfhi(pv.w); }
          *(u32x4*)tp = (u32x4){pk2(o[0], o[1]), pk2(o[2], o[3]), pk2(o[4], o[5]), pk2(o[6], o[7])}; }
    }
    __syncthreads();
#undef SC0_GCH
#undef SC0_PREFETCH
}
}

__device__ __forceinline__ void phase_scan0(const Ctx& c, const Params& P, int dir, int nblk) {
    const int nitems = NB * 32;
    for (int it = c.bid; it < nitems; it += nblk) {
        const int b = it / 32, r = it % 32;
        if (r < 16) sc0::chain<false>(c, P, dir, b, r >> 2, r & 3);
        else sc0::chain<true>(c, P, dir, b, r - 16, 0);
        __syncthreads();
    }
}

__device__ __forceinline__ void phase_post0(const Ctx& c, const Params& P) {
    bf16_t* P0 = (bf16_t*)(gmem(P.ws_()) + WS_BIG);
    const bf16_t* T_lat = (const bf16_t*)gmem(P.out_()); const bf16_t* T_ctx = sc0::tctx_ptr(gmem(P.ws_()));
    const int gw = c.bid * NWAVES + c.wave, NGW = c.G * NWAVES, lane = c.lane;
    const float* gn = gmem(P.in_(I_AGN)); const float* sn = gmem(P.in_(I_ASN));
    const float dsk = gmem(P.in_(I_AD))[lane >> 2];
    f32x4 gnv[4], snv[4];
#pragma unroll
    for (int q = 0; q < 4; ++q) { gnv[q] = *(const f32x4*)(gn + ((16 * lane) & 255) + 4 * q); snv[q] = *(const f32x4*)(sn + 16 * lane + 4 * q); }
    for (int row = gw; row < MT; row += NGW) {
        const bool isctx = row >= ML;
        const bf16_t* T = isctx ? T_ctx + (size_t)(row - ML) * 2048 : T_lat + (size_t)row * 2048;
        bf16_t* pr = P0 + (size_t)row * NP0;
        {   const u32x4 t0 = *(const u32x4*)(T + 16 * lane), t1 = *(const u32x4*)(T + 16 * lane + 8);
            const u32x4 g0 = *(const u32x4*)(pr + C_G + 16 * lane), g1 = *(const u32x4*)(pr + C_G + 16 * lane + 8);
            const unsigned tw[8] = {t0.x, t0.y, t0.z, t0.w, t1.x, t1.y, t1.z, t1.w}, gq[8] = {g0.x, g0.y, g0.z, g0.w, g1.x, g1.y, g1.z, g1.w};
            float tv[16], ss = 0.f;
#pragma unroll
            for (int e = 0; e < 8; ++e) { tv[2 * e] = bflo(tw[e]); tv[2 * e + 1] = bfhi(tw[e]); ss += tv[2 * e] * tv[2 * e] + tv[2 * e + 1] * tv[2 * e + 1]; }
            ss += __shfl_xor(ss, 1); ss += __shfl_xor(ss, 2); ss += __shfl_xor(ss, 4); ss += __shfl_xor(ss, 8);
            const float rs = 1.0f / sqrtf(ss * (1.0f / 256.0f) + EPS);
            unsigned o[8];
#pragma unroll
            for (int e = 0; e < 8; ++e) o[e] = pk2(tv[2 * e] * rs * gnv[e >> 1][2 * (e & 1)] * siluf_(bflo(gq[e])), tv[2 * e + 1] * rs * gnv[e >> 1][2 * (e & 1) + 1] * siluf_(bfhi(gq[e])));
            *(u32x4*)(pr + C_G + 16 * lane) = (u32x4){o[0], o[1], o[2], o[3]}; *(u32x4*)(pr + C_G + 16 * lane + 8) = (u32x4){o[4], o[5], o[6], o[7]}; }
        {   const u32x4 t0 = *(const u32x4*)(T + 1024 + 16 * lane), t1 = *(const u32x4*)(T + 1024 + 16 * lane + 8);
            const u32x4 z0 = *(const u32x4*)(pr + C_Z + 16 * lane), z1 = *(const u32x4*)(pr + C_Z + 16 * lane + 8);
            const u32x4 b0 = *(const u32x4*)(pr + C_XS + 16 * lane), b1 = *(const u32x4*)(pr + C_XS + 16 * lane + 8);
            const unsigned tw[8] = {t0.x, t0.y, t0.z, t0.w, t1.x, t1.y, t1.z, t1.w}, zq[8] = {z0.x, z0.y, z0.z, z0.w, z1.x, z1.y, z1.z, z1.w};
            const unsigned a_[8] = {b0.x, b0.y, b0.z, b0.w, b1.x, b1.y, b1.z, b1.w};
            float y[16], ss = 0.f;
#pragma unroll
            for (int e = 0; e < 16; ++e) { const int wi = e >> 1; const bool hi = e & 1;
                const float xs = hi ? bfhi(a_[wi]) : bflo(a_[wi]);
                const float tvv = hi ? bfhi(tw[wi]) : bflo(tw[wi]), zv = hi ? bfhi(zq[wi]) : bflo(zq[wi]);
                y[e] = (tvv + xs * dsk) * siluf_(zv); ss += y[e] * y[e]; }
            ss += __shfl_xor(ss, 1); ss += __shfl_xor(ss, 2); ss += __shfl_xor(ss, 4); ss += __shfl_xor(ss, 8); ss += __shfl_xor(ss, 16);
            const float rs = 1.0f / sqrtf(ss * (1.0f / 512.0f) + EPS);
            unsigned o[8];
#pragma unroll
            for (int e = 0; e < 8; ++e) o[e] = pk2(y[2 * e] * rs * snv[e >> 1][2 * (e & 1)], y[2 * e + 1] * rs * snv[e >> 1][2 * (e & 1) + 1]);
            *(u32x4*)(pr + C_Z + 16 * lane) = (u32x4){o[0], o[1], o[2], o[3]}; *(u32x4*)(pr + C_Z + 16 * lane + 8) = (u32x4){o[4], o[5], o[6], o[7]}; }
    }
}

__device__ __forceinline__ int row_of(int isctx, int b, int p) { return isctx ? ML + b * CTX + p : b * SEQ + (p % GROWS) * GW + p / GROWS; }

__device__ __forceinline__ void build_gate_weights(const Ctx& c, const Params& P, bf16_t* WG) {
    const float* wq = gmem(P.in_(I_BWQ)); const float* wk = gmem(P.in_(I_BWK)); const float* wv = gmem(P.in_(I_BWV)); const float* wif = gmem(P.in_(I_BWIF));
    for (int idx = c.bid * NTHREADS + c.tid; idx < 256 * 4096; idx += c.G * NTHREADS) {
        const int g = idx >> 12, cc = idx & 4095; float v = 0.f;
        if (g < 16) { const int dir = g >> 3, gi = g & 7; const float* wd = wif + (size_t)dir * 6144 * 8;
            if (cc < 2048) { const int n = cc >> 2, dp = cc & 3;
#pragma unroll
                for (int e = 0; e < 4; ++e) v += wv[n * 16 + dp * 4 + e] * wd[(size_t)(4096 + 4 * n + e) * 8 + gi]; }
            else { const int c2 = cc - 2048, n = c2 >> 2, dp = c2 & 3;
#pragma unroll
                for (int e = 0; e < 4; ++e) v += wq[n * 16 + dp * 4 + e] * wd[(size_t)(4 * n + e) * 8 + gi] + wk[n * 16 + dp * 4 + e] * wd[(size_t)(2048 + 4 * n + e) * 8 + gi]; } }
        WG[idx] = (bf16_t)f2bf(v);
    }
}
__device__ __forceinline__ void build_mblocks(const Ctx& c, const Params& P, float* MB) {
    const float* wq = gmem(P.in_(I_BWQ)); const float* wk = gmem(P.in_(I_BWK));
    for (int idx = c.bid * NTHREADS + c.tid; idx < 512 * 16; idx += c.G * NTHREADS) { const int n = idx >> 4, dp = (idx >> 2) & 3, e = idx & 3; float v = 0.f;
#pragma unroll
        for (int x = 0; x < 4; ++x) v += wq[n * 16 + dp * 4 + x] * wk[n * 16 + e * 4 + x];
        MB[idx] = v * 0.04419417382415922f; }
}
constexpr int GATE_NSL = 3;
__device__ __forceinline__ float* gates_ptr(unsigned char* ws) { return (float*)(ws + WS_H + 26 * MiB); }
static_assert(26 * MiB + (size_t)GATE_NSL * MT * 64 <= 34 * MiB, "gate partial slabs");
struct EpiGates {
    static constexpr bool PERM = false;
    float* G;
    __device__ __forceinline__ void operator()(const f32x4 (&acc)[2][2][4][2], const pg8::Unit& u, int wr, int wc, int fr, int fq) const {
        if (wc != 0 || u.pn != 0) return;
        float* Gs = G + (size_t)(u.sl < 0 ? 0 : u.sl) * MT * 16;
#pragma unroll
        for (int ai = 0; ai < 2; ++ai)
#pragma unroll
            for (int m = 0; m < 4; ++m) { const int row = u.pm * 256 + ai * 128 + wr * 64 + m * 16 + fr; *(f32x4*)(Gs + (size_t)row * 16 + 4 * fq) = acc[ai][0][m][0]; }
    }
};
__device__ __forceinline__ void phase_prep1(const Ctx& c, const Params& P) {
    bf16_t* XMC = (bf16_t*)(gmem(P.ws_()) + WS_BIG);
    const float* cw = gmem(P.in_(I_BCW)); const float* cb = gmem(P.in_(I_BCB));
    const int gw = c.bid * NWAVES + c.wave, NGW = c.G * NWAVES, lane = c.lane;
    f32x4 w0[8], w1[8], w2[8], wb[8];
#pragma unroll
    for (int q = 0; q < 8; ++q) { w0[q] = *(const f32x4*)(cw + 32 * lane + 4 * q); w1[q] = *(const f32x4*)(cw + 2048 + 32 * lane + 4 * q); w2[q] = *(const f32x4*)(cw + 4096 + 32 * lane + 4 * q); wb[q] = *(const f32x4*)(cb + 32 * lane + 4 * q); }
    constexpr int RPW_DEN = 1;
    const int rpw = (MT + NGW - 1) / NGW, s0 = gw * rpw, s1 = (s0 + rpw < MT) ? s0 + rpw : MT; (void)RPW_DEN;
    auto rowof = [](int s_, int& row_, bool& first_, bool& last_) { if (s_ < ML) { const int b = s_ / SEQ, p = s_ % SEQ; row_ = b * SEQ + (p % GROWS) * GW + p / GROWS; first_ = p == 0; last_ = p == SEQ - 1; }
                                                                  else { const int p = (s_ - ML) % CTX; row_ = s_; first_ = p == 0; last_ = p == CTX - 1; } };
    u32x4 pv[4], cv[4], nv[4];
    if (s0 < s1) { int r0, rm; bool f0, l0, fm, lm; rowof(s0, r0, f0, l0);
#pragma unroll
        for (int q = 0; q < 4; ++q) cv[q] = *(const u32x4*)(XMC + (size_t)r0 * 4096 + 32 * lane + 8 * q);
        if (!f0) { rowof(s0 - 1, rm, fm, lm);
#pragma unroll
            for (int q = 0; q < 4; ++q) pv[q] = *(const u32x4*)(XMC + (size_t)rm * 4096 + 32 * lane + 8 * q); }
        else {
#pragma unroll
            for (int q = 0; q < 4; ++q) pv[q] = (u32x4){0u, 0u, 0u, 0u}; } }
    for (int sidx = s0; sidx < s1; ++sidx) {
        int row, rn; bool first, last, fn_, ln_; rowof(sidx, row, first, last);
        if (!last) { rowof(sidx + 1, rn, fn_, ln_);
#pragma unroll
            for (int q = 0; q < 4; ++q) nv[q] = *(const u32x4*)(XMC + (size_t)rn * 4096 + 32 * lane + 8 * q); }
        else {
#pragma unroll
            for (int q = 0; q < 4; ++q) nv[q] = (u32x4){0u, 0u, 0u, 0u}; }
#pragma unroll
        for (int q = 0; q < 4; ++q) { const int ch = 32 * lane + 8 * q;
            const unsigned aw[4] = {pv[q].x, pv[q].y, pv[q].z, pv[q].w}, bw[4] = {cv[q].x, cv[q].y, cv[q].z, cv[q].w}, dw[4] = {nv[q].x, nv[q].y, nv[q].z, nv[q].w}; unsigned o[4];
#pragma unroll
            for (int e = 0; e < 4; ++e) { const int qq = 2 * q + (e >> 1), j = 2 * (e & 1);
                const float y0 = siluf_(w0[qq][j] * bflo(aw[e]) + w1[qq][j] * bflo(bw[e]) + w2[qq][j] * bflo(dw[e]) + wb[qq][j]);
                const float y1 = siluf_(w0[qq][j + 1] * bfhi(aw[e]) + w1[qq][j + 1] * bfhi(bw[e]) + w2[qq][j + 1] * bfhi(dw[e]) + wb[qq][j + 1]);
                o[e] = pk2(y0, y1); }
            *(u32x4*)(XMC + (size_t)row * 4096 + 2048 + ch) = (u32x4){o[0], o[1], o[2], o[3]}; }
#pragma unroll
        for (int q = 0; q < 4; ++q) { pv[q] = last ? (u32x4){0u, 0u, 0u, 0u} : cv[q]; cv[q] = nv[q]; }
        if (last && sidx + 1 < s1) { int r1; bool f1, l1; rowof(sidx + 1, r1, f1, l1);
#pragma unroll
            for (int q = 0; q < 4; ++q) cv[q] = *(const u32x4*)(XMC + (size_t)r1 * 4096 + 32 * lane + 8 * q); }
    }
}

namespace sc1 {
constexpr int EB = 32, LX = 520, LV = 48, LS = 72, NCL = SEQ / 64, NCC = CTX / 64, NCT = NCC + NCL, ET = 48;
constexpr int O_XC = 0;
constexpr int O_CT = O_XC + 64 * LX * 2;
constexpr int O_OST = O_CT + 33 * LX * 2;
constexpr int O_V = O_OST + 2 * 64 * 34 * 4;
constexpr int O_VW = O_V + 64 * LV * 2;
constexpr int O_S = O_VW + 64 * LV * 2;
constexpr int O_M = O_S + 64 * LS * 2;
constexpr int O_VEC = O_M + 128 * 16 * 2;
constexpr int O_DUMP = O_VEC + 256 * 4;
constexpr int O_END = O_DUMP + 512;
constexpr int IPD = 2;
constexpr int SC_M = O_XC + 2 * 64 * LX * 2;
static_assert(O_END <= PARAM_LDS_OFF && SC_M + 128 * 16 * 4 <= PARAM_LDS_OFF && O_CT + ET * LX * 2 <= O_V && O_V % 16 == 0, "scan1 LDS");
__device__ __forceinline__ bf16_t* sraw_ptr(unsigned char* ws) { return (bf16_t*)(ws + WS_H); }
__device__ __forceinline__ bf16_t* sdec_ptr(unsigned char* ws) { return (bf16_t*)(ws + WS_H) + (size_t)NB * 4 * NCL * 4096; }
__device__ __forceinline__ float* gv_ptr(unsigned char* ws) { return (float*)(ws + WS_WA + 8 * MiB); }
static_assert((size_t)NB * 4 * NCL * 4096 * 2 * 3 <= 26 * MiB && (size_t)NB * 4 * NCL * 4096 * 2 * 3 <= (size_t)MT * D * 2 && (size_t)NB * 8 * NCT * 384 * 4 <= 4 * MiB, "layer-1 scan scratch");
__device__ __forceinline__ bf16x8 frag(const LAS unsigned char* lds, int off, int ld, int row, int k) { return *(const LAS bf16x8*)(lds + off + (row * ld + k) * 2); }
__device__ __forceinline__ bf16x8 tr_frag(const LAS unsigned char* lds, int off, int ld, int k0, int n0, int fr, int fq) {
    typedef short v4i16_t __attribute__((ext_vector_type(4)));
    const LAS unsigned char* p0 = lds + off + ((k0 + 8 * fq + (fr >> 2)) * ld + n0 + 4 * (fr & 3)) * 2;
    const v4i16_t a = __builtin_amdgcn_ds_read_tr16_b64_v4i16((LAS v4i16_t*)p0), b = __builtin_amdgcn_ds_read_tr16_b64_v4i16((LAS v4i16_t*)(p0 + 4 * ld * 2));
    return (bf16x8){a[0], a[1], a[2], a[3], b[0], b[1], b[2], b[3]};
}
static_assert(64 % GROWS == 0, "a 64-token chunk covers whole grid columns");
__device__ __forceinline__ int chunk_rb(int isctx, int b, int ch) { return isctx ? ML + b * CTX + ch * 64 : b * SEQ + ch * (64 / GROWS); }
__device__ __forceinline__ int lat_off(int ip) { return (ip % GROWS) * GW + ip / GROWS; }
template <int R0 = 0, int R1 = 8>
__device__ __forceinline__ void stage_xc(const Ctx& c, LAS unsigned char* lds, const bf16_t* XMC, int isctx, int b, int ch, int h, int dir) {
    const bf16_t* base = XMC + (size_t)chunk_rb(isctx, b, ch) * 4096 + 2048 + h * 512 + c.lane * 8;
#pragma unroll
    for (int r = R0; r < R1; ++r) { const int i = 8 * c.wave + r, ip = dir ? 63 - i : i; const int off = (isctx ? ip : lat_off(ip)) * 4096;
        __builtin_amdgcn_global_load_lds((const unsigned*)(base + off), (LAS unsigned*)(lds + O_XC + i * LX * 2), 16, 0, 0); }
}
__device__ __forceinline__ void score_unit(const Ctx& c, const Params& P, int b, int h, int ch, bf16_t* SB) {
    LAS unsigned char* lds = c.lds; const int tid = c.tid, lane = c.lane, w = c.wave, fr = lane & 15, fq = lane >> 4, ti_ = tid >> 3, seg = tid & 7;
    const bf16_t* XMC = (const bf16_t*)(gmem(P.ws_()) + WS_BIG);
    const float* MB = (const float*)(gmem(P.ws_()) + WS_GATES + 3 * MiB / 2) + (size_t)h * 128 * 16;
    stage_xc(c, lds, XMC, 0, b, ch, h, 0);
    LAS float* ml = (LAS float*)(lds + SC_M);
    for (int i = tid; i < 128 * 16; i += NTHREADS) ml[i] = MB[i];
    ASM_VMCNT(0); __syncthreads();
    { const int tt = w >> 1; const f32x4 zero4 = {0.f, 0.f, 0.f, 0.f};
#pragma unroll 2
      for (int wi = 0; wi < 8; ++wi) { const int win = 8 * (w & 1) + wi; const bf16x8 xb = frag(lds, O_XC, LX, tt * 16 + fr, win * 32 + 8 * fq);
#pragma unroll
          for (int half = 0; half < 2; ++half) {
              const LAS float* mb = ml + (win * 8 + half * 4 + (fr >> 2)) * 16 + (fr & 3);
              const unsigned m01 = pk2(mb[0], mb[4]), m23 = pk2(mb[8], mb[12]); const bool on = fq == half * 2 + (fr >> 3); const bool hi4 = (fr >> 2) & 1;
              const bf16x8 ma = __builtin_bit_cast(bf16x8, (u32x4){on && !hi4 ? m01 : 0u, on && !hi4 ? m23 : 0u, on && hi4 ? m01 : 0u, on && hi4 ? m23 : 0u});
              const f32x4 pt = __builtin_amdgcn_mfma_f32_16x16x32_bf16(ma, xb, zero4, 0, 0, 0);
              *(LAS u32x2*)(lds + O_CT + ((tt * 16 + fr) * LX + (2 * win + half) * 16 + 4 * fq) * 2) = (u32x2){pk2(pt[0], pt[1]), pk2(pt[2], pt[3])}; } } }
    __syncthreads();
    { const int ti = w >> 1; f32x4 acc[2] = {(f32x4){0.f, 0.f, 0.f, 0.f}, (f32x4){0.f, 0.f, 0.f, 0.f}};
#pragma unroll 4
      for (int kq = 0; kq < 16; ++kq) { const bf16x8 pb = frag(lds, O_CT, LX, ti * 16 + fr, kq * 32 + 8 * fq);
#pragma unroll
          for (int q = 0; q < 2; ++q) acc[q] = __builtin_amdgcn_mfma_f32_16x16x32_bf16(frag(lds, O_XC, LX, (2 * (w & 1) + q) * 16 + fr, kq * 32 + 8 * fq), pb, acc[q], 0, 0, 0); }
#pragma unroll
      for (int q = 0; q < 2; ++q) { const int j0 = (2 * (w & 1) + q) * 16 + 4 * fq, i = ti * 16 + fr;
          *(u32x2*)(SB + (size_t)i * 64 + j0) = (u32x2){pk2(acc[q][0], acc[q][1]), pk2(acc[q][2], acc[q][3])}; } }
    __syncthreads();
}
__device__ __forceinline__ void gv_chain(const Ctx& c, const Params& P, int chain) {
    const int b = chain >> 3, h = (chain >> 1) & 3, dir = chain & 1, lane = c.lane, w = c.wave;
    const float* GT = gates_ptr(gmem(P.ws_())); float* GV = gv_ptr(gmem(P.ws_())) + (size_t)chain * NCT * 384;
    const float bi = gmem(P.in_(I_BBIF))[dir * 8 + h], bf = gmem(P.in_(I_BBIF))[dir * 8 + 4 + h];
    LAS float* cm = (LAS float*)c.lds;
    constexpr int NPW = (NCT + NWAVES - 1) / NWAVES;
    float bcr[NPW], ar[NPW], pmr[NPW], igr[NPW];
#pragma unroll
    for (int k = 0; k < NPW; ++k) { const int ci = w + k * NWAVES;
        bcr[k] = 0.f; ar[k] = 0.f; pmr[k] = 0.f; igr[k] = 0.f;
        if (ci < NCT) {
            const int isctx = ci < NCC; const int ch = isctx ? (dir ? NCC - 1 - ci : ci) : (dir ? NCT - 1 - ci : ci - NCC);
            const int rl = row_of(isctx, b, ch * 64 + (dir ? 63 - lane : lane));
            float ig = bi, fg = bf;
#pragma unroll
            for (int sl = 0; sl < GATE_NSL; ++sl) { const float* gr = GT + ((size_t)sl * MT + rl) * 16 + dir * 8 + h; ig += gr[0]; fg += gr[4]; }
            float bc = log_sigmoidf_(fg);
#pragma unroll
            for (int o = 1; o < 64; o <<= 1) { const float u = __shfl(bc, lane >= o ? lane - o : lane); if (lane >= o) bc += u; }
            const float a = ig - bc; float pm = a;
#pragma unroll
            for (int o = 1; o < 64; o <<= 1) { const float u = __shfl(pm, lane >= o ? lane - o : lane); if (lane >= o) pm = fmaxf(pm, u); }
            bcr[k] = bc; ar[k] = a; pmr[k] = pm; igr[k] = ig;
            if (lane == 63) { cm[2 * ci] = pm; cm[2 * ci + 1] = bc; } } }
    __syncthreads();
    if (c.tid == 0) { float m0 = -1e30f;
        for (int ci = 0; ci < NCT; ++ci) { const float pm63 = cm[2 * ci], b63 = cm[2 * ci + 1]; const float mn = b63 + fmaxf(m0, pm63); cm[2 * ci] = m0; cm[2 * ci + 1] = mn; m0 = mn; } }
    __syncthreads();
#pragma unroll
    for (int k = 0; k < NPW; ++k) { const int ci = w + k * NWAVES;
        if (ci < NCT) {
            const int isctx = ci < NCC; const int ch = isctx ? (dir ? NCC - 1 - ci : ci) : (dir ? NCT - 1 - ci : ci - NCC); const int gch = isctx ? ch : NCC + ch;
            const float m0 = cm[2 * ci], mnew = cm[2 * ci + 1], bc = bcr[k], a = ar[k], ig = igr[k];
            const float mrow = bc + fmaxf(m0, pmr[k]); const float b63 = __shfl(bc, 63);
            float* g = GV + (size_t)gch * 384;
            g[lane] = bc - mrow; g[64 + lane] = a; g[128 + lane] = __expf(bc + m0 - mrow); g[192 + lane] = __expf(b63 - bc + ig - mnew); g[256 + lane] = __expf(-mrow);
            g[320 + lane] = __expf(b63 + m0 - mnew); } }
    __syncthreads();
}
__device__ __forceinline__ void phase_score1(const Ctx& c, const Params& P) {
    bf16_t* SB = sraw_ptr(gmem(P.ws_()));
    const bool split = c.G > 64; const int nsb = split ? c.G - 32 : c.G;
    if (!split || c.bid < nsb)
        for (int u = c.bid; u < NB * 4 * NCL; u += nsb) { const int b = u / (4 * NCL), h = (u / NCL) % 4, ch = u % NCL; score_unit(c, P, b, h, ch, SB + (size_t)u * 4096); }
    if (split) { if (c.bid >= nsb) for (int ch = c.bid - nsb; ch < NB * 8; ch += 32) gv_chain(c, P, ch); }
    else for (int ch = c.bid; ch < NB * 8; ch += c.G) gv_chain(c, P, ch);
}
__device__ __forceinline__ void phase_score2(const Ctx& c, const Params& P) {
    const bf16_t* SB = sraw_ptr(gmem(P.ws_())); bf16_t* SD = sdec_ptr(gmem(P.ws_())); const float* GV = gv_ptr(gmem(P.ws_()));
    const int ti_ = c.tid >> 3, seg = c.tid & 7;
    for (int u = c.bid; u < NB * 8 * NCL; u += c.G) { const int chain = u / NCL, ch = u % NCL, dir = chain & 1;
        const bf16_t* sb = SB + (size_t)((chain >> 1) * NCL + ch) * 4096; const float* g = GV + ((size_t)chain * NCT + NCC + ch) * 384;
        const u32x4 sv = dir ? *(const u32x4*)(sb + (63 - ti_) * 64 + 56 - 8 * seg) : *(const u32x4*)(sb + ti_ * 64 + 8 * seg);
        const float ui = g[ti_]; const f32x4 a0 = *(const f32x4*)(g + 64 + 8 * seg), a1 = *(const f32x4*)(g + 64 + 8 * seg + 4);
        const unsigned sw[4] = {sv.x, sv.y, sv.z, sv.w}; float s8[8];
#pragma unroll
        for (int e = 0; e < 8; ++e) { const int fe = dir ? 7 - e : e; const float raw = (fe & 1) ? bfhi(sw[fe >> 1]) : bflo(sw[fe >> 1]); const int j = 8 * seg + e;
            s8[e] = (j <= ti_) ? raw * __expf(fminf(ui + (e < 4 ? a0[e] : a1[e - 4]), 0.f)) : 0.f; }
        *(u32x4*)(SD + (size_t)u * 4096 + ti_ * 64 + 8 * seg) = (u32x4){pk2(s8[0], s8[1]), pk2(s8[2], s8[3]), pk2(s8[4], s8[5]), pk2(s8[6], s8[7])}; }
}

__device__ __forceinline__ void chain(const Ctx& c, const Params& P, int dir, int b, int h, int eb) {
    const int tid = c.tid, lane = c.lane, w = c.wave, fr = lane & 15, fq = lane >> 4;
    unsigned char* wsg = gmem(P.ws_());
    const bf16_t* XMC = (const bf16_t*)(wsg + WS_BIG);
    bf16_t* O = (bf16_t*)(wsg + WS_BIG + (size_t)MT * 4096 * 2);
    const int chainid = (b * 4 + h) * 2 + dir;
    const bf16_t* SD = sdec_ptr(wsg) + (size_t)chainid * NCL * 4096; const float* GV = gv_ptr(wsg) + (size_t)chainid * NCT * 384;
    const int ti_ = tid >> 3, seg = tid & 7;
    const int ip_ = dir ? 63 - ti_ : ti_, roff_l = lat_off(ip_);
    { LAS unsigned char* lds = c.lds; LAS bf16_t* ml = (LAS bf16_t*)(lds + O_M); const float* MB = (const float*)(P.ws_() + WS_GATES + 3 * MiB / 2) + (size_t)h * 128 * 16;
      for (int i = tid; i < 128 * 16; i += NTHREADS) ml[i] = (bf16_t)f2bf(MB[i]);
      for (int i = tid; i < 33 * LX / 2; i += NTHREADS) ((LAS unsigned*)(lds + O_CT))[i] = 0u;
    }
    f32x4 cst[12];
#pragma unroll
    for (int t = 0; t < 12; ++t) cst[t] = (f32x4){0.f, 0.f, 0.f, 0.f};
    __syncthreads();
    const int ti = w >> 1, te = w & 1;
#define SC1_CHUNK(ci_, isctx_, ch_) const int isctx_ = (ci_) < NCC; const int ch_ = isctx_ ? (dir ? NCC - 1 - (ci_) : (ci_)) : (dir ? NCT - 1 - (ci_) : (ci_) - NCC);
    u32x4 pf_s = (u32x4){0u, 0u, 0u, 0u}, pf_v = pf_s, pf_o = pf_s; float pf_g = 0.f, pf_wk = 0.f;
#define SC1_PREFETCH(ci_) do { SC1_CHUNK(ci_, ic_, ch_) const int row_ = chunk_rb(ic_, b, ch_) + (ic_ ? ip_ : roff_l); const float* g_ = GV + (size_t)(ic_ ? ch_ : NCC + ch_) * 384; \
        stage_xc<0, 2>(c, c.lds, XMC, ic_, b, ch_, h, dir); \
        if (seg < 4) pf_v = *(const u32x4*)(XMC + (size_t)row_ * 4096 + h * 512 + eb * EB + seg * 8); \
        if (!ic_) { pf_s = *(const u32x4*)(SD + (size_t)ch_ * 4096 + ti_ * 64 + 8 * seg); \
            if (dir && seg < 4) pf_o = *(const u32x4*)(O + (size_t)row_ * 2048 + h * 512 + eb * EB + seg * 8); } \
        pf_wk = g_[192 + ti_]; if (tid < 193) pf_g = g_[tid < 192 ? 128 + tid : 320]; } while (0)
    SC1_PREFETCH(0);
    { SC1_CHUNK(0, ic0_, ch0_) stage_xc<2, 8>(c, c.lds, XMC, ic0_, b, ch0_, h, dir); }
    for (int ci = 0; ci < NCT; ++ci) {
        LAS unsigned char* lds = c.lds; LAS float* vec = (LAS float*)(lds + O_VEC);
        SC1_CHUNK(ci, isctx, ch)
        const int row = chunk_rb(isctx, b, ch) + (isctx ? ip_ : roff_l);
        if (tid < 193) vec[tid] = pf_g;
        if (seg < 6) { const float wkj = pf_wk; u32x4 xv = pf_v, wv;
            if (seg >= 4) { xv = (u32x4){seg == 4 ? 0x3f80u : 0u, 0u, 0u, 0u}; }
            wv.x = pk2(bflo(xv.x) * wkj, bfhi(xv.x) * wkj); wv.y = pk2(bflo(xv.y) * wkj, bfhi(xv.y) * wkj); wv.z = pk2(bflo(xv.z) * wkj, bfhi(xv.z) * wkj); wv.w = pk2(bflo(xv.w) * wkj, bfhi(xv.w) * wkj);
            *(LAS u32x4*)(lds + O_V + (ti_ * LV + seg * 8) * 2) = xv; *(LAS u32x4*)(lds + O_VW + (ti_ * LV + seg * 8) * 2) = wv; }
        if (!isctx) *(LAS u32x4*)(lds + O_S + (ti_ * LS + 8 * seg) * 2) = pf_s;
        ASM_VMCNT(0); __syncthreads();
        const float decay0 = vec[192];
        f32x4 U[12];
        if (!isctx) {
            LAS float* ost = (LAS float*)(lds + O_OST);
            { const int t2 = w & 3, kh = w >> 2; f32x4 aT[3], a1 = (f32x4){0.f, 0.f, 0.f, 0.f}, a1o = (f32x4){0.f, 0.f, 0.f, 0.f};
              LAS float* osth = ost + kh * 64 * 34;
#pragma unroll
              for (int q = 0; q < 3; ++q) aT[q] = (f32x4){0.f, 0.f, 0.f, 0.f};
              typedef short v4i16_t __attribute__((ext_vector_type(4)));
              bf16x8 sa_[2], va_[2]; f32x4 wi4;
              const bf16x8 vones = __builtin_bit_cast(bf16x8, fr == 0 ? (u32x4){0x3f803f80u, 0x3f803f80u, 0x3f803f80u, 0x3f803f80u} : (u32x4){0u, 0u, 0u, 0u});
              const LAS unsigned char* px = lds + O_XC + ((t2 * 16 + fr) * LX + kh * 256 + 8 * fq) * 2;
              const LAS unsigned char* pc = lds + O_CT + (fr * LX + kh * 256 + 8 * fq) * 2;
              bf16x8 xa_[IPD + 1], cb_[IPD + 1][3];
#define SC1_LOADB(k_) do { xa_[(k_) % (IPD + 1)] = *(const LAS bf16x8*)(px + (k_) * 64); \
                  _Pragma("unroll") for (int q = 0; q < 3; ++q) cb_[(k_) % (IPD + 1)][q] = *(const LAS bf16x8*)(pc + q * 16 * LX * 2 + (k_) * 64); } while (0)
#pragma unroll
              for (int k = 0; k < IPD; ++k) SC1_LOADB(k);
#pragma unroll
              for (int k = 0; k < 8; ++k) {
                  if (k + IPD < 8) SC1_LOADB(k + IPD);
                  if (k == 8 - 1 - IPD) {
              { const LAS unsigned char* ps = lds + O_S + ((t2 * 16 + fr) * LS + 8 * fq) * 2; const LAS unsigned char* pv = lds + O_V + ((8 * fq + (fr >> 2)) * LV + 4 * (fr & 3)) * 2;
                wi4 = *(const LAS f32x4*)(vec + t2 * 16 + 4 * fq);
#pragma unroll
                for (int kq = 0; kq < 2; ++kq) { sa_[kq] = *(const LAS bf16x8*)(ps + kq * 64);
                    const v4i16_t t0 = __builtin_amdgcn_ds_read_tr16_b64_v4i16((LAS v4i16_t*)(pv + kq * 32 * LV * 2 + kh * 32)), t1 = __builtin_amdgcn_ds_read_tr16_b64_v4i16((LAS v4i16_t*)(pv + kq * 32 * LV * 2 + kh * 32 + 4 * LV * 2));
                    va_[kq] = (bf16x8){t0[0], t0[1], t0[2], t0[3], t1[0], t1[1], t1[2], t1[3]};
                    } }
                  }
                  SCHED_FENCE();
#pragma unroll
                  for (int q = 0; q < 3; ++q) aT[q] = __builtin_amdgcn_mfma_f32_16x16x32_bf16(xa_[k % (IPD + 1)], cb_[k % (IPD + 1)][q], aT[q], 0, 0, 0);
                  SCHED_FENCE(); }
#undef SC1_LOADB
#pragma unroll
              for (int kq = 0; kq < 2; ++kq) { a1 = __builtin_amdgcn_mfma_f32_16x16x32_bf16(sa_[kq], va_[kq], a1, 0, 0, 0);
                  if (kh == 0) a1o = __builtin_amdgcn_mfma_f32_16x16x32_bf16(sa_[kq], vones, a1o, 0, 0, 0); }
#pragma unroll
              for (int r = 0; r < 4; ++r) { const int i = t2 * 16 + 4 * fq + r; const float wi = wi4[r];
                  osth[i * 34 + fr] = wi * aT[0][r] + (kh == 0 ? a1[r] : 0.f);
                  osth[i * 34 + 16 + fr] = wi * aT[1][r] + (kh == 1 ? a1[r] : 0.f);
                  LAS float* dst = fr == 0 ? osth + i * 34 + 32 : (LAS float*)(lds + O_DUMP) + lane;
                  *dst = wi * aT[2][r] + a1o[r]; } }
        }
        { typedef short v4i16_t __attribute__((ext_vector_type(4)));
          bf16x8 vb[2][3], xa[4][2];
          const LAS unsigned char* pv = lds + O_VW + ((8 * fq + (fr >> 2)) * LV + 4 * (fr & 3)) * 2; const LAS unsigned char* pxt = lds + O_XC + ((8 * fq + (fr >> 2)) * LX + 64 * w + 4 * (fr & 3)) * 2;
#pragma unroll
          for (int kq = 0; kq < 2; ++kq)
#pragma unroll
              for (int e2 = 0; e2 < 3; ++e2) { const v4i16_t t0 = __builtin_amdgcn_ds_read_tr16_b64_v4i16((LAS v4i16_t*)(pv + kq * 32 * LV * 2 + e2 * 32)), t1 = __builtin_amdgcn_ds_read_tr16_b64_v4i16((LAS v4i16_t*)(pv + kq * 32 * LV * 2 + e2 * 32 + 4 * LV * 2));
                  vb[kq][e2] = (bf16x8){t0[0], t0[1], t0[2], t0[3], t1[0], t1[1], t1[2], t1[3]}; }
#pragma unroll
          for (int dt = 0; dt < 4; ++dt)
#pragma unroll
              for (int kq = 0; kq < 2; ++kq) { const v4i16_t t0 = __builtin_amdgcn_ds_read_tr16_b64_v4i16((LAS v4i16_t*)(pxt + kq * 32 * LX * 2 + dt * 32)), t1 = __builtin_amdgcn_ds_read_tr16_b64_v4i16((LAS v4i16_t*)(pxt + kq * 32 * LX * 2 + dt * 32 + 4 * LX * 2));
                  xa[dt][kq] = (bf16x8){t0[0], t0[1], t0[2], t0[3], t1[0], t1[1], t1[2], t1[3]}; }
          SCHED_FENCE();
#pragma unroll
          for (int dt = 0; dt < 4; ++dt)
#pragma unroll
              for (int e2 = 0; e2 < 3; ++e2) { f32x4 u = (f32x4){0.f, 0.f, 0.f, 0.f};
#pragma unroll
                  for (int kq = 0; kq < 2; ++kq) u = __builtin_amdgcn_mfma_f32_16x16x32_bf16(xa[dt][kq], vb[kq][e2], u, 0, 0, 0);
                  U[dt * 3 + e2] = u; } }
        bf16x8 mA[4];
#pragma unroll
        for (int dt = 0; dt < 4; ++dt) { const u32x2 mrow = *(const LAS u32x2*)(lds + O_M + (((4 * w + dt) * 4 + fq) * 16 + (fr & 3) * 4) * 2);
            mA[dt] = __builtin_bit_cast(bf16x8, (fq == (fr >> 2)) ? (u32x4){mrow.x, mrow.y, 0u, 0u} : (u32x4){0u, 0u, 0u, 0u}); }
        const float emr_i = vec[128 + ti_];
        __syncthreads();
        const u32x4 cur_o = pf_o;
        if (ci + 1 < NCT) SC1_PREFETCH(ci + 1);
#pragma unroll
        for (int t = 0; t < 12; ++t) { const int td = 4 * w + t / 3, e2 = t % 3;
#pragma unroll
            for (int r = 0; r < 4; ++r) cst[t][r] = decay0 * cst[t][r] + U[t][r];
            const bf16x8 cb = __builtin_bit_cast(bf16x8, (u32x4){pk2(cst[t][0], cst[t][1]), pk2(cst[t][2], cst[t][3]), 0u, 0u});
            const f32x4 zero4 = {0.f, 0.f, 0.f, 0.f};
            const f32x4 o = __builtin_amdgcn_mfma_f32_16x16x32_bf16(mA[t / 3], cb, zero4, 0, 0, 0);
            const int ctoff = O_CT + ((e2 * 16 + fr) * LX + td * 16 + 4 * fq) * 2;
            *(LAS u32x2*)(lds + ((e2 < 2 || fr == 0) ? ctoff : O_DUMP + lane * 8)) = (u32x2){pk2(o[0], o[1]), pk2(o[2], o[3])};
            if ((t & 1) && ci + 1 < NCT) { SC1_CHUNK(ci + 1, icn_, chn_)
                if (t == 1) stage_xc<2, 3>(c, c.lds, XMC, icn_, b, chn_, h, dir); else if (t == 3) stage_xc<3, 4>(c, c.lds, XMC, icn_, b, chn_, h, dir);
                else if (t == 5) stage_xc<4, 5>(c, c.lds, XMC, icn_, b, chn_, h, dir); else if (t == 7) stage_xc<5, 6>(c, c.lds, XMC, icn_, b, chn_, h, dir);
                else if (t == 9) stage_xc<6, 7>(c, c.lds, XMC, icn_, b, chn_, h, dir); else stage_xc<7, 8>(c, c.lds, XMC, icn_, b, chn_, h, dir); } }
        if (!isctx && seg < 4) {
            const LAS float* ost = (const LAS float*)(lds + O_OST) + ti_ * 34; const LAS float* ost2 = ost + 64 * 34;
            f32x2 ra[4], rb[4];
#pragma unroll
            for (int e = 0; e < 4; ++e) { ra[e] = *(const LAS f32x2*)(ost + seg * 8 + 2 * e); rb[e] = *(const LAS f32x2*)(ost2 + seg * 8 + 2 * e); }
            const float d0 = ost[32], d1 = ost2[32];
            SCHED_FENCE();
            const float rdn = 1.0f / fmaxf(fabsf(d0 + d1), emr_i); float o[8];
#pragma unroll
            for (int e = 0; e < 4; ++e) { o[2 * e] = (ra[e][0] + rb[e][0]) * rdn; o[2 * e + 1] = (ra[e][1] + rb[e][1]) * rdn; }
            bf16_t* op = O + (size_t)row * 2048 + h * 512 + eb * EB + seg * 8;
            if (dir) { const u32x4 pv = cur_o; o[0] += bflo(pv.x); o[1] += bfhi(pv.x); o[2] += bflo(pv.y); o[3] += bfhi(pv.y); o[4] += bflo(pv.z); o[5] += bfhi(pv.z); o[6] += bflo(pv.w); o[7] += bfhi(pv.w); }
            *(u32x4*)op = (u32x4){pk2(o[0], o[1]), pk2(o[2], o[3]), pk2(o[4], o[5]), pk2(o[6], o[7])};
        }
    }
    __syncthreads();
#undef SC1_CHUNK
#undef SC1_PREFETCH
}
}
__device__ __forceinline__ void phase_scan1(const Ctx& c, const Params& P, int dir) {
    const int nitems = NB * 64;
    for (int it = c.bid; it < nitems; it += c.G) { sc1::chain(c, P, dir, it / 64, (it % 64) >> 4, it & 15); __syncthreads(); }
}
__device__ __forceinline__ void phase_post1(const Ctx& c, const Params& P) {
    const bf16_t* XMC = (const bf16_t*)(P.ws_() + WS_BIG); bf16_t* O = (bf16_t*)(P.ws_() + WS_BIG + (size_t)MT * 4096 * 2);
    const float* mh = P.in_(I_BMHN); const float* sk = P.in_(I_BSKIP); const float* wv = P.in_(I_BWV);
    const int gw = c.bid * NWAVES + c.wave, NGW = c.G * NWAVES, lane = c.lane;
    LAS float* wl = (LAS float*)c.lds; LAS float* ml = wl + 32 * 64 * 4; LAS float* sl = ml + 8 * 64 * 4;
    for (int i = c.tid; i < 512 * 16; i += NTHREADS) { const int n = i >> 4, dp = (i >> 2) & 3, e = i & 3; wl[(((n & 7) * 4 + dp) * 64 + (n >> 3)) * 4 + e] = wv[i]; }
    for (int i = c.tid; i < 2048; i += NTHREADS) { const int ln = i >> 5, q = (i >> 2) & 7, e = i & 3; ml[(q * 64 + ln) * 4 + e] = mh[i]; sl[(q * 64 + ln) * 4 + e] = sk[i]; }
    __syncthreads();
    for (int row = gw; row < ML; row += NGW) {
        float hv[32]; float s = 0.f;
#pragma unroll
        for (int q = 0; q < 4; ++q) { const u32x4 a = *(const u32x4*)(O + (size_t)row * 2048 + 32 * lane + 8 * q); const unsigned aw[4] = {a.x, a.y, a.z, a.w};
            float raw[8];
#pragma unroll
            for (int e = 0; e < 4; ++e) { raw[2 * e] = bflo(aw[e]); raw[2 * e + 1] = bfhi(aw[e]); }
#pragma unroll
            for (int bl = 0; bl < 2; ++bl) { const LAS float* wb = wl + ((2 * q + bl) * 4 * 64 + lane) * 4;
                const f32x4 r0 = *(const LAS f32x4*)wb, r1 = *(const LAS f32x4*)(wb + 256), r2 = *(const LAS f32x4*)(wb + 512), r3 = *(const LAS f32x4*)(wb + 768);
#pragma unroll
                for (int e = 0; e < 4; ++e) { const float v = raw[bl * 4] * r0[e] + raw[bl * 4 + 1] * r1[e] + raw[bl * 4 + 2] * r2[e] + raw[bl * 4 + 3] * r3[e]; hv[q * 8 + bl * 4 + e] = v; s += v; } } }
        s += __shfl_xor(s, 1); s += __shfl_xor(s, 2); s += __shfl_xor(s, 4); s += __shfl_xor(s, 8);
        const float mu = s * (1.0f / 512.0f); float v = 0.f;
#pragma unroll
        for (int e = 0; e < 32; ++e) { hv[e] -= mu; v += hv[e] * hv[e]; }
        v += __shfl_xor(v, 1); v += __shfl_xor(v, 2); v += __shfl_xor(v, 4); v += __shfl_xor(v, 8);
        const float rs = 1.0f / sqrtf(v * (1.0f / 512.0f) + EPS);
#pragma unroll
        for (int q = 0; q < 4; ++q) { const int ch = 32 * lane + 8 * q;
            const u32x4 xc = *(const u32x4*)(XMC + (size_t)row * 4096 + 2048 + ch), z = *(const u32x4*)(XMC + (size_t)row * 4096 + ch);
            const unsigned xw[4] = {xc.x, xc.y, xc.z, xc.w}, zw[4] = {z.x, z.y, z.z, z.w}; unsigned o[4];
            const f32x4 mh0 = *(const LAS f32x4*)(ml + ((2 * q) * 64 + lane) * 4), mh1 = *(const LAS f32x4*)(ml + ((2 * q + 1) * 64 + lane) * 4);
            const f32x4 sk0 = *(const LAS f32x4*)(sl + ((2 * q) * 64 + lane) * 4), sk1 = *(const LAS f32x4*)(sl + ((2 * q + 1) * 64 + lane) * 4);
#pragma unroll
            for (int e = 0; e < 4; ++e) { const int j = 2 * (e & 1); const f32x4 mm_ = e < 2 ? mh0 : mh1, ss_ = e < 2 ? sk0 : sk1;
                const float f0 = (hv[q * 8 + 2 * e] * rs * mm_[j] + ss_[j] * bflo(xw[e])) * siluf_(bflo(zw[e]));
                const float f1 = (hv[q * 8 + 2 * e + 1] * rs * mm_[j + 1] + ss_[j + 1] * bfhi(xw[e])) * siluf_(bfhi(zw[e]));
                o[e] = pk2(f0, f1); }
            *(u32x4*)(O + (size_t)row * 2048 + ch) = (u32x4){o[0], o[1], o[2], o[3]}; }
    }
    __syncthreads();
}
__device__ __forceinline__ void phase_final(const Ctx& c, const Params& P) {
    const float* w = P.in_(I_FNORM); const int gw = c.bid * NWAVES + c.wave, NGW = c.G * NWAVES;
    f32x4 wv[4];
#pragma unroll
    for (int j = 0; j < 4; ++j) wv[j] = *(const f32x4*)(w + 4 * c.lane + 256 * j);
    f32x4 nv[4];
    if (gw < ML) {
#pragma unroll
        for (int j = 0; j < 4; ++j) nv[j] = *(const f32x4*)(P.out_() + (size_t)gw * D + 4 * c.lane + 256 * j); }
    for (int row = gw; row < ML; row += NGW) { float* xr = P.out_() + (size_t)row * D; f32x4 v[4]; float s = 0.f;
#pragma unroll
        for (int j = 0; j < 4; ++j) v[j] = nv[j];
        if (row + NGW < ML) {
#pragma unroll
            for (int j = 0; j < 4; ++j) nv[j] = *(const f32x4*)(xr + (size_t)NGW * D + 4 * c.lane + 256 * j); }
#pragma unroll
        for (int j = 0; j < 4; ++j) s += (v[j].x * v[j].x + v[j].y * v[j].y) + (v[j].z * v[j].z + v[j].w * v[j].w);
        const float rs = 1.0f / sqrtf(wave_sum(s) * (1.0f / D) + EPS);
#pragma unroll
        for (int j = 0; j < 4; ++j) *(f32x4*)(xr + 4 * c.lane + 256 * j) = v[j] * rs * wv[j]; }
}

enum { PH_PRO = 0, PH_H0, PH_G0, PH_PREP0A, PH_PREP0B, PH_S0F, PH_S0B, PH_POST0, PH_G1, PH_H1, PH_G2, PH_G3, PH_H2, PH_G4, PH_PREP1, PH_GG, PH_SCORE1, PH_SCORE2, PH_S1F, PH_S1B, PH_H2B, PH_G5, PH_POST1, PH_G6, PH_H3, PH_G7, PH_G8, PH_FIN, PH_COUNT };

__device__ __forceinline__ void run_phase(int ph, const Params& P, LAS unsigned char* lds, int bid, int G, int tid) {
    Ctx c; c.lds = lds; c.tid = tid; c.lane = c.tid & 63; c.wave = __builtin_amdgcn_readfirstlane(c.tid >> 6); c.bid = bid; c.G = G;
    unsigned char* ws = P.ws_();
    float* mod = (float*)(ws + WS_MOD); float* mod1 = mod + (size_t)(NB + 1) * NMOD;
    bf16_t* WA = (bf16_t*)(ws + WS_WA); bf16_t* WB = (bf16_t*)(ws + WS_WB);
    bf16_t* H = (bf16_t*)(ws + WS_H); bf16_t* BIG = (bf16_t*)(ws + WS_BIG);
    float* ctxres = (float*)(ws + WS_CTXRES);
    switch (ph) {
    case PH_PRO: {
        phase_mods(c, P);
        int base = 0; const float* W = gmem(P.in_(I_AWIN));
        cvt_seg(c, W, A_IN, D, 2048, 1024, WA, C_G, base);
        cvt_seg(c, W, A_IN, D, 3104, 1024, WA, C_Z, base);
        cvt_seg(c, W, A_IN, D, 0, 512, WA, C_Q, base);
        cvt_seg(c, W, A_IN, D, 512, 512, WA, C_K, base);
        cvt_seg(c, W, A_IN, D, 1024, 1024, WA, C_V, base);
        cvt_seg(c, W, A_IN, D, 4128, 1536, WA, C_XS, base);
        cvt_seg(c, W, A_IN, D, 3072, 32, WA, C_R, base);
        cvt_seg(c, W, A_IN, D, 5664, 32, WA, C_DT, base);
        { bf16_t* wgt = (bf16_t*)(ws + WS_GATES + 7 * MiB / 4); const float* wg = gmem(P.in_(I_AGW));
          for (int i = c.bid * NTHREADS + c.tid; i < 8 * 128 * 32; i += c.G * NTHREADS) { const int r = i & 31, kk = (i >> 5) & 127, dhh = i >> 12, dir = dhh >> 2, h = dhh & 3;
              wgt[i] = r < 16 ? (bf16_t)f2bf(wg[(size_t)dir * 16 * 512 + r * 512 + h * 128 + kk]) : (bf16_t)0; } }
        for (int i = c.bid * NTHREADS + c.tid; i < (NP0 - A_IN) * D / 8; i += c.G * NTHREADS) *(u32x4*)(WA + (size_t)A_IN * D + (size_t)i * 8) = (u32x4){0u, 0u, 0u, 0u};
    } break;
    case PH_H0:
        phase_hnorm(c, gmem(P.in_(I_X)), gmem(P.in_(I_CTX)), gmem(P.in_(I_NMIX)), mod, 0, 1, H, 0, MT);
        break;
    case PH_G0: {
        pg8::Gemm g{H, WA + (size_t)2048 * D, MT, NP0 - 2048, D, D}; pg8::StaticOrder S; S.init(MT, NP0 - 2048, D, G, bid);
        EpiStoreBf16 E{BIG + 2048, NP0};
        pg8::gemm_phase(lds, g, S, E, c.tid);
    } break;
    case PH_PREP0A: sc0::phase_prep0a(c, P); break;
    case PH_PREP0B: sc0::phase_prep0b(c, P); break;
    case PH_S0F: case PH_S0B: {
        const int dir = ph == PH_S0B, nsc = G >= 2 ? G / 2 : G;
        if (bid < nsc) phase_scan0(c, P, dir, nsc);
        if (G < 2 || bid >= nsc) {
            const int cofs = dir ? C_G : C_Z;
            pg8::Gemm g{H, WA + (size_t)cofs * D, MT, 1024, D, D}; pg8::StaticOrder S; S.init(MT, 1024, D, G >= 2 ? G - nsc : 1, G >= 2 ? bid - nsc : 0);
            EpiStoreBf16 E{BIG + cofs, NP0};
            pg8::gemm_phase(lds, g, S, E, c.tid);
        }
    } break;
    case PH_POST0: {
        phase_post0(c, P);
        int base = 0; cvt_seg(c, gmem(P.in_(I_AWOUT)), D, 2048, 0, 1024, WB, 0, base);
    } break;
    case PH_G1: {
        pg8::Gemm g{BIG, WB, MT, D, 2048, NP0}; pg8::StaticOrderT<MC / 256, G1_NSL> S; S.init(ML, D, 2048, G, bid);
        EpiResid E{gmem(P.in_(I_X)), gmem(P.in_(I_CTX)), gmem(P.out_()), ctxres, mod + 2 * D, (float*)(BIG + 2048), NP0 / 2};
        pg8::gemm_phase(lds, g, S, E, c.tid);
    } break;
    case PH_H1: {
        phase_hnorm(c, gmem(P.out_()), gmem(P.in_(I_CTX)), gmem(P.in_(I_NFFN)), mod, 3, 4, H, 0, MT, CtxFix{(const float*)(BIG + 2048), NP0 / 2, G1_NSL, mod + (size_t)NB * NMOD + 2 * D, ctxres});
        int base = 0;
        for (int pn = 0; pn < DFF / 128; ++pn) { cvt_seg(c, gmem(P.in_(I_W1)), DFF, D, 128 * pn, 128, WA, 256 * pn, base); cvt_seg(c, gmem(P.in_(I_W3)), DFF, D, 128 * pn, 128, WA, 256 * pn + 128, base); }
        cvt_seg(c, gmem(P.in_(I_W2)), D, DFF, 0, 1024, WB, 0, base);
    } break;
    case PH_G2: {
        pg8::Gemm g{H, WA, MT, 2 * DFF, D, D}; pg8::StaticOrder S; S.init(MT, 2 * DFF, D, G, bid);
        EpiSwiGLU E{BIG, DFF};
        pg8::gemm_phase(lds, g, S, E, c.tid);
    } break;
    case PH_G3: {
        pg8::Gemm g{BIG, WB, MT, D, DFF, DFF}; pg8::StaticOrderT<MC / 256, G3_NSL> S; S.init(ML, D, DFF, G, bid);
        EpiResid E{gmem(P.out_()), ctxres, gmem(P.out_()), ctxres, mod + 5 * D, (float*)(BIG + (size_t)MT * DFF), D};
        pg8::gemm_phase(lds, g, S, E, c.tid);
    } break;
    case PH_H2: {
        phase_hnorm(c, gmem(P.out_()), ctxres, gmem(P.in_(I_NMIX)) + D, mod1, 0, 1, H, 0, MT, CtxFix{(const float*)(BIG + (size_t)MT * DFF), D, G3_NSL, mod + (size_t)NB * NMOD + 5 * D, ctxres});
        int base = 0;
        cvt_seg(c, gmem(P.in_(I_BWUP)), 4096, D, 0, 2048, WA, 0, base);
        cvt_seg(c, gmem(P.in_(I_BWUP)), 4096, D, 2048, 2048, WB, 0, base);
        build_gate_weights(c, P, WA + (size_t)5 * MiB / 2);
        build_mblocks(c, P, (float*)(ws + WS_GATES + 3 * MiB / 2));
    } break;
    case PH_G4: {
        pg8::Gemm g{H, WA, MT, 2048, D, D}; pg8::StaticOrder S; S.init(MT, 2048, D, G, bid);
        EpiStoreBf16 E{BIG, 4096};
        pg8::gemm_phase(lds, g, S, E, c.tid);
    } break;
    case PH_PREP1: phase_prep1(c, P); break;
    case PH_GG: {
        pg8::Gemm g{BIG, WA + (size_t)5 * MiB / 2, MT, 256, 4096, 4096}; pg8::StaticOrderT<MT / 256, GATE_NSL> S; S.init(0, 256, 4096, G, bid);
        EpiGates E{gates_ptr(ws)};
        pg8::gemm_phase(lds, g, S, E, c.tid);
    } break;
    case PH_SCORE1: sc1::phase_score1(c, P); break;
    case PH_SCORE2: sc1::phase_score2(c, P); break;
    case PH_S1F: phase_scan1(c, P, 0); break;
    case PH_S1B: phase_scan1(c, P, 1); break;
    case PH_H2B: phase_hnorm(c, gmem(P.out_()), ctxres, gmem(P.in_(I_NMIX)) + D, mod1, 0, 1, H, 0, ML); break;
    case PH_G5: {
        pg8::Gemm g{H, WB, ML, 2048, D, D}; pg8::StaticOrder S; S.init(ML, 2048, D, G, bid);
        EpiStoreBf16 E{BIG, 4096};
        pg8::gemm_phase(lds, g, S, E, c.tid);
    } break;
    case PH_POST1: {
        phase_post1(c, P);
        int base = 0; cvt_seg(c, gmem(P.in_(I_BWDOWN)), D, 2048, 0, 1024, WB, 0, base);
    } break;
    case PH_G6: {
        pg8::Gemm g{BIG + (size_t)MT * 4096, WB, ML, D, 2048, 2048}; pg8::StaticOrder S; S.init(ML, D, 2048, G, bid);
        EpiResid E{gmem(P.out_()), ctxres, gmem(P.out_()), ctxres, mod1 + 2 * D, nullptr, 0};
        pg8::gemm_phase(lds, g, S, E, c.tid);
    } break;
    case PH_H3: {
        phase_hnorm(c, gmem(P.out_()), ctxres, gmem(P.in_(I_NFFN)) + D, mod1, 3, 4, H, 0, ML);
        int base = 0; const float* w1 = gmem(P.in_(I_W1)) + (size_t)D * DFF; const float* w3 = gmem(P.in_(I_W3)) + (size_t)D * DFF;
        for (int pn = 0; pn < DFF / 128; ++pn) { cvt_seg(c, w1, DFF, D, 128 * pn, 128, WA, 256 * pn, base); cvt_seg(c, w3, DFF, D, 128 * pn, 128, WA, 256 * pn + 128, base); }
        cvt_seg(c, gmem(P.in_(I_W2)) + (size_t)DFF * D, D, DFF, 0, 1024, WB, 0, base);
    } break;
    case PH_G7: {
        pg8::Gemm g{H, WA, ML, 2 * DFF, D, D}; pg8::StaticOrder S; S.init(ML, 2 * DFF, D, G, bid);
        EpiSwiGLU E{BIG, DFF};
        pg8::gemm_phase(lds, g, S, E, c.tid);
    } break;
    case PH_G8: {
        pg8::Gemm g{BIG, WB, ML, D, DFF, DFF}; pg8::StaticOrder S; S.init(ML, D, DFF, G, bid);
        EpiResid E{gmem(P.out_()), ctxres, gmem(P.out_()), ctxres, mod1 + 5 * D, nullptr, 0};
        pg8::gemm_phase(lds, g, S, E, c.tid);
    } break;
    case PH_FIN: phase_final(c, P); break;
    default: break;
    }
}

#ifndef EMU
#include <hip/hip_cooperative_groups.h>
namespace cg = cooperative_groups;
constexpr int LDS_BYTES = 147456;
#define XB_TMO      128
#define XB_XCNT(j)  (256  + 64 * (j))
#define XB_XSUB(j)  (1280 + 64 * (j))
#define XB_XGEN(j)  (2304 + 64 * (j))
#define XB_TOP      3328
#define XB_TOPGEN   3392
#define XCD_BAR_WORDS 3456
#define XB_SPIN_CAP (1u << 20)
__device__ __forceinline__ unsigned xb_ld(unsigned* p)              { return __hip_atomic_load(p, __ATOMIC_RELAXED, __HIP_MEMORY_SCOPE_AGENT); }
__device__ __forceinline__ unsigned xb_add(unsigned* p, unsigned v) { return __hip_atomic_fetch_add(p, v, __ATOMIC_RELAXED, __HIP_MEMORY_SCOPE_AGENT); }
__device__ __forceinline__ unsigned xb_xcc_id() { return (unsigned)__builtin_amdgcn_s_getreg((3 << 11) | 20) & 0xFu; }
#define XB_SPIN(cond, bar) do { unsigned _sp = 0; while (cond) { __builtin_amdgcn_s_sleep(1); \
    if ((++_sp & 255u) == 0u) { if (xb_ld(&(bar)[XB_TMO])) break; if (_sp > XB_SPIN_CAP) { atomicAdd(&(bar)[XB_TMO], 1u); break; } } } } while (0)
struct XcdBarrier { unsigned* bar; unsigned x; volatile LAS unsigned* st; };
__device__ __forceinline__ XcdBarrier xcd_barrier_post(unsigned* bar, volatile LAS unsigned* st) {
    XcdBarrier b; b.bar = bar; b.x = xb_xcc_id(); b.st = st;
    if (threadIdx.x == 0) (void)xb_add(&bar[XB_XCNT(b.x)], 1u);
    return b;
}
__device__ __forceinline__ void xcd_barrier_complete(unsigned* bar, unsigned x, unsigned& nloc, unsigned& nx) {
    const unsigned G = gridDim.x * gridDim.y * gridDim.z;
    unsigned sum, cnt, mine, sp = 0u;
    for (;;) {
        sum = 0u; cnt = 0u; mine = 0u;
#pragma unroll
        for (unsigned j = 0; j < 16; ++j) { const unsigned c = xb_ld(&bar[XB_XCNT(j)]); sum += c; cnt += (c > 0u) ? 1u : 0u; mine = (j == x) ? c : mine; }
        if (sum == G) break;
        __builtin_amdgcn_s_sleep(1);
        if ((++sp & 255u) == 0u) { if (xb_ld(&bar[XB_TMO])) break; if (sp > XB_SPIN_CAP) { atomicAdd(&bar[XB_TMO], 1u); break; } }
    }
    nloc = mine > 0u ? mine : 1u; nx = cnt > 0u ? cnt : 1u;
}
__device__ __forceinline__ void xcd_barrier(const XcdBarrier& b) {
    asm volatile("s_waitcnt vmcnt(0)" ::: "memory");
    __syncthreads();
    if (threadIdx.x == 0) {
        unsigned* bar = b.bar;
        __builtin_amdgcn_s_waitcnt(0);
        unsigned nloc = b.st[0], nx = b.st[1];
        if (nloc == 0u) { xcd_barrier_complete(bar, b.x, nloc, nx); b.st[0] = nloc; b.st[1] = nx; }
        const unsigned old = xb_add(&bar[XB_XSUB(b.x)], 1u);
        const unsigned gen = old / nloc;
        if (old + 1u == (gen + 1u) * nloc) {
            __builtin_amdgcn_fence(__ATOMIC_RELEASE, "agent");
            asm volatile("s_waitcnt vmcnt(0)" ::: "memory");
            const unsigned og = xb_add(&bar[XB_TOP], 1u);
            const unsigned tg = og / nx;
            if (og + 1u == (tg + 1u) * nx) xb_add(&bar[XB_TOPGEN], 1u);
            else XB_SPIN(xb_ld(&bar[XB_TOPGEN]) == tg, bar);
            __builtin_amdgcn_fence(__ATOMIC_ACQUIRE, "agent");
            xb_add(&bar[XB_XGEN(b.x)], 1u);
            asm volatile("s_waitcnt vmcnt(0)" ::: "memory");
        } else {
            XB_SPIN(xb_ld(&bar[XB_XGEN(b.x)]) == gen, bar);
            __builtin_amdgcn_fence(__ATOMIC_ACQUIRE, "agent");
            asm volatile("s_waitcnt vmcnt(0)" ::: "memory");
        }
    }
    __syncthreads();
}

__global__ void __launch_bounds__(NTHREADS, 2) fwd_megakernel(ParamsK K) {
    extern __shared__ __attribute__((aligned(16))) unsigned char lds[];
    cg::grid_group grid = cg::this_grid();
    LAS unsigned long long* pl = (LAS unsigned long long*)((LAS unsigned char*)lds + PARAM_LDS_OFF);
    volatile LAS unsigned* bst = (volatile LAS unsigned*)((LAS unsigned char*)lds + PARAM_LDS_OFF + 320);
    if (threadIdx.x == 0) {
#pragma unroll
        for (int i = 0; i < 34; ++i) pl[i] = (unsigned long long)K.in[i];
        pl[34] = (unsigned long long)K.out; pl[35] = (unsigned long long)K.ws;
        bst[0] = 0u; bst[1] = 0u;
    }
    __syncthreads();
    (void)xcd_barrier_post((unsigned*)(K.ws + WS_CTL), bst);
#pragma nounroll
    for (int ph = 0; ph < PH_COUNT; ++ph) {
        int phv = ph, bid = blockIdx.x, G = gridDim.x, tid = threadIdx.x; unsigned lo = 0;
        asm volatile("" : "+s"(phv), "+s"(bid), "+s"(G), "+s"(lo), "+v"(tid));
        Params P; P.pl = (const LAS unsigned long long*)((LAS unsigned char*)lds + PARAM_LDS_OFF + lo);
        run_phase(phv, P, (LAS unsigned char*)lds + lo, bid, G, tid);
#ifdef DUP_MASK
        if ((DUP_MASK >> ph) & 1u) {
            XcdBarrier bar; bar.bar = (unsigned*)(P.ws_() + WS_CTL); bar.x = xb_xcc_id(); bar.st = (volatile LAS unsigned*)((LAS unsigned char*)lds + lo + PARAM_LDS_OFF + 320);
            if (ph != 0) { xcd_barrier(bar); run_phase(phv, P, (LAS unsigned char*)lds + lo, bid, G, tid); } }
#endif
        if (ph == 0) grid.sync();
        else if (ph + 1 < PH_COUNT) {
            XcdBarrier bar; bar.bar = (unsigned*)(P.ws_() + WS_CTL); bar.x = xb_xcc_id(); bar.st = (volatile LAS unsigned*)((LAS unsigned char*)lds + lo + PARAM_LDS_OFF + 320);
            xcd_barrier(bar); }
    }
}
extern "C" void kernel_launch(void* const* d_in, const int* in_sizes, int n_in, void* d_out, int out_size, void* d_ws, size_t ws_size, hipStream_t stream) {
    static int grid = 0;
    if (grid == 0) {
        int dev = 0, cus = 0, per_cu = 0;
        (void)hipGetDevice(&dev); (void)hipDeviceGetAttribute(&cus, hipDeviceAttributeMultiprocessorCount, dev);
        (void)hipFuncSetAttribute((const void*)fwd_megakernel, hipFuncAttributeMaxDynamicSharedMemorySize, LDS_BYTES);
        if (hipOccupancyMaxActiveBlocksPerMultiprocessor(&per_cu, (const void*)fwd_megakernel, NTHREADS, LDS_BYTES) != hipSuccess || per_cu < 1) per_cu = 1;
        if (per_cu > 1) per_cu = 1;
        grid = (cus > 0 ? cus : 256) * per_cu;
        if (ws_size < WS_END) fprintf(stderr, "kernel_launch: workspace too small: %zu < %zu\n", ws_size, (size_t)WS_END);
    }
    ParamsK P{};
    for (int i = 0; i < 34; ++i) P.in[i] = (const float*)d_in[i];
    P.out = (float*)d_out; P.ws = (unsigned char*)d_ws;
    (void)hipMemsetAsync((char*)d_ws + WS_CTL, 0, CTL_ZERO_BYTES, stream);
    void* args[] = {&P};
    hipError_t e = hipLaunchCooperativeKernel((const void*)fwd_megakernel, dim3(grid), dim3(NTHREADS), args, LDS_BYTES, stream);
    if (e != hipSuccess) fprintf(stderr, "cooperative launch failed: %s (grid %d)\n", hipGetErrorString(e), grid);
}
#endif
```

```cpp
#ifndef EMU
#include <hip/hip_runtime.h>
#include <cstdio>
#include <cstdint>
#endif

#ifndef CFG_BATCH
#define CFG_BATCH 4
#define CFG_SEQ 4096
#define CFG_CTX 256
#define CFG_GW 64
#endif
constexpr int D = 1024, NB = CFG_BATCH, SEQ = CFG_SEQ, CTX = CFG_CTX, GW = CFG_GW, GROWS = SEQ / GW, CHUNK = 64;
constexpr int ML = NB * SEQ, MC = NB * CTX, MT = ML + MC;
static_assert(ML % 256 == 0 && MT % 256 == 0 && SEQ % 64 == 0 && CTX % 64 == 0, "row tiling");
constexpr int NMOD = 6 * D;
constexpr int DFF = 2816;
constexpr int A_IN = 5696, NP0 = 5888;
constexpr int C_G = 0, C_Z = 1024, C_Q = 2048, C_K = 2560, C_V = 3072, C_XS = 4096, C_B = 5120, C_C = 5376, C_R = 5632, C_DT = 5664;
constexpr float EPS = 1e-6f;
constexpr int NTHREADS = 512, NWAVES = 8;
constexpr int G1_NSL = 3, G3_NSL = ((size_t)MT * (NP0 - DFF) * 2 >= (size_t)11 * MC * D * 4) ? 11 : 4;

#ifdef EMU
#define LAS
#define GAS
#define GAS
#define ASM_VMCNT(n) do {} while (0)
#define ASM_LGKMCNT(n) do {} while (0)
#define ASM_FENCE() do {} while (0)
#define WAVE_LDS_SYNC() emu::wave_sync()
#define LDS_BARRIER() __syncthreads()
#define SCHED_FENCE() do {} while (0)
#define OPAQUE_V(x) do {} while (0)
#else
#define LAS __attribute__((address_space(3)))
#define GAS __attribute__((address_space(1)))
#define GAS __attribute__((address_space(1)))
#define ASM_VMCNT(n) asm volatile("s_waitcnt vmcnt(" #n ")" ::: "memory")
#define ASM_LGKMCNT(n) asm volatile("s_waitcnt lgkmcnt(" #n ")" ::: "memory")
#define ASM_FENCE() asm volatile("" ::: "memory")
#define LDS_BARRIER() asm volatile("s_waitcnt lgkmcnt(0)\n\ts_barrier" ::: "memory")
#define SCHED_FENCE() do { asm volatile("" ::: "memory"); __builtin_amdgcn_sched_barrier(0); } while (0)
#define OPAQUE_V(x) asm volatile("" : "+v"(x))
#define WAVE_LDS_SYNC() do { asm volatile("s_waitcnt lgkmcnt(0)" ::: "memory"); } while (0)
#endif

typedef unsigned short bf16_t;
typedef short bf16x8 __attribute__((ext_vector_type(8)));
typedef short bf16x4 __attribute__((ext_vector_type(4)));
typedef float f32x4 __attribute__((ext_vector_type(4)));
typedef float f32x2 __attribute__((ext_vector_type(2)));
typedef unsigned u32x4 __attribute__((ext_vector_type(4)));
typedef unsigned u32x2 __attribute__((ext_vector_type(2)));

__device__ __forceinline__ unsigned f2bf(float f) { unsigned u = __builtin_bit_cast(unsigned, f); return (u + 0x7fffu + ((u >> 16) & 1u)) >> 16; }
#ifdef EMU
__device__ __forceinline__ unsigned pk2(float lo, float hi) { return f2bf(lo) | (f2bf(hi) << 16); }
#else
typedef __bf16 hwbf16x2 __attribute__((ext_vector_type(2)));
__device__ __forceinline__ unsigned pk2(float lo, float hi) { const f32x2 v = {lo, hi}; return __builtin_bit_cast(unsigned, __builtin_convertvector(v, hwbf16x2)); }
#endif
#ifdef EMU
__device__ __forceinline__ float dot2bf(unsigned a, unsigned b, float c) { return emu_fdot2_bf16(a, b, c); }
#else
__device__ __forceinline__ float dot2bf(unsigned a, unsigned b, float c) { return __builtin_amdgcn_fdot2_f32_bf16(__builtin_bit_cast(hwbf16x2, a), __builtin_bit_cast(hwbf16x2, b), c, false); }
#endif
__device__ __forceinline__ float bf2f(unsigned h) { return __builtin_bit_cast(float, (h & 0xffffu) << 16); }
__device__ __forceinline__ float bflo(unsigned w) { return __builtin_bit_cast(float, w << 16); }
__device__ __forceinline__ float bfhi(unsigned w) { return __builtin_bit_cast(float, w & 0xffff0000u); }
__device__ __forceinline__ float sigmoidf_(float x) { return __builtin_amdgcn_rcpf(1.0f + __expf(-x)); }
__device__ __forceinline__ float siluf_(float x) { return x * __builtin_amdgcn_rcpf(1.0f + __expf(-x)); }
__device__ __forceinline__ float log1pexp_(float ax) { return __logf(1.0f + __expf(-ax)); }
__device__ __forceinline__ float log_sigmoidf_(float x) { return fminf(x, 0.f) - log1pexp_(fabsf(x)); }
__device__ __forceinline__ float softplusf_(float x) { return fmaxf(x, 0.f) + log1pexp_(fabsf(x)); }
__device__ __forceinline__ float wave_sum(float v) {
#pragma unroll
    for (int o = 1; o < 64; o <<= 1) v += __shfl_xor(v, o);
    return v;
}

constexpr size_t MiB = 1u << 20;
constexpr size_t WS_CTL = 0;
constexpr size_t WS_MOD = 64 * 1024;
constexpr size_t MOD_BYTES = (size_t)2 * (NB + 1) * NMOD * 4;
constexpr size_t CTL_ZERO_BYTES = 512 * 1024;
static_assert(WS_MOD + MOD_BYTES <= CTL_ZERO_BYTES && 3456 * 4 <= WS_MOD, "mods and barrier words inside the memset region");
constexpr size_t WS_GATES = 1 * MiB;
constexpr size_t WS_WB = 3 * MiB;
constexpr size_t WS_CTXRES = 9 * MiB;
constexpr size_t WS_H = 13 * MiB;
constexpr size_t WS_BIG = 47 * MiB;
constexpr size_t BIG_BYTES = (size_t)MT * NP0 * 2;
constexpr size_t WS_WA = WS_BIG + ((BIG_BYTES + 255) & ~(size_t)255);
constexpr size_t WS_END = WS_WA + 12 * MiB;
static_assert((size_t)MT * DFF * 2 + (size_t)G3_NSL * MC * D * 4 <= BIG_BYTES, "FFN-down partial slabs fit behind the hidden activations");
static_assert(WS_CTXRES + (size_t)MC * D * 4 <= WS_H && WS_H + (size_t)MT * D * 2 <= WS_BIG, "workspace map");
static_assert((size_t)MT * 4096 * 2 + (size_t)ML * 2048 * 2 <= BIG_BYTES + 5 * MiB, "layer-1 O spills at most 5 MiB into WA");
static_assert(WS_END <= 256 * MiB, "workspace fits 256 MiB");

struct ParamsK {
    const float* in[34];
    float* out;
    unsigned char* ws;
};
constexpr int PARAM_LDS_OFF = 147456 - 512;
struct Params {
    const LAS unsigned long long* pl;
    __device__ __forceinline__ unsigned long long ld(int i) const {
#ifdef EMU
        return pl[i];
#else
        const unsigned long long v = pl[i]; const unsigned lo = __builtin_amdgcn_readfirstlane((unsigned)v), hi = __builtin_amdgcn_readfirstlane((unsigned)(v >> 32));
        return ((unsigned long long)hi << 32) | lo;
#endif
    }
    __device__ __forceinline__ const float* in_(int i) const { return (const float*)ld(i); }
    __device__ __forceinline__ float* out_() const { return (float*)ld(34); }
    __device__ __forceinline__ unsigned char* ws_() const { return (unsigned char*)ld(35); }
};
#ifdef EMU
template <class T> __device__ __forceinline__ T* gmem(T* p) { return p; }
#else
template <class T> __device__ __forceinline__ T* gmem(T* p) { return (T*)(GAS T*)(unsigned long long)p; }
#endif
enum { I_X = 0, I_C, I_CTX, I_CCTX, I_WMOD, I_BMOD, I_NMIX, I_NFFN, I_W1, I_W3, I_W2, I_AWIN, I_AGW, I_AGB, I_AGN, I_ACW, I_ACB, I_AALOG, I_ADTB, I_AD, I_ASN, I_AWOUT,
       I_BWUP, I_BCW, I_BCB, I_BWQ, I_BWK, I_BWV, I_BWIF, I_BBIF, I_BMHN, I_BSKIP, I_BWDOWN, I_FNORM };

namespace pg8 {
constexpr int BM = 256, BK = 64, HALF = 128, HTB = HALF * BK * 2, STAGE_BYTES = 8 * HTB, NXCD = 8, WGM = 8;
__host__ __device__ __forceinline__ int lds_byte(int r, int c) { const int st = (r >> 4) * 2 + (c >> 5), rr = r & 15, cc = c & 31, ob = rr * 64 + cc * 2; return st * 1024 + (ob ^ (((ob >> 9) & 1) << 5)); }
__host__ __device__ __forceinline__ void stage_rc(int b, int& R, int& C) { const int st = b / 1024, sb = b % 1024, swz = sb ^ (((sb >> 9) & 1) << 5); R = (st >> 1) * 16 + swz / 64; C = (st & 1) * 32 + (swz % 64) / 2; }
__host__ __device__ __forceinline__ int perm32(int rho) { const int n = rho >> 4, i = rho & 15; return 8 * (i >> 2) + 4 * n + (i & 3); }
struct Unit { int pm, pn, k0, nt, sl; };
struct Gemm { const bf16_t* A; const bf16_t* Bt; int M, N, K, lda; };
template <int NXM = 0, int NSL = 1>
struct StaticOrderT {
    int nM, nN, G, c, ntK;
    __host__ __device__ void init(int M, int N, int K, int G_, int c_) { nM = M / BM; nN = N / BM; G = G_; c = c_; ntK = K / BK; }
    __host__ __device__ bool next(int i, Unit& u) const {
        const int nwg = nM * nN; const int L = i * G + c;
        int pm = 0, pn = 0, k0 = 0, nt = ntK, sl = -1; bool ok = false;
        if (L < nwg) {
            int wgid = L; { const int q = nwg / NXCD, r = nwg % NXCD, xcd = wgid % NXCD, off = wgid / NXCD; wgid = (xcd < r ? xcd * (q + 1) : r * (q + 1) + (xcd - r) * q) + off; }
            const int nig = WGM * nN, gid = wgid / nig, fm = gid * WGM, gsz = (nM - fm) < WGM ? (nM - fm) : WGM;
            pm = fm + ((wgid % nig) % gsz); pn = (wgid % nig) / gsz; ok = true; }
        else if (NXM != 0) {
            const int xunits = NXM * nN * NSL, nmain = (nwg - c + G - 1) / G;
            const int j = (i - nmain) * G + c;
            if (j < xunits) { sl = j % NSL; const int t = j / NSL; pn = t % nN; pm = nM + t / nN;
                const int base = (ntK / NSL) & ~1; k0 = sl * base; nt = (sl == NSL - 1) ? ntK - base * (NSL - 1) : base; ok = true; }
        }
        u.pm = pm; u.pn = pn; u.k0 = k0; u.nt = nt; u.sl = sl; return ok;
    }
};
typedef StaticOrderT<0, 1> StaticOrder;
template <class Epi, class Order>
__device__ __forceinline__ void gemm_phase(LAS unsigned char* lds, const Gemm g, const Order& S, const Epi& E, const int tid) {
    const int wid = __builtin_amdgcn_readfirstlane(tid >> 6), lane = tid & 63, wr = wid >> 2, wc = wid & 3, fr = lane & 15, fq = lane >> 4;
    const int K = g.K, lda = g.lda;
    unsigned voffA[2], voffB[2];
#pragma unroll
    for (int i = 0; i < 2; ++i) { int R, C; stage_rc(tid * 16 + i * 8192, R, C); const int Rb = Epi::PERM ? ((R & ~31) + perm32(R & 31)) : R;
        voffA[i] = (unsigned)(R * lda + C) * 2u; voffB[i] = (unsigned)(Rb * K + C) * 2u; }
    const size_t kstep = (size_t)(BK * 2);
    const size_t hstepA = (size_t)HALF * lda * 2, hstepB = (size_t)HALF * K * 2;
    const size_t tstepA = 2 * hstepA, tstepB = 2 * hstepB;
    const unsigned ldsw = (unsigned)wid * 1024u;
    const int aoff = lds_byte(wr * 64 + fr, fq * 8), boff = lds_byte(wc * 32 + fr, fq * 8);
#define PG8_SA(b, h) (((b) * 2 + (h)) * HTB)
#define PG8_SB(b, h) ((4 + (b) * 2 + (h)) * HTB)
#define PG8_STAGE(bufoff, gbase, voff) do { _Pragma("unroll") for (int _i = 0; _i < 2; ++_i) \
        __builtin_amdgcn_global_load_lds((const unsigned*)((const char*)(gbase) + (voff)[_i]), (LAS unsigned*)(lds + (bufoff) + ldsw + _i * 8192), 16, 0, 0); } while (0)
#define PG8_LDA(dst, b, h) do { _Pragma("unroll") for (int m = 0; m < 4; ++m) _Pragma("unroll") for (int k = 0; k < 2; ++k) dst[m][k] = *(const LAS bf16x8*)(lds + PG8_SA(b, h) + aoff + m * 2048 + k * 1024); } while (0)
#define PG8_LDB(dst, b, h) do { _Pragma("unroll") for (int n = 0; n < 2; ++n) _Pragma("unroll") for (int k = 0; k < 2; ++k) dst[n][k] = *(const LAS bf16x8*)(lds + PG8_SB(b, h) + boff + n * 2048 + k * 1024); } while (0)
#define PG8_MMA(ai, bj, At, Bt) do { __builtin_amdgcn_s_setprio(1); _Pragma("unroll") for (int m = 0; m < 4; ++m) _Pragma("unroll") for (int n = 0; n < 2; ++n) _Pragma("unroll") for (int k = 0; k < 2; ++k) \
        acc[ai][bj][m][n] = __builtin_amdgcn_mfma_f32_16x16x32_bf16(Bt[n][k], At[m][k], acc[ai][bj][m][n], 0, 0, 0); __builtin_amdgcn_s_setprio(0); } while (0)
#define PG8_BAR __builtin_amdgcn_s_barrier()
#define PG8_SCHED __builtin_amdgcn_sched_barrier(0)
    Unit cur, nxt; int ui = 0;
    if (!S.next(0, cur)) return;
    f32x4 acc[2][2][4][2];
#pragma unroll
    for (int a = 0; a < 2; ++a)
#pragma unroll
        for (int b = 0; b < 2; ++b)
#pragma unroll
            for (int m = 0; m < 4; ++m)
#pragma unroll
                for (int n = 0; n < 2; ++n) acc[a][b][m][n] = (f32x4){0.f, 0.f, 0.f, 0.f};
    bf16x8 At[4][2], B0[2][2], B1[2][2];
    const char* cA = (const char*)g.A + (size_t)cur.pm * tstepA + (size_t)cur.k0 * kstep; const char* cB = (const char*)g.Bt + (size_t)cur.pn * tstepB + (size_t)cur.k0 * kstep;
    PG8_STAGE(PG8_SB(0, 0), cB, voffB); PG8_STAGE(PG8_SB(0, 1), cB + hstepB, voffB); PG8_STAGE(PG8_SA(0, 0), cA, voffA); PG8_STAGE(PG8_SA(0, 1), cA + hstepA, voffA);
    if (wr == 1) PG8_BAR;
    ASM_VMCNT(2); PG8_BAR;
    PG8_STAGE(PG8_SB(1, 0), cB + kstep, voffB); PG8_STAGE(PG8_SA(1, 0), cA + kstep, voffA); PG8_STAGE(PG8_SB(1, 1), cB + hstepB + kstep, voffB);
    ASM_VMCNT(6); PG8_BAR;
    for (;;) {
        const bool has_next = S.next(ui + 1, nxt);
        const char* nA = has_next ? (const char*)g.A + (size_t)nxt.pm * tstepA + (size_t)nxt.k0 * kstep : cA; const char* nB = has_next ? (const char*)g.Bt + (size_t)nxt.pn * tstepB + (size_t)nxt.k0 * kstep : cB;
        const int nt = cur.nt;
        for (int t = 0; t < nt; t += 2) {
            const bool last = (t == nt - 2);
            const char* a1 = cA + (size_t)(t + 1) * kstep;
            const char* a2 = last ? nA : cA + (size_t)(t + 2) * kstep; const char* b2 = last ? nB : cB + (size_t)(t + 2) * kstep;
            const char* a3 = a2 + kstep; const char* b3 = b2 + kstep;
            PG8_LDB(B0, 0, 0); PG8_LDB(B1, 0, 1); PG8_SCHED; PG8_LDA(At, 0, 0); PG8_STAGE(PG8_SA(1, 1), a1 + hstepA, voffA);
            ASM_VMCNT(8); ASM_LGKMCNT(0); PG8_BAR; PG8_MMA(0, 0, At, B0); PG8_MMA(0, 1, At, B1); PG8_BAR; PG8_SCHED;
            PG8_LDA(At, 0, 1); PG8_STAGE(PG8_SB(0, 0), b2, voffB); PG8_STAGE(PG8_SB(0, 1), b2 + hstepB, voffB); PG8_STAGE(PG8_SA(0, 0), a2, voffA);
            ASM_VMCNT(8); ASM_LGKMCNT(0); PG8_BAR; PG8_MMA(1, 0, At, B0); PG8_MMA(1, 1, At, B1); PG8_BAR; PG8_SCHED;
            PG8_LDB(B0, 1, 0); PG8_LDB(B1, 1, 1); PG8_SCHED; PG8_LDA(At, 1, 0); PG8_STAGE(PG8_SA(0, 1), a2 + hstepA, voffA);
            ASM_VMCNT(8); ASM_LGKMCNT(0); PG8_BAR; PG8_MMA(0, 0, At, B0); PG8_MMA(0, 1, At, B1); PG8_BAR; PG8_SCHED;
            PG8_LDA(At, 1, 1); PG8_STAGE(PG8_SB(1, 0), b3, voffB); PG8_STAGE(PG8_SB(1, 1), b3 + hstepB, voffB); PG8_STAGE(PG8_SA(1, 0), a3, voffA);
            ASM_VMCNT(8); ASM_LGKMCNT(0); PG8_BAR; PG8_MMA(1, 0, At, B0); PG8_MMA(1, 1, At, B1); PG8_BAR; PG8_SCHED;
        }
        if (wr == 0) PG8_BAR;
        E(acc, cur, wr, wc, fr, fq);
        if (!has_next) break;
#pragma unroll
        for (int a = 0; a < 2; ++a)
#pragma unroll
            for (int b = 0; b < 2; ++b)
#pragma unroll
                for (int m = 0; m < 4; ++m)
#pragma unroll
                    for (int n = 0; n < 2; ++n) acc[a][b][m][n] = (f32x4){0.f, 0.f, 0.f, 0.f};
        cur = nxt; cA = nA; cB = nB; ++ui;
        if (wr == 1) PG8_BAR;
    }
    ASM_VMCNT(0);
    PG8_BAR;
#undef PG8_SA
#undef PG8_SB
#undef PG8_STAGE
#undef PG8_LDA
#undef PG8_LDB
#undef PG8_MMA
#undef PG8_BAR
#undef PG8_SCHED
}
}

struct EpiStoreBf16 {
    static constexpr bool PERM = true;
    bf16_t* O; int ldc;
    __device__ __forceinline__ void operator()(const f32x4 (&acc)[2][2][4][2], const pg8::Unit& u, int wr, int wc, int fr, int fq) const {
        const int row0 = u.pm * 256 + wr * 64 + fr, col0 = u.pn * 256 + wc * 32 + 8 * fq;
#pragma unroll
        for (int ai = 0; ai < 2; ++ai)
#pragma unroll
            for (int m = 0; m < 4; ++m) { bf16_t* rowp = O + (size_t)(row0 + ai * 128 + m * 16) * ldc + col0;
#pragma unroll
                for (int bj = 0; bj < 2; ++bj) { const f32x4 v0 = acc[ai][bj][m][0], v1 = acc[ai][bj][m][1];
                    u32x4 w; w.x = pk2(v0[0], v0[1]); w.y = pk2(v0[2], v0[3]); w.z = pk2(v1[0], v1[1]); w.w = pk2(v1[2], v1[3]);
                    *(u32x4*)(rowp + bj * 128) = w; } }
    }
};
struct EpiStoreBf16Halo {
    static constexpr bool PERM = true;
    bf16_t* O; int ldc; bf16_t* HL;
    __device__ __forceinline__ void operator()(const f32x4 (&acc)[2][2][4][2], const pg8::Unit& u, int wr, int wc, int fr, int fq) const {
        const int row0 = u.pm * 256 + wr * 64 + fr, col0 = u.pn * 256 + wc * 32 + 8 * fq;
        const bool xs = u.pn >= 8 && u.pn < 14;
#pragma unroll
        for (int ai = 0; ai < 2; ++ai)
#pragma unroll
            for (int m = 0; m < 4; ++m) { const int row = row0 + ai * 128 + m * 16; bf16_t* rowp = O + (size_t)row * ldc + col0;
                const bool edge = xs && ((m == 0 && fr == 0) || (m == 3 && fr == 15));
                bf16_t* hp = HL;
                if (edge) { const int isl = row < ML, rc = isl ? row : row - ML; const int b = isl ? rc / SEQ : rc / CTX, gch = isl ? CTX / 64 + (rc % SEQ) / 64 : (rc % CTX) / 64;
                    hp = HL + (size_t)((b * (CTX / 64 + SEQ / 64) + gch) * 2 + (m == 3 ? 1 : 0)) * 1536 + (col0 - 2048); }
#pragma unroll
                for (int bj = 0; bj < 2; ++bj) { const f32x4 v0 = acc[ai][bj][m][0], v1 = acc[ai][bj][m][1];
                    u32x4 w; w.x = pk2(v0[0], v0[1]); w.y = pk2(v0[2], v0[3]); w.z = pk2(v1[0], v1[1]); w.w = pk2(v1[2], v1[3]);
                    *(u32x4*)(rowp + bj * 128) = w;
                    if (edge) *(u32x4*)(hp + bj * 128) = w; } }
    }
};
struct EpiSwiGLU {
    static constexpr bool PERM = true;
    bf16_t* O; int ldc;
    __device__ __forceinline__ void operator()(const f32x4 (&acc)[2][2][4][2], const pg8::Unit& u, int wr, int wc, int fr, int fq) const {
        const int row0 = u.pm * 256 + wr * 64 + fr, col0 = u.pn * 128 + wc * 32 + 8 * fq;
#pragma unroll
        for (int ai = 0; ai < 2; ++ai)
#pragma unroll
            for (int m = 0; m < 4; ++m) { bf16_t* rowp = O + (size_t)(row0 + ai * 128 + m * 16) * ldc + col0;
                float r[8];
#pragma unroll
                for (int n = 0; n < 2; ++n)
#pragma unroll
                    for (int i = 0; i < 4; ++i) r[n * 4 + i] = siluf_(acc[ai][0][m][n][i]) * acc[ai][1][m][n][i];
                u32x4 w; w.x = pk2(r[0], r[1]); w.y = pk2(r[2], r[3]); w.z = pk2(r[4], r[5]); w.w = pk2(r[6], r[7]);
                *(u32x4*)rowp = w; }
    }
};
struct EpiResid {
    static constexpr bool PERM = false;
    const float* xin_lat; const float* xin_ctx; float* xout_lat; float* xout_ctx; const float* gate;
    float* part; int prs;
    __device__ __forceinline__ void operator()(const f32x4 (&acc)[2][2][4][2], const pg8::Unit& u, int wr, int wc, int fr, int fq) const {
        if (u.sl >= 0) { const int col0 = u.pn * 256 + wc * 32 + 4 * fq;
#pragma unroll
            for (int ai = 0; ai < 2; ++ai)
#pragma unroll
                for (int m = 0; m < 4; ++m) { float* pr = part + (size_t)(u.sl * MC + u.pm * 256 - ML + ai * 128 + wr * 64 + m * 16 + fr) * prs + col0;
#pragma unroll
                    for (int bj = 0; bj < 2; ++bj)
#pragma unroll
                        for (int n = 0; n < 2; ++n) *(f32x4*)(pr + bj * 128 + n * 16) = acc[ai][bj][m][n]; }
            return; }
        const int rbase = u.pm * 256;
        const bool isctx = rbase >= ML;
        const float* xin = isctx ? xin_ctx - (size_t)ML * D : xin_lat; float* xout = isctx ? xout_ctx - (size_t)ML * D : xout_lat;
        const float* gp = gate + (size_t)(isctx ? NB : rbase / SEQ) * NMOD;
        const int col0 = u.pn * 256 + wc * 32 + 4 * fq;
        f32x4 gv[2][2];
#pragma unroll
        for (int bj = 0; bj < 2; ++bj)
#pragma unroll
            for (int n = 0; n < 2; ++n) gv[bj][n] = *(const f32x4*)(gp + col0 + bj * 128 + n * 16);
#pragma unroll
        for (int ai = 0; ai < 2; ++ai)
#pragma unroll
            for (int m = 0; m < 4; ++m) { const size_t off = (size_t)(rbase + ai * 128 + wr * 64 + m * 16 + fr) * D + col0;
#pragma unroll
                for (int bj = 0; bj < 2; ++bj)
#pragma unroll
                    for (int n = 0; n < 2; ++n) { const f32x4 xi = *(const f32x4*)(xin + off + bj * 128 + n * 16);
                        *(f32x4*)(xout + off + bj * 128 + n * 16) = xi + gv[bj][n] * acc[ai][bj][m][n]; } }
    }
};

struct Ctx {
    LAS unsigned char* lds; int tid, lane, wave, bid, G;
};
__device__ __forceinline__ void cvt_item(const float* W, int ldw, int K, int c0, bf16_t* WT, int r0, LAS float* scr, int item, int nblk, int lane) {
    const int kb = item / nblk, nb = item % nblk, k0 = 64 * kb, n0 = 32 * nb;
#pragma unroll
    for (int i = 0; i < 8; ++i) { const int kk = 8 * i + (lane >> 3), c4 = (lane & 7) * 4; const f32x4 v = *(const f32x4*)(W + (size_t)(k0 + kk) * ldw + c0 + n0 + c4);
        LAS float* d = scr + kk * 33 + c4; d[0] = v[0]; d[1] = v[1]; d[2] = v[2]; d[3] = v[3]; }
    WAVE_LDS_SYNC();
    const int c = lane & 7;
#pragma unroll
    for (int j = 0; j < 4; ++j) { const int n = (lane >> 3) + 8 * j; const LAS float* s = scr + (8 * c) * 33 + n;
        u32x4 o; o.x = pk2(s[0 * 33], s[1 * 33]); o.y = pk2(s[2 * 33], s[3 * 33]); o.z = pk2(s[4 * 33], s[5 * 33]); o.w = pk2(s[6 * 33], s[7 * 33]);
        *(u32x4*)(WT + (size_t)(r0 + n0 + n) * K + k0 + 8 * c) = o; }
    WAVE_LDS_SYNC();
}
__device__ __forceinline__ void cvt_seg(const Ctx& c, const float* W, int ldw, int K, int c0, int ncols, bf16_t* WT, int r0, int& base) {
    LAS float* scr = (LAS float*)(c.lds + c.wave * 16384);
    const int nblk = ncols / 32, nitems = (K / 64) * nblk, NGW = c.G * NWAVES, gw = c.bid * NWAVES + c.wave;
    int first = (gw - base) % NGW; if (first < 0) first += NGW;
    for (int it = first; it < nitems; it += NGW) cvt_item(W, ldw, K, c0, WT, r0, scr, it, nblk, c.lane);
    base = (base + nitems) % NGW;
}

struct CtxFix { const float* part; int prs, nsl; const float* gate; float* ctx_out; };
__device__ __forceinline__ void phase_hnorm(const Ctx& c, const float* xlat, const float* xctx, const float* w, const float* mod, int shift_blk, int scale_blk, bf16_t* H, int row_lo, int row_hi, const CtxFix fx = CtxFix{nullptr, 0, 0, nullptr, nullptr}) {
    const int gw = c.bid * NWAVES + c.wave, NGW = c.G * NWAVES;
    f32x4 wv[4];
#pragma unroll
    for (int j = 0; j < 4; ++j) wv[j] = *(const f32x4*)(w + 4 * c.lane + 256 * j);
    f32x4 nv[4];
    { const int r0 = row_lo + gw; if (r0 < row_hi) { const float* xr = r0 >= ML ? xctx + (size_t)(r0 - ML) * D : xlat + (size_t)r0 * D;
#pragma unroll
        for (int j = 0; j < 4; ++j) nv[j] = *(const f32x4*)(xr + 4 * c.lane + 256 * j); } }
    for (int row = row_lo + gw; row < row_hi; row += NGW) {
        const bool isctx = row >= ML;
        const float* mp = mod + (size_t)(isctx ? NB : row / SEQ) * NMOD;
        f32x4 v[4]; float s = 0.f;
#pragma unroll
        for (int j = 0; j < 4; ++j) v[j] = nv[j];
        { const int r1 = row + NGW; if (r1 < row_hi) { const float* xr = r1 >= ML ? xctx + (size_t)(r1 - ML) * D : xlat + (size_t)r1 * D;
#pragma unroll
            for (int j = 0; j < 4; ++j) nv[j] = *(const f32x4*)(xr + 4 * c.lane + 256 * j); } }
        f32x4 shv[4], scv[4];
#pragma unroll
        for (int j = 0; j < 4; ++j) { shv[j] = *(const f32x4*)(mp + shift_blk * D + 4 * c.lane + 256 * j); scv[j] = *(const f32x4*)(mp + scale_blk * D + 4 * c.lane + 256 * j); }
#pragma unroll
        for (int j = 0; j < 4; ++j) {
            if (isctx && fx.part) { f32x4 a = (f32x4){0.f, 0.f, 0.f, 0.f};
                for (int sl = 0; sl < fx.nsl; ++sl) a += *(const f32x4*)(fx.part + (size_t)(sl * MC + row - ML) * fx.prs + 4 * c.lane + 256 * j);
                v[j] += *(const f32x4*)(fx.gate + 4 * c.lane + 256 * j) * a;
                *(f32x4*)(fx.ctx_out + (size_t)(row - ML) * D + 4 * c.lane + 256 * j) = v[j]; }
            s += (v[j].x * v[j].x + v[j].y * v[j].y) + (v[j].z * v[j].z + v[j].w * v[j].w); }
        const float rs = 1.0f / sqrtf(wave_sum(s) * (1.0f / D) + EPS);
#pragma unroll
        for (int j = 0; j < 4; ++j) {
            const f32x4 o = v[j] * rs * wv[j] * (1.0f + scv[j]) + shv[j];
            u32x2 pw; pw.x = pk2(o.x, o.y); pw.y = pk2(o.z, o.w);
            *(u32x2*)(H + (size_t)row * D + 4 * c.lane + 256 * j) = pw;
        }
    }
}

__device__ __forceinline__ void phase_mods(const Ctx& c, const Params& P) {
    float* mod = (float*)(gmem(P.ws_()) + WS_MOD);
    const float* cv = gmem(P.in_(I_C)); const float* cc = gmem(P.in_(I_CCTX)); const float* wm = gmem(P.in_(I_WMOD)); const float* bm = gmem(P.in_(I_BMOD));
    LAS float* sc = (LAS float*)c.lds;
    LAS float* pt = sc + (NB + 1) * D;
    for (int i = c.tid; i < (NB + 1) * D; i += NTHREADS) { const int r = i / D, k = i % D; sc[i] = siluf_(r < NB ? cv[r * D + k] : cc[k]); }
    __syncthreads();
    constexpr int NU = 2 * (NMOD / 64);
    for (int u = c.bid; u < NU; u += c.G) {
        const int l = u / (NMOD / 64), kq = c.lane >> 4, n4 = (c.lane & 15) * 4, k0 = c.wave * 128;
        const float* wcol = wm + (size_t)l * D * NMOD + (u % (NMOD / 64)) * 64 + n4;
        f32x4 acc[NB + 1];
#pragma unroll
        for (int i = 0; i <= NB; ++i) acc[i] = (f32x4){0.f, 0.f, 0.f, 0.f};
#pragma unroll 8
        for (int kk = 0; kk < 32; ++kk) { const int k = k0 + 4 * kk + kq; const f32x4 wv = *(const f32x4*)(wcol + (size_t)k * NMOD);
#pragma unroll
            for (int i = 0; i <= NB; ++i) acc[i] += sc[i * D + k] * wv; }
#pragma unroll
        for (int i = 0; i <= NB; ++i) {
#pragma unroll
            for (int e = 0; e < 4; ++e) { float v = acc[i][e]; v += __shfl_xor(v, 16); v += __shfl_xor(v, 32); acc[i][e] = v; }
            if (kq == 0) *(LAS f32x4*)(pt + (c.wave * (NB + 1) + i) * 64 + n4) = acc[i]; }
        __syncthreads();
        if (c.tid < (NB + 1) * 64) { const int r = c.tid >> 6, nn = c.tid & 63; float s = bm[(size_t)l * NMOD + (u % (NMOD / 64)) * 64 + nn];
#pragma unroll
            for (int w = 0; w < 8; ++w) s += pt[(w * (NB + 1) + r) * 64 + nn];
            mod[((size_t)l * (NB + 1) + r) * NMOD + (u % (NMOD / 64)) * 64 + nn] = s; }
        __syncthreads();
    }
}

namespace sc0 {
constexpr int NCT = CTX / 64 + SEQ / 64, NCC = CTX / 64;
__device__ __forceinline__ size_t chunk_row0(int b, int gch) { return gch < NCC ? (size_t)ML + (size_t)b * CTX + (size_t)gch * 64 : (size_t)b * SEQ + (size_t)(gch - NCC) * 64; }
__device__ __forceinline__ bf16_t* tctx_ptr(unsigned char* ws) { return (bf16_t*)(ws + WS_WA + 4 * MiB); }
__device__ __forceinline__ float* ssdv_row(unsigned char* ws, size_t row) { return row < (size_t)ML ? (float*)(ws + WS_CTXRES) + row * 64 : (float*)(ws + WS_GATES + 5 * MiB / 4) + (row - ML) * 64; }
__device__ __forceinline__ float* glaf_ptr(unsigned char* ws) { return (float*)(ws + WS_GATES); }
__device__ __forceinline__ bf16_t* halo_ptr(unsigned char* ws) { return (bf16_t*)(ws + WS_WB); }
__device__ __forceinline__ bf16_t* qkf_row(unsigned char* ws, size_t row) { return row < (size_t)ML ? (bf16_t*)(ws + WS_BIG) + row * NP0 : (bf16_t*)(ws + WS_WB + 4 * MiB) + (row - ML) * D; }
static_assert((size_t)NB * NCT * 2 * 1536 * 2 <= 4 * MiB && (size_t)MC * D * 2 <= 2 * MiB, "halo and context q~k~ rows share WB");
static_assert((size_t)MC * 2048 * 2 <= 8 * MiB && (size_t)ML * 64 * 4 <= 4 * MiB && (size_t)NB * 8 * NCT * 128 * 4 <= 5 * MiB / 4 && (size_t)MC * 64 * 4 <= MiB / 4 && (size_t)NB * NCT * 2 * 1536 * 2 <= 6 * MiB, "layer-0 scan scratch");

constexpr int LQ = 136, LT = 72;
__device__ __forceinline__ bf16x8 frag(const LAS unsigned char* lds, int off, int ld, int row, int k) { return *(const LAS bf16x8*)(lds + off + (row * ld + k) * 2); }
__device__ __forceinline__ bf16x8 tr_frag(const LAS unsigned char* lds, int off, int ld, int k0, int n0, int fr, int fq) {
    typedef short v4i16_t __attribute__((ext_vector_type(4)));
    const LAS unsigned char* p0 = lds + off + ((k0 + 8 * fq + (fr >> 2)) * ld + n0 + 4 * (fr & 3)) * 2;
    const v4i16_t a = __builtin_amdgcn_ds_read_tr16_b64_v4i16((LAS v4i16_t*)p0), b = __builtin_amdgcn_ds_read_tr16_b64_v4i16((LAS v4i16_t*)(p0 + 4 * ld * 2));
    return (bf16x8){a[0], a[1], a[2], a[3], b[0], b[1], b[2], b[3]};
}

__device__ __forceinline__ void phase_prep0a(const Ctx& c, const Params& P) {
    const bf16_t* P0 = (const bf16_t*)(gmem(P.ws_()) + WS_BIG); bf16_t* HL = halo_ptr(gmem(P.ws_()));
    const int n = NB * NCT * 2 * (1536 / 8);
    for (int i = c.bid * NTHREADS + c.tid; i < n; i += c.G * NTHREADS) { const int piece = i % 192, which = (i / 192) & 1, u = i / 384, b = u / NCT, gch = u % NCT;
        const size_t row = chunk_row0(b, gch) + (which ? 63 : 0);
        *(u32x4*)(HL + (size_t)(u * 2 + which) * 1536 + piece * 8) = *(const u32x4*)(P0 + row * NP0 + C_XS + piece * 8); }
}
constexpr int PB_T = 0;
constexpr int PB_W = 66 * 776 * 2;
static_assert(PB_W + 4 * 768 * 4 <= PARAM_LDS_OFF, "prep0 LDS");
__device__ __forceinline__ void prep_ssd_unit(const Ctx& c, const Params& P, int b, int gch) {
    LAS unsigned char* lds = c.lds; const int tid = c.tid, lane = c.lane, w = c.wave;
    bf16_t* P0 = (bf16_t*)(gmem(P.ws_()) + WS_BIG); const bf16_t* HL = halo_ptr(gmem(P.ws_()));
    const size_t row0 = chunk_row0(b, gch); const int isctx = gch < NCC; const int u = b * NCT + gch;
    const bool hasprev = gch != 0 && gch != NCC, hasnext = gch != NCC - 1 && gch != NCT - 1;
    LAS float* cwl = (LAS float*)(lds + PB_W);
    for (int half = 0; half < 2; ++half) {
        const int col0 = half * 768;
        { float wreg[6];
#pragma unroll
          for (int k = 0; k < 6; ++k) { const int i = tid + k * NTHREADS, tap = i / 768, cc = i % 768; wreg[k] = tap < 3 ? gmem(P.in_(I_ACW))[tap * 1536 + col0 + cc] : gmem(P.in_(I_ACB))[col0 + cc]; }
          u32x4 treg[13];
#pragma unroll
          for (int k = 0; k < 13; ++k) { const int i = tid + k * NTHREADS, r = i / 96, pc = i % 96; u32x4 v = (u32x4){0u, 0u, 0u, 0u};
              if (i < 66 * 96) {
                  if (r == 0) { if (hasprev) v = *(const u32x4*)(HL + (size_t)((u - 1) * 2 + 1) * 1536 + col0 + pc * 8); }
                  else if (r == 65) { if (hasnext) v = *(const u32x4*)(HL + (size_t)((u + 1) * 2 + 0) * 1536 + col0 + pc * 8); }
                  else v = *(const u32x4*)(P0 + (row0 + r - 1) * NP0 + C_XS + col0 + pc * 8); }
              treg[k] = v; }
#pragma unroll
          for (int k = 0; k < 6; ++k) cwl[tid + k * NTHREADS] = wreg[k];
#pragma unroll
          for (int k = 0; k < 13; ++k) { const int i = tid + k * NTHREADS, r = i / 96, pc = i % 96; if (i < 66 * 96) *(LAS u32x4*)(lds + PB_T + (r * 776 + pc * 8) * 2) = treg[k]; } }
        __syncthreads();
#pragma unroll 4
        for (int i = tid; i < 64 * 96; i += NTHREADS) { const int r = i / 96, pc = i % 96;
            const u32x4 a = *(const LAS u32x4*)(lds + PB_T + (r * 776 + pc * 8) * 2), m = *(const LAS u32x4*)(lds + PB_T + ((r + 1) * 776 + pc * 8) * 2), n = *(const LAS u32x4*)(lds + PB_T + ((r + 2) * 776 + pc * 8) * 2);
            const unsigned aw[4] = {a.x, a.y, a.z, a.w}, mw[4] = {m.x, m.y, m.z, m.w}, nw[4] = {n.x, n.y, n.z, n.w}; unsigned o[4];
            const LAS f32x4* cw4 = (const LAS f32x4*)(cwl + pc * 8);
            const f32x4 t0[2] = {cw4[0], cw4[1]}, t1[2] = {cw4[192], cw4[193]}, t2[2] = {cw4[384], cw4[385]}, tb[2] = {cw4[576], cw4[577]};
#pragma unroll
            for (int e = 0; e < 4; ++e) { const int hh = e >> 1, j = 2 * (e & 1);
                const float y0 = siluf_(t0[hh][j] * bflo(aw[e]) + t1[hh][j] * bflo(mw[e]) + t2[hh][j] * bflo(nw[e]) + tb[hh][j]);
                const float y1 = siluf_(t0[hh][j + 1] * bfhi(aw[e]) + t1[hh][j + 1] * bfhi(mw[e]) + t2[hh][j + 1] * bfhi(nw[e]) + tb[hh][j + 1]);
                o[e] = pk2(y0, y1); }
            *(u32x4*)(P0 + (row0 + r) * NP0 + C_XS + col0 + pc * 8) = (u32x4){o[0], o[1], o[2], o[3]}; }
        __syncthreads();
    }
#pragma unroll
    for (int q = 0; q < 4; ++q) { const int dh = w * 4 + q, dir = dh >> 4, h = dh & 15; const size_t row = row0 + (dir ? 63 - lane : lane);
        const float dt = softplusf_(bf2f(P0[row * NP0 + C_DT + dh]) + gmem(P.in_(I_ADTB))[dh]); float v = -dt * __expf(gmem(P.in_(I_AALOG))[dh]);
#pragma unroll
        for (int o = 1; o < 64; o <<= 1) { const float uu = __shfl(v, lane >= o ? lane - o : lane); if (lane >= o) v += uu; }
        *(f32x2*)(ssdv_row(gmem(P.ws_()), row) + dh * 2) = (f32x2){dt, v}; (void)h; }
    (void)isctx;
}
constexpr int PG_LA = 0;
constexpr int PG_PART = PG_LA + 64 * 128 * 4;
constexpr int PG_R = PG_PART + 4 * 128 * 4;
constexpr int PG_WG = PG_R + 64 * 40 * 2;
constexpr int PG_BG = PG_WG + 128 * 40 * 2;
constexpr int PG_DIR = PG_BG + 128 * 4;
static_assert(2 * PG_DIR <= PARAM_LDS_OFF && PG_DIR % 16 == 0, "prep0 GLA LDS");
__device__ __forceinline__ void prep_gla_unit(const Ctx& c, const Params& P, int b, int gch, int h) {
    LAS unsigned char* lds = c.lds; const int tid = c.tid, lane = c.lane, w = c.wave, fr = lane & 15, fq = lane >> 4, ti_ = tid >> 3, seg = tid & 7;
    bf16_t* P0 = (bf16_t*)(gmem(P.ws_()) + WS_BIG); float* GF = glaf_ptr(gmem(P.ws_()));
    const size_t row0 = chunk_row0(b, gch);
    { const bf16_t* wg0 = (const bf16_t*)(gmem(P.ws_()) + WS_GATES + 7 * MiB / 4) + (size_t)h * 128 * 32;
      int tq = tid; OPAQUE_V(tq);
#pragma unroll
      for (int dir = 0; dir < 2; ++dir)
          *(LAS u32x4*)(lds + dir * PG_DIR + PG_WG + ((tq >> 2) * 40 + (tq & 3) * 8) * 2) = *(const u32x4*)(wg0 + (size_t)dir * 4 * 128 * 32 + (tq >> 2) * 32 + (tq & 3) * 8);
      if (tid < 256) { const int dir = tid >> 7, kk = tid & 127; ((LAS float*)(lds + dir * PG_DIR + PG_BG))[kk] = gmem(P.in_(I_AGB))[dir * 512 + h * 128 + kk]; }
      { const int dir = seg >> 2, s4 = seg & 3; u32x4 v = (u32x4){0u, 0u, 0u, 0u};
        if (s4 < 2) { const size_t rr = row0 + (dir ? 63 - ti_ : ti_); v = *(const u32x4*)(P0 + rr * NP0 + C_R + dir * 16 + s4 * 8); }
        *(LAS u32x4*)(lds + dir * PG_DIR + PG_R + (ti_ * 40 + s4 * 8) * 2) = v; } }
    __syncthreads();
    { const int ti = w >> 1;
#pragma unroll
      for (int dir = 0; dir < 2; ++dir) { const int dof = dir * PG_DIR; LAS float* la = (LAS float*)(lds + dof + PG_LA); const LAS float* bgl = (const LAS float*)(lds + dof + PG_BG);
          const bf16x8 a = frag(lds, dof + PG_R, 40, ti * 16 + fr, 8 * fq);
#pragma unroll
          for (int q = 0; q < 4; ++q) { const int tk = 4 * (w & 1) + q; const bf16x8 bb = frag(lds, dof + PG_WG, 40, tk * 16 + fr, 8 * fq);
              f32x4 acc = (f32x4){0.f, 0.f, 0.f, 0.f}; acc = __builtin_amdgcn_mfma_f32_16x16x32_bf16(a, bb, acc, 0, 0, 0);
              const float bg = bgl[tk * 16 + fr];
#pragma unroll
              for (int r = 0; r < 4; ++r) la[(ti * 16 + 4 * fq + r) * 128 + tk * 16 + fr] = log_sigmoidf_(acc[r] + bg) * (1.0f / 16.0f); } } }
    __syncthreads();
    const bf16_t* prow = P0 + (row0 + ti_) * NP0;
    const u32x4 q0 = *(const u32x4*)(prow + C_Q + h * 128 + seg * 16), q1 = *(const u32x4*)(prow + C_Q + h * 128 + seg * 16 + 8);
    const u32x4 k0 = *(const u32x4*)(prow + C_K + h * 128 + seg * 16), k1 = *(const u32x4*)(prow + C_K + h * 128 + seg * 16 + 8);
    const unsigned qw[8] = {q0.x, q0.y, q0.z, q0.w, q1.x, q1.y, q1.z, q1.w}, kw[8] = {k0.x, k0.y, k0.z, k0.w, k1.x, k1.y, k1.z, k1.w};
    { const int kk = tid & 127, qd = tid >> 7;
#pragma unroll
      for (int dir = 0; dir < 2; ++dir) { LAS float* la = (LAS float*)(lds + dir * PG_DIR + PG_LA); float run = 0.f;
#pragma unroll
          for (int r = 0; r < 16; ++r) { run += la[(qd * 16 + r) * 128 + kk]; la[(qd * 16 + r) * 128 + kk] = run; }
          ((LAS float*)(lds + dir * PG_DIR + PG_PART))[qd * 128 + kk] = run; } }
    __syncthreads();
    { const int kk = tid & 127, qd = tid >> 7;
      if (qd > 0) {
#pragma unroll
          for (int dir = 0; dir < 2; ++dir) { LAS float* la = (LAS float*)(lds + dir * PG_DIR + PG_LA); const LAS float* part = (const LAS float*)(lds + dir * PG_DIR + PG_PART); float offv = 0.f;
              for (int q = 0; q < qd; ++q) offv += part[q * 128 + kk];
#pragma unroll
              for (int r = 0; r < 16; ++r) la[(qd * 16 + r) * 128 + kk] += offv; } } }
    __syncthreads();
#pragma nounroll
    for (int dir = 0; dir < 2; ++dir) { const LAS float* la = (const LAS float*)(lds + dir * PG_DIR + PG_LA);
        const int li = dir ? 63 - ti_ : ti_; unsigned qo[8], ko[8];
#pragma unroll
        for (int e = 0; e < 8; ++e) { const float g0 = la[li * 128 + seg * 16 + 2 * e], g1 = la[li * 128 + seg * 16 + 2 * e + 1]; const float e0 = __expf(g0), e1 = __expf(g1);
            qo[e] = pk2(bflo(qw[e]) * e0 * 0.08838834764831845f, bfhi(qw[e]) * e1 * 0.08838834764831845f); ko[e] = pk2(bflo(kw[e]) * __expf(-g0), bfhi(kw[e]) * __expf(-g1)); }
        bf16_t* qd_ = (dir ? P0 + (row0 + ti_) * NP0 + C_Q : qkf_row(gmem(P.ws_()), row0 + ti_)) + h * 128 + seg * 16;
        bf16_t* kd_ = qd_ + 512;
        *(u32x4*)qd_ = (u32x4){qo[0], qo[1], qo[2], qo[3]}; *(u32x4*)(qd_ + 8) = (u32x4){qo[4], qo[5], qo[6], qo[7]};
        *(u32x4*)kd_ = (u32x4){ko[0], ko[1], ko[2], ko[3]}; *(u32x4*)(kd_ + 8) = (u32x4){ko[4], ko[5], ko[6], ko[7]}; }
    if (tid < 256) { const int dir = tid >> 7, kk = tid & 127; GF[((size_t)((b * 4 + h) * 2 + dir) * NCT + gch) * 128 + kk] = __expf(((const LAS float*)(lds + dir * PG_DIR + PG_LA))[63 * 128 + kk]); }
    __syncthreads();
}
__device__ __forceinline__ void phase_prep0b(const Ctx& c, const Params& P) {
    constexpr int NXT = (MC / 256) * 8;
    if (c.G >= 2 * NXT && c.bid < NXT) { unsigned char* wsf = P.ws_();
        pg8::Gemm g{(const bf16_t*)(wsf + WS_H) + (size_t)ML * D, (const bf16_t*)(wsf + WS_WA), MC, 2048, D, D}; pg8::StaticOrder S; S.init(MC, 2048, D, NXT, c.bid);
        EpiStoreBf16 E{(bf16_t*)(wsf + WS_BIG) + (size_t)ML * NP0 + C_G, NP0};
        pg8::gemm_phase(c.lds, g, S, E, c.tid);
        __syncthreads(); }
    const int nssd = NB * NCT, nu = nssd * 5;
    unsigned* ctr = (unsigned*)(gmem(P.ws_()) + WS_CTL + 16384);
    volatile LAS unsigned* slot = (volatile LAS unsigned*)(c.lds + PARAM_LDS_OFF + 384);
    for (;;) {
        if (c.tid == 0) *slot = atomicAdd(ctr, 1u);
        __syncthreads();
        const int q = (int)__builtin_amdgcn_readfirstlane(*slot);
        __syncthreads();
        if (q >= nu) break;
        if (q < nssd) prep_ssd_unit(c, P, q / NCT, q % NCT);
        else { const int g = q - nssd, bc = g >> 2; prep_gla_unit(c, P, bc / NCT, bc % NCT, g & 3); }
    }
}

constexpr int O_Q = 0;
constexpr int O_K = O_Q + 64 * LQ * 2;
constexpr int O_V = O_K + 64 * LQ * 2;
constexpr int O_VW = O_V + 64 * LT * 2;
constexpr int O_S = O_VW + 64 * LT * 2;
constexpr int O_ST = O_S + 64 * LT * 2;
constexpr int O_OST = O_ST + 64 * LQ * 2;
constexpr int O_VEC = O_OST + 64 * 68 * 4;
constexpr int O_END = O_VEC + 320 * 4;
static_assert(O_END <= PARAM_LDS_OFF, "scan0 LDS");

template <bool SSD>
__device__ __forceinline__ void chain(const Ctx& c, const Params& P, int dir, int b, int h, int vb, const bool conc, unsigned* myflag, unsigned* peerflag) {
    constexpr int XS = NCC + (NCT - NCC) / 2;
    const int tid = c.tid, lane = c.lane, w = c.wave, fr = lane & 15, fq = lane >> 4, ti_ = tid >> 3, seg = tid & 7;
    unsigned char* wsb = gmem(P.ws_());
    const bf16_t* P0 = (const bf16_t*)(wsb + WS_BIG); const float* GF = glaf_ptr(wsb);
    bf16_t* T_lat = (bf16_t*)gmem(P.out_()); bf16_t* T_ctx = tctx_ptr(wsb) + (dir ? (size_t)MC * 2048 : 0);
    const int vcol = SSD ? C_XS + h * 64 : C_V + h * 256 + vb * 64, tcol = SSD ? 1024 + h * 64 : h * 256 + vb * 64, dh = dir * 16 + h;
    f32x4 st[4];
#pragma unroll
    for (int t = 0; t < 4; ++t) st[t] = (f32x4){0.f, 0.f, 0.f, 0.f};
    for (int i = tid; i < 64 * LQ / 2; i += NTHREADS) ((LAS unsigned*)(c.lds + O_ST))[i] = 0u;
    __syncthreads();
    u32x4 pa0, pa1, pb0, pb1, pvv, ptt = (u32x4){0u, 0u, 0u, 0u}; f32x2 pdg = (f32x2){0.f, 0.f}; float pgl = 0.f, pgf = 0.f;
#define SC0_RMW(ci_) ((ci_) >= NCC && (conc ? (ci_) >= XS : dir != 0))
#define SC0_GCH(ci_) (dir ? ((ci_) < NCC ? NCC - 1 - (ci_) : NCT - 1 - ((ci_) - NCC)) : (ci_))
#define SC0_PREFETCH(ci_) do { const int g_ = SC0_GCH(ci_); const size_t r0_ = chunk_row0(b, g_), row_ = r0_ + (dir ? 63 - ti_ : ti_); \
        const bf16_t* qs_ = SSD ? P0 + row_ * NP0 + C_C + (h >> 3) * 128 : (dir ? P0 + row_ * NP0 + C_Q : (const bf16_t*)qkf_row(wsb, row_)) + h * 128; \
        const bf16_t* ks_ = SSD ? P0 + row_ * NP0 + C_B + (h >> 3) * 128 : qs_ + 512; \
        pa0 = *(const u32x4*)(qs_ + seg * 16); pa1 = *(const u32x4*)(qs_ + seg * 16 + 8); pb0 = *(const u32x4*)(ks_ + seg * 16); pb1 = *(const u32x4*)(ks_ + seg * 16 + 8); \
        pvv = *(const u32x4*)(P0 + row_ * NP0 + vcol + seg * 8); \
        if (SSD) { pdg = *(const f32x2*)(ssdv_row(wsb, row_) + dh * 2); pgl = ssdv_row(wsb, r0_ + (dir ? 0 : 63))[dh * 2 + 1]; } \
        else if (tid < 128) pgf = GF[((size_t)((b * 4 + h) * 2 + dir) * NCT + g_) * 128 + tid]; \
        if (SC0_RMW(ci_) && !(conc && (ci_) == XS)) ptt = *(const u32x4*)(T_lat + row_ * 2048 + tcol + seg * 8); } while (0)
    SC0_PREFETCH(0);
    for (int ci = 0; ci < NCT; ++ci) {
        LAS unsigned char* lds = c.lds; LAS float* vec = (LAS float*)(lds + O_VEC);
        const int gch = SC0_GCH(ci);
        const int isctx = gch < NCC;
        const size_t row0 = chunk_row0(b, gch), row = row0 + (dir ? 63 - ti_ : ti_);
#ifndef EMU
        if (conc && ci == XS) {
            if (tid == 0) { unsigned sp_ = 0; while (__hip_atomic_load(peerflag, __ATOMIC_RELAXED, __HIP_MEMORY_SCOPE_AGENT) == 0u) { __builtin_amdgcn_s_sleep(1); if (++sp_ > (1u << 22)) break; }
                __builtin_amdgcn_fence(__ATOMIC_ACQUIRE, "agent"); }
            __syncthreads();
            ptt = *(const u32x4*)(T_lat + row * 2048 + tcol + seg * 8);
        }
#endif
        const u32x4 cur_t = ptt;
        { *(LAS u32x4*)(lds + O_Q + (ti_ * LQ + seg * 16) * 2) = pa0; *(LAS u32x4*)(lds + O_Q + (ti_ * LQ + seg * 16 + 8) * 2) = pa1;
          *(LAS u32x4*)(lds + O_K + (ti_ * LQ + seg * 16) * 2) = pb0; *(LAS u32x4*)(lds + O_K + (ti_ * LQ + seg * 16 + 8) * 2) = pb1;
          *(LAS u32x4*)(lds + O_V + (ti_ * LT + seg * 8) * 2) = pvv;
          if (SSD) { const float kf = pdg[0] * __expf(pgl - pdg[1]); const u32x4 vv = pvv;
              u32x4 xw; xw.x = pk2(bflo(vv.x) * kf, bfhi(vv.x) * kf); xw.y = pk2(bflo(vv.y) * kf, bfhi(vv.y) * kf); xw.z = pk2(bflo(vv.z) * kf, bfhi(vv.z) * kf); xw.w = pk2(bflo(vv.w) * kf, bfhi(vv.w) * kf);
              *(LAS u32x4*)(lds + O_VW + (ti_ * LT + seg * 8) * 2) = xw;
              if (seg == 0) { vec[128 + ti_] = pdg[1]; vec[192 + ti_] = pdg[0]; vec[256 + ti_] = __expf(pdg[1]); } }
          else if (tid < 128) vec[tid] = pgf; }
        if (ci + 1 < NCT) SC0_PREFETCH(ci + 1);
        LDS_BARRIER();
        typedef short v4i16_t __attribute__((ext_vector_type(4)));
#define SC0_TR(p_, off_, ld_) ({ const v4i16_t t0_ = __builtin_amdgcn_ds_read_tr16_b64_v4i16((LAS v4i16_t*)((p_) + (off_))), t1_ = __builtin_amdgcn_ds_read_tr16_b64_v4i16((LAS v4i16_t*)((p_) + (off_) + 4 * (ld_) * 2)); \
        (bf16x8){t0_[0], t0_[1], t0_[2], t0_[3], t1_[0], t1_[1], t1_[2], t1_[3]}; })
        const int ti = w >> 1, hb = w & 1;
        bf16x8 qa[4];
        { bf16x8 kf[2][4];
          const LAS unsigned char* pq = lds + O_Q + ((ti * 16 + fr) * LQ + 8 * fq) * 2; const LAS unsigned char* pk = lds + O_K + ((hb * 32 + fr) * LQ + 8 * fq) * 2;
#pragma unroll
          for (int kq = 0; kq < 4; ++kq) qa[kq] = *(const LAS bf16x8*)(pq + kq * 64);
#pragma unroll
          for (int q = 0; q < 2; ++q)
#pragma unroll
              for (int kq = 0; kq < 4; ++kq) kf[q][kq] = *(const LAS bf16x8*)(pk + q * 16 * LQ * 2 + kq * 64);
          SCHED_FENCE();
#pragma unroll
          for (int q = 0; q < 2; ++q) { const int tj = 2 * hb + q; f32x4 acc = (f32x4){0.f, 0.f, 0.f, 0.f};
              if (tj <= ti) {
#pragma unroll
                  for (int kq = 0; kq < 4; ++kq) acc = __builtin_amdgcn_mfma_f32_16x16x32_bf16(kf[q][kq], qa[kq], acc, 0, 0, 0); }
              const int i = ti * 16 + fr; float s4[4];
#pragma unroll
              for (int r = 0; r < 4; ++r) { const int j = tj * 16 + 4 * fq + r; float s = (j <= i) ? acc[r] : 0.f;
                  if (SSD) s *= vec[192 + j] * __expf(fminf(vec[128 + i] - vec[128 + j], 0.f));
                  s4[r] = s; }
              *(LAS u32x2*)(lds + O_S + (i * LT + tj * 16 + 4 * fq) * 2) = (u32x2){pk2(s4[0], s4[1]), pk2(s4[2], s4[3])}; } }
        LDS_BARRIER();
        f32x4 U[4];
        { bf16x8 sa[2], vt[2][2], stf[2][4], ka[2], vu[4][2];
          const LAS unsigned char* ps = lds + O_S + ((ti * 16 + fr) * LT + 8 * fq) * 2;
          const LAS unsigned char* pvt = lds + O_V + ((8 * fq + (fr >> 2)) * LT + hb * 32 + 4 * (fr & 3)) * 2;
          const LAS unsigned char* pst = lds + O_ST + ((hb * 32 + fr) * LQ + 8 * fq) * 2;
          const LAS unsigned char* pkt = lds + O_K + ((8 * fq + (fr >> 2)) * LQ + w * 16 + 4 * (fr & 3)) * 2;
          const LAS unsigned char* pvu = lds + (SSD ? O_VW : O_V) + ((8 * fq + (fr >> 2)) * LT + 4 * (fr & 3)) * 2;
#pragma unroll
          for (int kq = 0; kq < 2; ++kq) sa[kq] = *(const LAS bf16x8*)(ps + kq * 64);
#pragma unroll
          for (int q = 0; q < 2; ++q) {
#pragma unroll
              for (int kq = 0; kq < 2; ++kq) vt[q][kq] = SC0_TR(pvt, kq * 32 * LT * 2 + q * 32, LT);
#pragma unroll
              for (int kq = 0; kq < 4; ++kq) stf[q][kq] = *(const LAS bf16x8*)(pst + q * 16 * LQ * 2 + kq * 64); }
#pragma unroll
          for (int kq = 0; kq < 2; ++kq) ka[kq] = SC0_TR(pkt, kq * 32 * LQ * 2, LQ);
#pragma unroll
          for (int t = 0; t < 4; ++t)
#pragma unroll
              for (int kq = 0; kq < 2; ++kq) vu[t][kq] = SC0_TR(pvu, kq * 32 * LT * 2 + t * 32, LT);
          SCHED_FENCE();
          LAS float* ost = (LAS float*)(lds + O_OST);
#pragma unroll
          for (int q = 0; q < 2; ++q) { const int tv = 2 * hb + q; f32x4 a1 = (f32x4){0.f, 0.f, 0.f, 0.f}, a2 = (f32x4){0.f, 0.f, 0.f, 0.f};
#pragma unroll
              for (int kq = 0; kq < 2; ++kq) a1 = __builtin_amdgcn_mfma_f32_16x16x32_bf16(sa[kq], vt[q][kq], a1, 0, 0, 0);
#pragma unroll
              for (int kq = 0; kq < 4; ++kq) a2 = __builtin_amdgcn_mfma_f32_16x16x32_bf16(qa[kq], stf[q][kq], a2, 0, 0, 0);
#pragma unroll
              for (int r = 0; r < 4; ++r) { const int i = ti * 16 + 4 * fq + r; ost[i * 68 + tv * 16 + fr] = a1[r] + (SSD ? vec[256 + i] : 1.f) * a2[r]; } }
#pragma unroll
          for (int t = 0; t < 4; ++t) { f32x4 u = (f32x4){0.f, 0.f, 0.f, 0.f};
#pragma unroll
              for (int kq = 0; kq < 2; ++kq) u = __builtin_amdgcn_mfma_f32_16x16x32_bf16(ka[kq], vu[t][kq], u, 0, 0, 0);
              U[t] = u; } }
#undef SC0_TR
        float fk[4];
#pragma unroll
        for (int r = 0; r < 4; ++r) fk[r] = SSD ? vec[256 + 63] : vec[w * 16 + 4 * fq + r];
        LDS_BARRIER();
#pragma unroll
        for (int t = 0; t < 4; ++t) {
#pragma unroll
            for (int r = 0; r < 4; ++r) st[t][r] = SSD ? fk[r] * st[t][r] + U[t][r] : fk[r] * (st[t][r] + U[t][r]);
            *(LAS u32x2*)(lds + O_ST + ((t * 16 + fr) * LQ + w * 16 + 4 * fq) * 2) = (u32x2){pk2(st[t][0], st[t][1]), pk2(st[t][2], st[t][3])}; }
        { bf16_t* T = isctx ? T_ctx + (row - ML) * 2048 : T_lat + row * 2048; bf16_t* tp = T + tcol + seg * 8;
          const LAS float* ost = (const LAS float*)(lds + O_OST) + ti_ * 68 + seg * 8; float o[8];
#pragma unroll
          for (int e = 0; e < 8; ++e) o[e] = ost[e];
          if (SC0_RMW(ci)) { const u32x4 pv = cur_t; o[0] += bflo(pv.x); o[1] += bfhi(pv.x); o[2] += bflo(pv.y); o[3] += bfhi(pv.y); o[4] += bflo(pv.z); o[5] += bfhi(pv.z); o[6] += bflo(pv.w); o[7] += bfhi(pv.w); }
          *(u32x4*)tp = (u32x4){pk2(o[0], o[1]), pk2(o[2], o[3]), pk2(o[4], o[5]), pk2(o[6], o[7])}; }
#ifndef EMU
        if (conc && ci == XS - 1) {
            ASM_VMCNT(0); __syncthreads();
            if (tid == 0) { __builtin_amdgcn_fence(__ATOMIC_RELEASE, "agent"); asm volatile("s_waitcnt vmcnt(0)" ::: "memory"); __hip_atomic_store(myflag, 1u, __ATOMIC_RELAXED, __HIP_MEMORY_SCOPE_AGENT); }
        }
#endif
    }
    __syncthreads();
#undef SC0_RMW
#undef SC0_GCH
#undef SC0_PREFETCH
}
}

__device__ __forceinline__ void phase_scan0(const Ctx& c, const Params& P) {
    const int nper = NB * 32, nitems = 2 * nper;
    unsigned* flags = (unsigned*)(gmem(P.ws_()) + WS_CTL + 20480);
#ifndef EMU
    const bool conc = c.G >= nitems;
#else
    const bool conc = false;
#endif
    const int nq = conc ? nitems : nper, npass = conc ? 1 : 2;
    for (int q = c.bid; q < nq; q += c.G) {
#pragma nounroll
        for (int pass = 0; pass < npass; ++pass) {
            const int it = conc ? ((q / 8) / (nitems / 16)) * nper + (q % 8) * (nitems / 16) + (q / 8) % (nitems / 16) : pass * nper + q;
            const int dir = it / nper, b = (it / 32) % NB, r = it % 32;
            unsigned* mf = flags + it * 16; unsigned* pf = flags + ((it + nper) % nitems) * 16;
            if (r < 16) sc0::chain<false>(c, P, dir, b, r >> 2, r & 3, conc, mf, pf);
            else sc0::chain<true>(c, P, dir, b, r - 16, 0, conc, mf, pf);
            ASM_VMCNT(0); __syncthreads();
#ifndef EMU
            if (!conc) __builtin_amdgcn_fence(__ATOMIC_ACQUIRE, "agent");
#endif
        }
    }
}

__device__ __forceinline__ void phase_post0(const Ctx& c, const Params& P) {
    bf16_t* P0 = (bf16_t*)(gmem(P.ws_()) + WS_BIG);
    const bf16_t* T_lat = (const bf16_t*)gmem(P.out_()); const bf16_t* T_ctx = sc0::tctx_ptr(gmem(P.ws_()));
    const int gw = c.bid * NWAVES + c.wave, NGW = c.G * NWAVES, lane = c.lane;
    const float* gn = gmem(P.in_(I_AGN)); const float* sn = gmem(P.in_(I_ASN));
    const float dsk = gmem(P.in_(I_AD))[lane >> 2];
    f32x4 gnv[4], snv[4];
#pragma unroll
    for (int q = 0; q < 4; ++q) { gnv[q] = *(const f32x4*)(gn + ((16 * lane) & 255) + 4 * q); snv[q] = *(const f32x4*)(sn + 16 * lane + 4 * q); }
    for (int row = gw; row < MT; row += NGW) {
        const bool isctx = row >= ML;
        const bf16_t* T = isctx ? T_ctx + (size_t)(row - ML) * 2048 : T_lat + (size_t)row * 2048;
        bf16_t* pr = P0 + (size_t)row * NP0;
        {   const u32x4 t0 = *(const u32x4*)(T + 16 * lane), t1 = *(const u32x4*)(T + 16 * lane + 8);
            u32x4 r0 = (u32x4){0u, 0u, 0u, 0u}, r1 = r0;
            if (isctx) { r0 = *(const u32x4*)(T + (size_t)MC * 2048 + 16 * lane); r1 = *(const u32x4*)(T + (size_t)MC * 2048 + 16 * lane + 8); }
            const u32x4 g0 = *(const u32x4*)(pr + C_G + 16 * lane), g1 = *(const u32x4*)(pr + C_G + 16 * lane + 8);
            const unsigned tw[8] = {t0.x, t0.y, t0.z, t0.w, t1.x, t1.y, t1.z, t1.w}, rw[8] = {r0.x, r0.y, r0.z, r0.w, r1.x, r1.y, r1.z, r1.w}, gq[8] = {g0.x, g0.y, g0.z, g0.w, g1.x, g1.y, g1.z, g1.w};
            float tv[16], ss = 0.f;
#pragma unroll
            for (int e = 0; e < 8; ++e) { tv[2 * e] = bflo(tw[e]) + bflo(rw[e]); tv[2 * e + 1] = bfhi(tw[e]) + bfhi(rw[e]); ss += tv[2 * e] * tv[2 * e] + tv[2 * e + 1] * tv[2 * e + 1]; }
            ss += __shfl_xor(ss, 1); ss += __shfl_xor(ss, 2); ss += __shfl_xor(ss, 4); ss += __shfl_xor(ss, 8);
            const float rs = 1.0f / sqrtf(ss * (1.0f / 256.0f) + EPS);
            unsigned o[8];
#pragma unroll
            for (int e = 0; e < 8; ++e) o[e] = pk2(tv[2 * e] * rs * gnv[e >> 1][2 * (e & 1)] * siluf_(bflo(gq[e])), tv[2 * e + 1] * rs * gnv[e >> 1][2 * (e & 1) + 1] * siluf_(bfhi(gq[e])));
            *(u32x4*)(pr + C_G + 16 * lane) = (u32x4){o[0], o[1], o[2], o[3]}; *(u32x4*)(pr + C_G + 16 * lane + 8) = (u32x4){o[4], o[5], o[6], o[7]}; }
        {   const u32x4 t0 = *(const u32x4*)(T + 1024 + 16 * lane), t1 = *(const u32x4*)(T + 1024 + 16 * lane + 8);
            u32x4 r0 = (u32x4){0u, 0u, 0u, 0u}, r1 = r0;
            if (isctx) { r0 = *(const u32x4*)(T + (size_t)MC * 2048 + 1024 + 16 * lane); r1 = *(const u32x4*)(T + (size_t)MC * 2048 + 1024 + 16 * lane + 8); }
            const u32x4 z0 = *(const u32x4*)(pr + C_Z + 16 * lane), z1 = *(const u32x4*)(pr + C_Z + 16 * lane + 8);
            const u32x4 b0 = *(const u32x4*)(pr + C_XS + 16 * lane), b1 = *(const u32x4*)(pr + C_XS + 16 * lane + 8);
            const unsigned tw[8] = {t0.x, t0.y, t0.z, t0.w, t1.x, t1.y, t1.z, t1.w}, rw[8] = {r0.x, r0.y, r0.z, r0.w, r1.x, r1.y, r1.z, r1.w}, zq[8] = {z0.x, z0.y, z0.z, z0.w, z1.x, z1.y, z1.z, z1.w};
            const unsigned a_[8] = {b0.x, b0.y, b0.z, b0.w, b1.x, b1.y, b1.z, b1.w};
            float y[16], ss = 0.f;
#pragma unroll
            for (int e = 0; e < 16; ++e) { const int wi = e >> 1; const bool hi = e & 1;
                const float xs = hi ? bfhi(a_[wi]) : bflo(a_[wi]);
                const float tvv = hi ? bfhi(tw[wi]) + bfhi(rw[wi]) : bflo(tw[wi]) + bflo(rw[wi]), zv = hi ? bfhi(zq[wi]) : bflo(zq[wi]);
                y[e] = (tvv + xs * dsk) * siluf_(zv); ss += y[e] * y[e]; }
            ss += __shfl_xor(ss, 1); ss += __shfl_xor(ss, 2); ss += __shfl_xor(ss, 4); ss += __shfl_xor(ss, 8); ss += __shfl_xor(ss, 16);
            const float rs = 1.0f / sqrtf(ss * (1.0f / 512.0f) + EPS);
            unsigned o[8];
#pragma unroll
            for (int e = 0; e < 8; ++e) o[e] = pk2(y[2 * e] * rs * snv[e >> 1][2 * (e & 1)], y[2 * e + 1] * rs * snv[e >> 1][2 * (e & 1) + 1]);
            *(u32x4*)(pr + C_Z + 16 * lane) = (u32x4){o[0], o[1], o[2], o[3]}; *(u32x4*)(pr + C_Z + 16 * lane + 8) = (u32x4){o[4], o[5], o[6], o[7]}; }
    }
}

__device__ __forceinline__ int row_of(int isctx, int b, int p) { return isctx ? ML + b * CTX + p : b * SEQ + (p % GROWS) * GW + p / GROWS; }

__device__ __forceinline__ void build_gate_weights(const Ctx& c, const Params& P, bf16_t* WG) {
    const float* wq = gmem(P.in_(I_BWQ)); const float* wk = gmem(P.in_(I_BWK)); const float* wv = gmem(P.in_(I_BWV)); const float* wif = gmem(P.in_(I_BWIF));
    for (int idx = c.bid * NTHREADS + c.tid; idx < 256 * 4096; idx += c.G * NTHREADS) {
        const int g = idx >> 12, cc = idx & 4095; float v = 0.f;
        if (g < 16) { const int dir = g >> 3, gi = g & 7; const float* wd = wif + (size_t)dir * 6144 * 8;
            if (cc < 2048) { const int n = cc >> 2, dp = cc & 3;
#pragma unroll
                for (int e = 0; e < 4; ++e) v += wv[n * 16 + dp * 4 + e] * wd[(size_t)(4096 + 4 * n + e) * 8 + gi]; }
            else { const int c2 = cc - 2048, n = c2 >> 2, dp = c2 & 3;
#pragma unroll
                for (int e = 0; e < 4; ++e) v += wq[n * 16 + dp * 4 + e] * wd[(size_t)(4 * n + e) * 8 + gi] + wk[n * 16 + dp * 4 + e] * wd[(size_t)(2048 + 4 * n + e) * 8 + gi]; } }
        WG[idx] = (bf16_t)f2bf(v);
    }
}
__device__ __forceinline__ void build_mblocks(const Ctx& c, const Params& P, float* MB) {
    const float* wq = gmem(P.in_(I_BWQ)); const float* wk = gmem(P.in_(I_BWK));
    for (int idx = c.bid * NTHREADS + c.tid; idx < 512 * 16; idx += c.G * NTHREADS) { const int n = idx >> 4, dp = (idx >> 2) & 3, e = idx & 3; float v = 0.f;
#pragma unroll
        for (int x = 0; x < 4; ++x) v += wq[n * 16 + dp * 4 + x] * wk[n * 16 + e * 4 + x];
        MB[idx] = v * 0.04419417382415922f; }
}
constexpr int GATE_NSL = 3;
__device__ __forceinline__ float* gates_ptr(unsigned char* ws) { return (float*)(ws + WS_H + 26 * MiB); }
static_assert(26 * MiB + (size_t)GATE_NSL * MT * 64 <= 34 * MiB, "gate partial slabs");
struct EpiGates {
    static constexpr bool PERM = false;
    float* G;
    __device__ __forceinline__ void operator()(const f32x4 (&acc)[2][2][4][2], const pg8::Unit& u, int wr, int wc, int fr, int fq) const {
        if (wc != 0 || u.pn != 0) return;
        float* Gs = G + (size_t)(u.sl < 0 ? 0 : u.sl) * MT * 16;
#pragma unroll
        for (int ai = 0; ai < 2; ++ai)
#pragma unroll
            for (int m = 0; m < 4; ++m) { const int row = u.pm * 256 + ai * 128 + wr * 64 + m * 16 + fr; *(f32x4*)(Gs + (size_t)row * 16 + 4 * fq) = acc[ai][0][m][0]; }
    }
};
__device__ __forceinline__ void phase_prep1(const Ctx& c, const Params& P, const int S_END) {
    bf16_t* XMC = (bf16_t*)(gmem(P.ws_()) + WS_BIG);
    const float* cw = gmem(P.in_(I_BCW)); const float* cb = gmem(P.in_(I_BCB));
    const int gw = c.bid * NWAVES + c.wave, NGW = c.G * NWAVES, lane = c.lane;
    f32x4 w0[8], w1[8], w2[8], wb[8];
#pragma unroll
    for (int q = 0; q < 8; ++q) { w0[q] = *(const f32x4*)(cw + 32 * lane + 4 * q); w1[q] = *(const f32x4*)(cw + 2048 + 32 * lane + 4 * q); w2[q] = *(const f32x4*)(cw + 4096 + 32 * lane + 4 * q); wb[q] = *(const f32x4*)(cb + 32 * lane + 4 * q); }
    constexpr int RPW_DEN = 1;
    const int rpw = (S_END + NGW - 1) / NGW, s0 = gw * rpw, s1 = (s0 + rpw < S_END) ? s0 + rpw : S_END; (void)RPW_DEN;
    auto rowof = [](int s_, int& row_, bool& first_, bool& last_) { if (s_ < ML) { const int b = s_ / SEQ, p = s_ % SEQ; row_ = b * SEQ + (p % GROWS) * GW + p / GROWS; first_ = p == 0; last_ = p == SEQ - 1; }
                                                                  else { const int p = (s_ - ML) % CTX; row_ = s_; first_ = p == 0; last_ = p == CTX - 1; } };
    u32x4 pv[4], cv[4], nv[4];
    if (s0 < s1) { int r0, rm; bool f0, l0, fm, lm; rowof(s0, r0, f0, l0);
#pragma unroll
        for (int q = 0; q < 4; ++q) cv[q] = *(const u32x4*)(XMC + (size_t)r0 * 4096 + 32 * lane + 8 * q);
        if (!f0) { rowof(s0 - 1, rm, fm, lm);
#pragma unroll
            for (int q = 0; q < 4; ++q) pv[q] = *(const u32x4*)(XMC + (size_t)rm * 4096 + 32 * lane + 8 * q); }
        else {
#pragma unroll
            for (int q = 0; q < 4; ++q) pv[q] = (u32x4){0u, 0u, 0u, 0u}; } }
    for (int sidx = s0; sidx < s1; ++sidx) {
        int row, rn; bool first, last, fn_, ln_; rowof(sidx, row, first, last);
        if (!last) { rowof(sidx + 1, rn, fn_, ln_);
#pragma unroll
            for (int q = 0; q < 4; ++q) nv[q] = *(const u32x4*)(XMC + (size_t)rn * 4096 + 32 * lane + 8 * q); }
        else {
#pragma unroll
            for (int q = 0; q < 4; ++q) nv[q] = (u32x4){0u, 0u, 0u, 0u}; }
#pragma unroll
        for (int q = 0; q < 4; ++q) { const int ch = 32 * lane + 8 * q;
            const unsigned aw[4] = {pv[q].x, pv[q].y, pv[q].z, pv[q].w}, bw[4] = {cv[q].x, cv[q].y, cv[q].z, cv[q].w}, dw[4] = {nv[q].x, nv[q].y, nv[q].z, nv[q].w}; unsigned o[4];
#pragma unroll
            for (int e = 0; e < 4; ++e) { const int qq = 2 * q + (e >> 1), j = 2 * (e & 1);
                const float y0 = siluf_(w0[qq][j] * bflo(aw[e]) + w1[qq][j] * bflo(bw[e]) + w2[qq][j] * bflo(dw[e]) + wb[qq][j]);
                const float y1 = siluf_(w0[qq][j + 1] * bfhi(aw[e]) + w1[qq][j + 1] * bfhi(bw[e]) + w2[qq][j + 1] * bfhi(dw[e]) + wb[qq][j + 1]);
                o[e] = pk2(y0, y1); }
            *(u32x4*)(XMC + (size_t)row * 4096 + 2048 + ch) = (u32x4){o[0], o[1], o[2], o[3]}; }
#pragma unroll
        for (int q = 0; q < 4; ++q) { pv[q] = last ? (u32x4){0u, 0u, 0u, 0u} : cv[q]; cv[q] = nv[q]; }
        if (last && sidx + 1 < s1) { int r1; bool f1, l1; rowof(sidx + 1, r1, f1, l1);
#pragma unroll
            for (int q = 0; q < 4; ++q) cv[q] = *(const u32x4*)(XMC + (size_t)r1 * 4096 + 32 * lane + 8 * q); }
    }
}

static_assert(256 % CTX == 0 || CTX % 256 == 0, "context sequences vs row tiles");
__device__ __forceinline__ void prep1_ctx_tile(const Ctx& c, const Params& P, int pm, int pn) {
    bf16_t* XMC = (bf16_t*)(gmem(P.ws_()) + WS_BIG) + (size_t)ML * 4096;
    const float* cw = gmem(P.in_(I_BCW)); const float* cb = gmem(P.in_(I_BCB));
    const int col = 256 * pn + 4 * c.lane;
    const f32x4 t0 = *(const f32x4*)(cw + col), t1 = *(const f32x4*)(cw + 2048 + col), t2 = *(const f32x4*)(cw + 4096 + col), tb = *(const f32x4*)(cb + col);
#pragma nounroll
    for (int g = 0; g < 4; ++g) {
        const int cr0 = 256 * pm + 32 * c.wave + 8 * g;
        u32x2 v[10];
#pragma unroll
        for (int j = 0; j < 10; ++j) { const int cr = cr0 + j - 1; v[j] = (cr >= 0 && cr < MC) ? *(const u32x2*)(XMC + (size_t)cr * 4096 + col) : (u32x2){0u, 0u}; }
#pragma unroll
        for (int i = 0; i < 8; ++i) { const int cr = cr0 + i, p = cr % CTX;
            const u32x2 a = p == 0 ? (u32x2){0u, 0u} : v[i], m = v[i + 1], n = p == CTX - 1 ? (u32x2){0u, 0u} : v[i + 2];
            const float y0 = siluf_(t0[0] * bflo(a.x) + t1[0] * bflo(m.x) + t2[0] * bflo(n.x) + tb[0]), y1 = siluf_(t0[1] * bfhi(a.x) + t1[1] * bfhi(m.x) + t2[1] * bfhi(n.x) + tb[1]);
            const float y2 = siluf_(t0[2] * bflo(a.y) + t1[2] * bflo(m.y) + t2[2] * bflo(n.y) + tb[2]), y3 = siluf_(t0[3] * bfhi(a.y) + t1[3] * bfhi(m.y) + t2[3] * bfhi(n.y) + tb[3]);
            *(u32x2*)(XMC + (size_t)cr * 4096 + 2048 + col) = (u32x2){pk2(y0, y1), pk2(y2, y3)}; }
    }
}

namespace sc1 {
constexpr int EB = 32, LX = 520, LXC = 528, LV = 48, LS = 72, NCL = SEQ / 64, NCC = CTX / 64, NCT = NCC + NCL, ET = 48;
constexpr int O_XC = 0;
constexpr int O_CT = O_XC + 64 * LXC * 2;
constexpr int O_OST = O_CT + 33 * LX * 2;
constexpr int O_V = O_OST + 2 * 64 * 34 * 4;
constexpr int O_VW = O_V + 64 * LV * 2;
constexpr int O_S = O_VW + 64 * LV * 2;
constexpr int O_M = O_S + 64 * LS * 2;
constexpr int O_VEC = O_M + 128 * 16 * 2;
constexpr int O_DUMP = O_VEC + 256 * 4;
constexpr int O_END = O_DUMP + 512;
constexpr int IPD = 2;
constexpr int SC_M = O_CT + 64 * LX * 2;
static_assert(O_END <= PARAM_LDS_OFF && SC_M + 128 * 16 * 4 <= PARAM_LDS_OFF && O_CT + ET * LX * 2 <= O_V && O_V % 16 == 0, "scan1 LDS");
__device__ __forceinline__ bf16_t* sraw_ptr(unsigned char* ws) { return (bf16_t*)(ws + WS_H); }
__device__ __forceinline__ bf16_t* sdec_ptr(unsigned char* ws) { return (bf16_t*)(ws + WS_H) + (size_t)NB * 4 * NCL * 4096; }
__device__ __forceinline__ float* gv_ptr(unsigned char* ws) { return (float*)(ws + WS_WA + 8 * MiB); }
static_assert((size_t)NB * 4 * NCL * 4096 * 2 * 3 <= 26 * MiB && (size_t)NB * 4 * NCL * 4096 * 2 * 3 <= (size_t)MT * D * 2 && (size_t)NB * 8 * NCT * 384 * 4 <= 4 * MiB, "layer-1 scan scratch");
__device__ __forceinline__ bf16x8 frag(const LAS unsigned char* lds, int off, int ld, int row, int k) { return *(const LAS bf16x8*)(lds + off + (row * ld + k) * 2); }
__device__ __forceinline__ bf16x8 tr_frag(const LAS unsigned char* lds, int off, int ld, int k0, int n0, int fr, int fq) {
    typedef short v4i16_t __attribute__((ext_vector_type(4)));
    const LAS unsigned char* p0 = lds + off + ((k0 + 8 * fq + (fr >> 2)) * ld + n0 + 4 * (fr & 3)) * 2;
    const v4i16_t a = __builtin_amdgcn_ds_read_tr16_b64_v4i16((LAS v4i16_t*)p0), b = __builtin_amdgcn_ds_read_tr16_b64_v4i16((LAS v4i16_t*)(p0 + 4 * ld * 2));
    return (bf16x8){a[0], a[1], a[2], a[3], b[0], b[1], b[2], b[3]};
}
static_assert(64 % GROWS == 0, "a 64-token chunk covers whole grid columns");
__device__ __forceinline__ int chunk_rb(int isctx, int b, int ch) { return isctx ? ML + b * CTX + ch * 64 : b * SEQ + ch * (64 / GROWS); }
__device__ __forceinline__ int lat_off(int ip) { return (ip % GROWS) * GW + ip / GROWS; }
template <int R0 = 0, int R1 = 8, int LDX = LX>
__device__ __forceinline__ void stage_xc(const Ctx& c, LAS unsigned char* lds, const bf16_t* XMC, int isctx, int b, int ch, int h, int dir) {
    const bf16_t* base = XMC + (size_t)chunk_rb(isctx, b, ch) * 4096 + 2048 + h * 512 + c.lane * 8;
#pragma unroll
    for (int r = R0; r < R1; ++r) { const int i = 8 * c.wave + r, ip = dir ? 63 - i : i; const int off = (isctx ? ip : lat_off(ip)) * 4096;
        __builtin_amdgcn_global_load_lds((const unsigned*)(base + off), (LAS unsigned*)(lds + O_XC + i * LDX * 2), 16, 0, 0); }
}
__device__ __forceinline__ void score_unit(const Ctx& c, const Params& P, int b, int h, int ch, bf16_t* SB) {
    LAS unsigned char* lds = c.lds; const int tid = c.tid, lane = c.lane, w = c.wave, fr = lane & 15, fq = lane >> 4, ti_ = tid >> 3, seg = tid & 7;
    const bf16_t* XMC = (const bf16_t*)(gmem(P.ws_()) + WS_BIG);
    const float* MB = (const float*)(gmem(P.ws_()) + WS_GATES + 3 * MiB / 2) + (size_t)h * 128 * 16;
    stage_xc(c, lds, XMC, 0, b, ch, h, 0);
    LAS float* ml = (LAS float*)(lds + SC_M);
    for (int i = tid; i < 128 * 16; i += NTHREADS) ml[i] = MB[i];
    ASM_VMCNT(0); __syncthreads();
    { const int tt = w >> 1; const f32x4 zero4 = {0.f, 0.f, 0.f, 0.f};
#pragma unroll 2
      for (int wi = 0; wi < 8; ++wi) { const int win = 8 * (w & 1) + wi; const bf16x8 xb = frag(lds, O_XC, LX, tt * 16 + fr, win * 32 + 8 * fq);
#pragma unroll
          for (int half = 0; half < 2; ++half) {
              const LAS float* mb = ml + (win * 8 + half * 4 + (fr >> 2)) * 16 + (fr & 3);
              const unsigned m01 = pk2(mb[0], mb[4]), m23 = pk2(mb[8], mb[12]); const bool on = fq == half * 2 + (fr >> 3); const bool hi4 = (fr >> 2) & 1;
              const bf16x8 ma = __builtin_bit_cast(bf16x8, (u32x4){on && !hi4 ? m01 : 0u, on && !hi4 ? m23 : 0u, on && hi4 ? m01 : 0u, on && hi4 ? m23 : 0u});
              const f32x4 pt = __builtin_amdgcn_mfma_f32_16x16x32_bf16(ma, xb, zero4, 0, 0, 0);
              *(LAS u32x2*)(lds + O_CT + ((tt * 16 + fr) * LX + (2 * win + half) * 16 + 4 * fq) * 2) = (u32x2){pk2(pt[0], pt[1]), pk2(pt[2], pt[3])}; } } }
    __syncthreads();
    { const int ti = w >> 1; f32x4 acc[2] = {(f32x4){0.f, 0.f, 0.f, 0.f}, (f32x4){0.f, 0.f, 0.f, 0.f}};
#pragma unroll 4
      for (int kq = 0; kq < 16; ++kq) { const bf16x8 pb = frag(lds, O_CT, LX, ti * 16 + fr, kq * 32 + 8 * fq);
#pragma unroll
          for (int q = 0; q < 2; ++q) acc[q] = __builtin_amdgcn_mfma_f32_16x16x32_bf16(frag(lds, O_XC, LX, (2 * (w & 1) + q) * 16 + fr, kq * 32 + 8 * fq), pb, acc[q], 0, 0, 0); }
#pragma unroll
      for (int q = 0; q < 2; ++q) { const int j0 = (2 * (w & 1) + q) * 16 + 4 * fq, i = ti * 16 + fr;
          *(u32x2*)(SB + (size_t)i * 64 + j0) = (u32x2){pk2(acc[q][0], acc[q][1]), pk2(acc[q][2], acc[q][3])}; } }
    __syncthreads();
}
__device__ __forceinline__ void gv_chain(const Ctx& c, const Params& P, int chain) {
    const int b = chain >> 3, h = (chain >> 1) & 3, dir = chain & 1, lane = c.lane, w = c.wave;
    const float* GT = gates_ptr(gmem(P.ws_())); float* GV = gv_ptr(gmem(P.ws_())) + (size_t)chain * NCT * 384;
    const float bi = gmem(P.in_(I_BBIF))[dir * 8 + h], bf = gmem(P.in_(I_BBIF))[dir * 8 + 4 + h];
    LAS float* cm = (LAS float*)c.lds;
    constexpr int NPW = (NCT + NWAVES - 1) / NWAVES;
    float bcr[NPW], ar[NPW], pmr[NPW], igr[NPW];
#pragma unroll
    for (int k = 0; k < NPW; ++k) { const int ci = w + k * NWAVES;
        bcr[k] = 0.f; ar[k] = 0.f; pmr[k] = 0.f; igr[k] = 0.f;
        if (ci < NCT) {
            const int isctx = ci < NCC; const int ch = isctx ? (dir ? NCC - 1 - ci : ci) : (dir ? NCT - 1 - ci : ci - NCC);
            const int rl = row_of(isctx, b, ch * 64 + (dir ? 63 - lane : lane));
            float ig = bi, fg = bf;
#pragma unroll
            for (int sl = 0; sl < GATE_NSL; ++sl) { const float* gr = GT + ((size_t)sl * MT + rl) * 16 + dir * 8 + h; ig += gr[0]; fg += gr[4]; }
            float bc = log_sigmoidf_(fg);
#pragma unroll
            for (int o = 1; o < 64; o <<= 1) { const float u = __shfl(bc, lane >= o ? lane - o : lane); if (lane >= o) bc += u; }
            const float a = ig - bc; float pm = a;
#pragma unroll
            for (int o = 1; o < 64; o <<= 1) { const float u = __shfl(pm, lane >= o ? lane - o : lane); if (lane >= o) pm = fmaxf(pm, u); }
            bcr[k] = bc; ar[k] = a; pmr[k] = pm; igr[k] = ig;
            if (lane == 63) { cm[2 * ci] = pm; cm[2 * ci + 1] = bc; } } }
    __syncthreads();
    if (c.tid == 0) { float m0 = -1e30f;
        for (int ci = 0; ci < NCT; ++ci) { const float pm63 = cm[2 * ci], b63 = cm[2 * ci + 1]; const float mn = b63 + fmaxf(m0, pm63); cm[2 * ci] = m0; cm[2 * ci + 1] = mn; m0 = mn; } }
    __syncthreads();
#pragma unroll
    for (int k = 0; k < NPW; ++k) { const int ci = w + k * NWAVES;
        if (ci < NCT) {
            const int isctx = ci < NCC; const int ch = isctx ? (dir ? NCC - 1 - ci : ci) : (dir ? NCT - 1 - ci : ci - NCC); const int gch = isctx ? ch : NCC + ch;
            const float m0 = cm[2 * ci], mnew = cm[2 * ci + 1], bc = bcr[k], a = ar[k], ig = igr[k];
            const float mrow = bc + fmaxf(m0, pmr[k]); const float b63 = __shfl(bc, 63);
            float* g = GV + (size_t)gch * 384;
            g[lane] = bc - mrow; g[64 + lane] = a; g[128 + lane] = __expf(bc + m0 - mrow); g[192 + lane] = __expf(b63 - bc + ig - mnew); g[256 + lane] = __expf(-mrow);
            g[320 + lane] = __expf(b63 + m0 - mnew); } }
    __syncthreads();
}
__device__ __forceinline__ void phase_score1(const Ctx& c, const Params& P) {
    bf16_t* SB = sraw_ptr(gmem(P.ws_()));
    const bool split = c.G > 64; const int nsb = split ? c.G - 32 : c.G;
    if (!split || c.bid < nsb)
        for (int u = c.bid; u < NB * 4 * NCL; u += nsb) { const int b = u / (4 * NCL), h = (u / NCL) % 4, ch = u % NCL; score_unit(c, P, b, h, ch, SB + (size_t)u * 4096); }
    if (split) { if (c.bid >= nsb) for (int ch = c.bid - nsb; ch < NB * 8; ch += 32) gv_chain(c, P, ch); }
    else for (int ch = c.bid; ch < NB * 8; ch += c.G) gv_chain(c, P, ch);
}
__device__ __forceinline__ void phase_score2(const Ctx& c, const Params& P) {
    const bf16_t* SB = sraw_ptr(gmem(P.ws_())); bf16_t* SD = sdec_ptr(gmem(P.ws_())); const float* GV = gv_ptr(gmem(P.ws_()));
    const int ti_ = c.tid >> 3, seg = c.tid & 7;
    for (int u = c.bid; u < NB * 8 * NCL; u += c.G) { const int chain = u / NCL, ch = u % NCL, dir = chain & 1;
        const bf16_t* sb = SB + (size_t)((chain >> 1) * NCL + ch) * 4096; const float* g = GV + ((size_t)chain * NCT + NCC + ch) * 384;
        const u32x4 sv = dir ? *(const u32x4*)(sb + (63 - ti_) * 64 + 56 - 8 * seg) : *(const u32x4*)(sb + ti_ * 64 + 8 * seg);
        const float ui = g[ti_]; const f32x4 a0 = *(const f32x4*)(g + 64 + 8 * seg), a1 = *(const f32x4*)(g + 64 + 8 * seg + 4);
        const unsigned sw[4] = {sv.x, sv.y, sv.z, sv.w}; float s8[8];
#pragma unroll
        for (int e = 0; e < 8; ++e) { const int fe = dir ? 7 - e : e; const float raw = (fe & 1) ? bfhi(sw[fe >> 1]) : bflo(sw[fe >> 1]); const int j = 8 * seg + e;
            s8[e] = (j <= ti_) ? raw * __expf(fminf(ui + (e < 4 ? a0[e] : a1[e - 4]), 0.f)) : 0.f; }
        *(u32x4*)(SD + (size_t)u * 4096 + ti_ * 64 + 8 * seg) = (u32x4){pk2(s8[0], s8[1]), pk2(s8[2], s8[3]), pk2(s8[4], s8[5]), pk2(s8[6], s8[7])}; }
}

__device__ __forceinline__ void chain(const Ctx& c, const Params& P, int dir, int b, int h, int eb) {
    const int tid = c.tid, lane = c.lane, w = c.wave, fr = lane & 15, fq = lane >> 4;
    unsigned char* wsg = gmem(P.ws_());
    const bf16_t* XMC = (const bf16_t*)(wsg + WS_BIG);
    bf16_t* O = (bf16_t*)(wsg + WS_BIG + (size_t)MT * 4096 * 2);
    const int chainid = (b * 4 + h) * 2 + dir;
    const bf16_t* SD = sdec_ptr(wsg) + (size_t)chainid * NCL * 4096; const float* GV = gv_ptr(wsg) + (size_t)chainid * NCT * 384;
    const int ti_ = tid >> 3, seg = tid & 7;
    const int ip_ = dir ? 63 - ti_ : ti_, roff_l = lat_off(ip_);
    { LAS unsigned char* lds = c.lds; LAS bf16_t* ml = (LAS bf16_t*)(lds + O_M); const float* MB = (const float*)(P.ws_() + WS_GATES + 3 * MiB / 2) + (size_t)h * 128 * 16;
      for (int i = tid; i < 128 * 16; i += NTHREADS) ml[i] = (bf16_t)f2bf(MB[i]);
      for (int i = tid; i < 33 * LX / 2; i += NTHREADS) ((LAS unsigned*)(lds + O_CT))[i] = 0u;
    }
    f32x4 cst[12];
#pragma unroll
    for (int t = 0; t < 12; ++t) cst[t] = (f32x4){0.f, 0.f, 0.f, 0.f};
    __syncthreads();
    const int ti = w >> 1, te = w & 1;
#define SC1_CHUNK(ci_, isctx_, ch_) const int isctx_ = (ci_) < NCC; const int ch_ = isctx_ ? (dir ? NCC - 1 - (ci_) : (ci_)) : (dir ? NCT - 1 - (ci_) : (ci_) - NCC);
    u32x4 pf_s = (u32x4){0u, 0u, 0u, 0u}, pf_v = pf_s, pf_o = pf_s; float pf_g = 0.f, pf_wk = 0.f;
#define SC1_PREFETCH(ci_) do { SC1_CHUNK(ci_, ic_, ch_) const int row_ = chunk_rb(ic_, b, ch_) + (ic_ ? ip_ : roff_l); const float* g_ = GV + (size_t)(ic_ ? ch_ : NCC + ch_) * 384; \
        stage_xc<0, 2, LXC>(c, c.lds, XMC, ic_, b, ch_, h, dir); \
        if (seg < 4) pf_v = *(const u32x4*)(XMC + (size_t)row_ * 4096 + h * 512 + eb * EB + seg * 8); \
        if (!ic_) { pf_s = *(const u32x4*)(SD + (size_t)ch_ * 4096 + ti_ * 64 + 8 * seg); \
            if (dir && seg < 4) pf_o = *(const u32x4*)(O + (size_t)row_ * 2048 + h * 512 + eb * EB + seg * 8); } \
        pf_wk = g_[192 + ti_]; if (tid < 193) pf_g = g_[tid < 192 ? 128 + tid : 320]; } while (0)
    u32x4 st_v = (u32x4){0u, 0u, 0u, 0u}; bf16_t* st_p = O; bool st_on = false;
    SC1_PREFETCH(0);
    { SC1_CHUNK(0, ic0_, ch0_) stage_xc<2, 8, LXC>(c, c.lds, XMC, ic0_, b, ch0_, h, dir); }
    for (int ci = 0; ci < NCT; ++ci) {
        LAS unsigned char* lds = c.lds; LAS float* vec = (LAS float*)(lds + O_VEC);
        SC1_CHUNK(ci, isctx, ch)
        const int row = chunk_rb(isctx, b, ch) + (isctx ? ip_ : roff_l);
        if (tid < 193) vec[tid] = pf_g;
        if (seg < 6) { const float wkj = pf_wk; u32x4 xv = pf_v, wv;
            if (seg >= 4) { xv = (u32x4){seg == 4 ? 0x3f80u : 0u, 0u, 0u, 0u}; }
            wv.x = pk2(bflo(xv.x) * wkj, bfhi(xv.x) * wkj); wv.y = pk2(bflo(xv.y) * wkj, bfhi(xv.y) * wkj); wv.z = pk2(bflo(xv.z) * wkj, bfhi(xv.z) * wkj); wv.w = pk2(bflo(xv.w) * wkj, bfhi(xv.w) * wkj);
            *(LAS u32x4*)(lds + O_V + (ti_ * LV + seg * 8) * 2) = xv; *(LAS u32x4*)(lds + O_VW + (ti_ * LV + seg * 8) * 2) = wv; }
        if (!isctx) *(LAS u32x4*)(lds + O_S + (ti_ * LS + 8 * seg) * 2) = pf_s;
        ASM_VMCNT(0); __syncthreads();
        const float decay0 = vec[192];
        if (!isctx) {
            LAS float* ost = (LAS float*)(lds + O_OST);
            { const int t2 = w & 3, kh = w >> 2; f32x4 aT[3], a1 = (f32x4){0.f, 0.f, 0.f, 0.f}, a1o = (f32x4){0.f, 0.f, 0.f, 0.f};
              LAS float* osth = ost + kh * 64 * 34;
#pragma unroll
              for (int q = 0; q < 3; ++q) aT[q] = (f32x4){0.f, 0.f, 0.f, 0.f};
              typedef short v4i16_t __attribute__((ext_vector_type(4)));
              bf16x8 sa_[2], va_[2]; f32x4 wi4;
              const bf16x8 vones = __builtin_bit_cast(bf16x8, fr == 0 ? (u32x4){0x3f803f80u, 0x3f803f80u, 0x3f803f80u, 0x3f803f80u} : (u32x4){0u, 0u, 0u, 0u});
              const LAS unsigned char* px = lds + O_XC + ((t2 * 16 + fr) * LXC + kh * 256 + 8 * fq) * 2;
              const LAS unsigned char* pc = lds + O_CT + (fr * LX + kh * 256 + 8 * fq) * 2;
              bf16x8 xa_[IPD + 1], cb_[IPD + 1][3];
#define SC1_LOADB(k_) do { xa_[(k_) % (IPD + 1)] = *(const LAS bf16x8*)(px + (k_) * 64); \
                  _Pragma("unroll") for (int q = 0; q < 3; ++q) cb_[(k_) % (IPD + 1)][q] = *(const LAS bf16x8*)(pc + q * 16 * LX * 2 + (k_) * 64); } while (0)
#pragma unroll
              for (int k = 0; k < IPD; ++k) SC1_LOADB(k);
#pragma unroll
              for (int k = 0; k < 8; ++k) {
                  if (k + IPD < 8) SC1_LOADB(k + IPD);
                  if (k == 8 - 1 - IPD) {
              { const LAS unsigned char* ps = lds + O_S + ((t2 * 16 + fr) * LS + 8 * fq) * 2; const LAS unsigned char* pv = lds + O_V + ((8 * fq + (fr >> 2)) * LV + 4 * (fr & 3)) * 2;
                wi4 = *(const LAS f32x4*)(vec + t2 * 16 + 4 * fq);
#pragma unroll
                for (int kq = 0; kq < 2; ++kq) { sa_[kq] = *(const LAS bf16x8*)(ps + kq * 64);
                    const v4i16_t t0 = __builtin_amdgcn_ds_read_tr16_b64_v4i16((LAS v4i16_t*)(pv + kq * 32 * LV * 2 + kh * 32)), t1 = __builtin_amdgcn_ds_read_tr16_b64_v4i16((LAS v4i16_t*)(pv + kq * 32 * LV * 2 + kh * 32 + 4 * LV * 2));
                    va_[kq] = (bf16x8){t0[0], t0[1], t0[2], t0[3], t1[0], t1[1], t1[2], t1[3]};
                    } }
                  }
                  SCHED_FENCE();
#pragma unroll
                  for (int q = 0; q < 3; ++q) aT[q] = __builtin_amdgcn_mfma_f32_16x16x32_bf16(xa_[k % (IPD + 1)], cb_[k % (IPD + 1)][q], aT[q], 0, 0, 0);
                  SCHED_FENCE(); }
#undef SC1_LOADB
#pragma unroll
              for (int kq = 0; kq < 2; ++kq) { a1 = __builtin_amdgcn_mfma_f32_16x16x32_bf16(sa_[kq], va_[kq], a1, 0, 0, 0);
                  if (kh == 0) a1o = __builtin_amdgcn_mfma_f32_16x16x32_bf16(sa_[kq], vones, a1o, 0, 0, 0); }
#pragma unroll
              for (int r = 0; r < 4; ++r) { const int i = t2 * 16 + 4 * fq + r; const float wi = wi4[r];
                  osth[i * 34 + fr] = wi * aT[0][r] + (kh == 0 ? a1[r] : 0.f);
                  osth[i * 34 + 16 + fr] = wi * aT[1][r] + (kh == 1 ? a1[r] : 0.f);
                  LAS float* dst = fr == 0 ? osth + i * 34 + 32 : (LAS float*)(lds + O_DUMP) + lane;
                  *dst = wi * aT[2][r] + a1o[r]; } }
        }
        { typedef short v4i16_t __attribute__((ext_vector_type(4)));
          bf16x8 vb[2][3], xa[4][2];
          const LAS unsigned char* pv = lds + O_VW + ((8 * fq + (fr >> 2)) * LV + 4 * (fr & 3)) * 2; const LAS unsigned char* pxt = lds + O_XC + ((8 * fq + (fr >> 2)) * LXC + 64 * w + 4 * (fr & 3)) * 2;
#pragma unroll
          for (int kq = 0; kq < 2; ++kq)
#pragma unroll
              for (int e2 = 0; e2 < 3; ++e2) { const v4i16_t t0 = __builtin_amdgcn_ds_read_tr16_b64_v4i16((LAS v4i16_t*)(pv + kq * 32 * LV * 2 + e2 * 32)), t1 = __builtin_amdgcn_ds_read_tr16_b64_v4i16((LAS v4i16_t*)(pv + kq * 32 * LV * 2 + e2 * 32 + 4 * LV * 2));
                  vb[kq][e2] = (bf16x8){t0[0], t0[1], t0[2], t0[3], t1[0], t1[1], t1[2], t1[3]}; }
#pragma unroll
          for (int dt = 0; dt < 4; ++dt)
#pragma unroll
              for (int kq = 0; kq < 2; ++kq) { const v4i16_t t0 = __builtin_amdgcn_ds_read_tr16_b64_v4i16((LAS v4i16_t*)(pxt + kq * 32 * LXC * 2 + dt * 32)), t1 = __builtin_amdgcn_ds_read_tr16_b64_v4i16((LAS v4i16_t*)(pxt + kq * 32 * LXC * 2 + dt * 32 + 4 * LXC * 2));
                  xa[dt][kq] = (bf16x8){t0[0], t0[1], t0[2], t0[3], t1[0], t1[1], t1[2], t1[3]}; }
          SCHED_FENCE();
#pragma unroll
          for (int dt = 0; dt < 4; ++dt)
#pragma unroll
              for (int e2 = 0; e2 < 3; ++e2) { f32x4 u = decay0 * cst[dt * 3 + e2];
#pragma unroll
                  for (int kq = 0; kq < 2; ++kq) u = __builtin_amdgcn_mfma_f32_16x16x32_bf16(xa[dt][kq], vb[kq][e2], u, 0, 0, 0);
                  cst[dt * 3 + e2] = u; } }
        bf16x8 mA[4];
#pragma unroll
        for (int dt = 0; dt < 4; ++dt) { const u32x2 mrow = *(const LAS u32x2*)(lds + O_M + (((4 * w + dt) * 4 + fq) * 16 + (fr & 3) * 4) * 2);
            mA[dt] = __builtin_bit_cast(bf16x8, (fq == (fr >> 2)) ? (u32x4){mrow.x, mrow.y, 0u, 0u} : (u32x4){0u, 0u, 0u, 0u}); }
        const float emr_i = vec[128 + ti_];
        __syncthreads();
        const u32x4 cur_o = pf_o;
        if (st_on && seg < 4) *(u32x4*)st_p = st_v;
        f32x2 ra[4], rb[4]; float d0, d1;
        { const LAS float* ost = (const LAS float*)(lds + O_OST) + ti_ * 34 + (seg & 3) * 8; const LAS float* ost2 = ost + 64 * 34;
#pragma unroll
          for (int e = 0; e < 4; ++e) { ra[e] = *(const LAS f32x2*)(ost + 2 * e); rb[e] = *(const LAS f32x2*)(ost2 + 2 * e); }
          d0 = ost[32 - (seg & 3) * 8]; d1 = ost2[32 - (seg & 3) * 8]; }
        if (ci + 1 < NCT) SC1_PREFETCH(ci + 1);
#pragma unroll
        for (int t = 0; t < 12; ++t) { const int td = 4 * w + t / 3, e2 = t % 3;
            const bf16x8 cb = __builtin_bit_cast(bf16x8, (u32x4){pk2(cst[t][0], cst[t][1]), pk2(cst[t][2], cst[t][3]), 0u, 0u});
            const f32x4 zero4 = {0.f, 0.f, 0.f, 0.f};
            const f32x4 o = __builtin_amdgcn_mfma_f32_16x16x32_bf16(mA[t / 3], cb, zero4, 0, 0, 0);
            const int ctoff = O_CT + ((e2 * 16 + fr) * LX + td * 16 + 4 * fq) * 2;
            *(LAS u32x2*)(lds + ((e2 < 2 || fr == 0) ? ctoff : O_DUMP + lane * 8)) = (u32x2){pk2(o[0], o[1]), pk2(o[2], o[3])};
            if ((t & 1) && ci + 1 < NCT) { SC1_CHUNK(ci + 1, icn_, chn_)
                if (t == 1) stage_xc<2, 3, LXC>(c, c.lds, XMC, icn_, b, chn_, h, dir); else if (t == 3) stage_xc<3, 4, LXC>(c, c.lds, XMC, icn_, b, chn_, h, dir);
                else if (t == 5) stage_xc<4, 5, LXC>(c, c.lds, XMC, icn_, b, chn_, h, dir); else if (t == 7) stage_xc<5, 6, LXC>(c, c.lds, XMC, icn_, b, chn_, h, dir);
                else if (t == 9) stage_xc<6, 7, LXC>(c, c.lds, XMC, icn_, b, chn_, h, dir); else stage_xc<7, 8, LXC>(c, c.lds, XMC, icn_, b, chn_, h, dir); } }
        st_on = !isctx;
        if (!isctx && seg < 4) {
            const float rdn = 1.0f / fmaxf(fabsf(d0 + d1), emr_i); float o[8];
#pragma unroll
            for (int e = 0; e < 4; ++e) { o[2 * e] = (ra[e][0] + rb[e][0]) * rdn; o[2 * e + 1] = (ra[e][1] + rb[e][1]) * rdn; }
            st_p = O + (size_t)row * 2048 + h * 512 + eb * EB + seg * 8;
            if (dir) { const u32x4 pv = cur_o; o[0] += bflo(pv.x); o[1] += bfhi(pv.x); o[2] += bflo(pv.y); o[3] += bfhi(pv.y); o[4] += bflo(pv.z); o[5] += bfhi(pv.z); o[6] += bflo(pv.w); o[7] += bfhi(pv.w); }
            st_v = (u32x4){pk2(o[0], o[1]), pk2(o[2], o[3]), pk2(o[4], o[5]), pk2(o[6], o[7])};
        }
    }
    if (st_on && seg < 4) *(u32x4*)st_p = st_v;
    __syncthreads();
#undef SC1_CHUNK
#undef SC1_PREFETCH
}
}
__device__ __forceinline__ void phase_scan1(const Ctx& c, const Params& P, int dir) {
    const int nitems = NB * 64;
    for (int it = c.bid; it < nitems; it += c.G) { sc1::chain(c, P, dir, it / 64, (it % 64) >> 4, it & 15); __syncthreads(); }
}
__device__ __forceinline__ void phase_post1(const Ctx& c, const Params& P) {
    const bf16_t* XMC = (const bf16_t*)(P.ws_() + WS_BIG); bf16_t* O = (bf16_t*)(P.ws_() + WS_BIG + (size_t)MT * 4096 * 2);
    const float* mh = P.in_(I_BMHN); const float* sk = P.in_(I_BSKIP); const float* wv = P.in_(I_BWV);
    const int gw = c.bid * NWAVES + c.wave, NGW = c.G * NWAVES, lane = c.lane;
    LAS float* wl = (LAS float*)c.lds; LAS float* ml = wl + 32 * 64 * 4; LAS float* sl = ml + 8 * 64 * 4;
    for (int i = c.tid; i < 512 * 16; i += NTHREADS) { const int n = i >> 4, dp = (i >> 2) & 3, e = i & 3; wl[(((n & 7) * 4 + dp) * 64 + (n >> 3)) * 4 + e] = wv[i]; }
    for (int i = c.tid; i < 2048; i += NTHREADS) { const int ln = i >> 5, q = (i >> 2) & 7, e = i & 3; ml[(q * 64 + ln) * 4 + e] = mh[i]; sl[(q * 64 + ln) * 4 + e] = sk[i]; }
    __syncthreads();
    for (int row = gw; row < ML; row += NGW) {
        u32x4 oc[4], xcv[4], zv[4];
#pragma unroll
        for (int q = 0; q < 4; ++q) { oc[q] = *(const u32x4*)(O + (size_t)row * 2048 + 32 * lane + 8 * q); xcv[q] = *(const u32x4*)(XMC + (size_t)row * 4096 + 2048 + 32 * lane + 8 * q); zv[q] = *(const u32x4*)(XMC + (size_t)row * 4096 + 32 * lane + 8 * q); }
        unsigned hp[16]; float s = 0.f, s2 = 0.f;
#pragma unroll
        for (int q = 0; q < 4; ++q) { const u32x4 a = oc[q]; const unsigned aw[4] = {a.x, a.y, a.z, a.w};
            float raw[8];
#pragma unroll
            for (int e = 0; e < 4; ++e) { raw[2 * e] = bflo(aw[e]); raw[2 * e + 1] = bfhi(aw[e]); }
#pragma unroll
            for (int bl = 0; bl < 2; ++bl) { const LAS float* wb = wl + ((2 * q + bl) * 4 * 64 + lane) * 4;
                const f32x4 r0 = *(const LAS f32x4*)wb, r1 = *(const LAS f32x4*)(wb + 256), r2 = *(const LAS f32x4*)(wb + 512), r3 = *(const LAS f32x4*)(wb + 768);
                float t[4];
#pragma unroll
                for (int e = 0; e < 4; ++e) { const float v = raw[bl * 4] * r0[e] + raw[bl * 4 + 1] * r1[e] + raw[bl * 4 + 2] * r2[e] + raw[bl * 4 + 3] * r3[e]; t[e] = v; s += v; s2 += v * v; }
                hp[q * 4 + bl * 2] = pk2(t[0], t[1]); hp[q * 4 + bl * 2 + 1] = pk2(t[2], t[3]); } }
        s += __shfl_xor(s, 1); s2 += __shfl_xor(s2, 1); s += __shfl_xor(s, 2); s2 += __shfl_xor(s2, 2); s += __shfl_xor(s, 4); s2 += __shfl_xor(s2, 4); s += __shfl_xor(s, 8); s2 += __shfl_xor(s2, 8);
        const float mu = s * (1.0f / 512.0f);
        const float rs = 1.0f / sqrtf(fmaxf(s2 * (1.0f / 512.0f) - mu * mu, 0.f) + EPS);
#pragma unroll
        for (int q = 0; q < 4; ++q) { const int ch = 32 * lane + 8 * q;
            const u32x4 xc = xcv[q], z = zv[q];
            const unsigned xw[4] = {xc.x, xc.y, xc.z, xc.w}, zw[4] = {z.x, z.y, z.z, z.w}; unsigned o[4];
            const f32x4 mh0 = *(const LAS f32x4*)(ml + ((2 * q) * 64 + lane) * 4), mh1 = *(const LAS f32x4*)(ml + ((2 * q + 1) * 64 + lane) * 4);
            const f32x4 sk0 = *(const LAS f32x4*)(sl + ((2 * q) * 64 + lane) * 4), sk1 = *(const LAS f32x4*)(sl + ((2 * q + 1) * 64 + lane) * 4);
#pragma unroll
            for (int e = 0; e < 4; ++e) { const int j = 2 * (e & 1); const f32x4 mm_ = e < 2 ? mh0 : mh1, ss_ = e < 2 ? sk0 : sk1;
                const float f0 = ((bflo(hp[q * 4 + e]) - mu) * rs * mm_[j] + ss_[j] * bflo(xw[e])) * siluf_(bflo(zw[e]));
                const float f1 = ((bfhi(hp[q * 4 + e]) - mu) * rs * mm_[j + 1] + ss_[j + 1] * bfhi(xw[e])) * siluf_(bfhi(zw[e]));
                o[e] = pk2(f0, f1); }
            *(u32x4*)(O + (size_t)row * 2048 + ch) = (u32x4){o[0], o[1], o[2], o[3]}; }
    }
    __syncthreads();
}
__device__ __forceinline__ void phase_final(const Ctx& c, const Params& P) {
    const float* w = P.in_(I_FNORM); const int gw = c.bid * NWAVES + c.wave, NGW = c.G * NWAVES;
    f32x4 wv[4];
#pragma unroll
    for (int j = 0; j < 4; ++j) wv[j] = *(const f32x4*)(w + 4 * c.lane + 256 * j);
    f32x4 nv[4];
    if (gw < ML) {
#pragma unroll
        for (int j = 0; j < 4; ++j) nv[j] = *(const f32x4*)(P.out_() + (size_t)gw * D + 4 * c.lane + 256 * j); }
    for (int row = gw; row < ML; row += NGW) { float* xr = P.out_() + (size_t)row * D; f32x4 v[4]; float s = 0.f;
#pragma unroll
        for (int j = 0; j < 4; ++j) v[j] = nv[j];
        if (row + NGW < ML) {
#pragma unroll
            for (int j = 0; j < 4; ++j) nv[j] = *(const f32x4*)(xr + (size_t)NGW * D + 4 * c.lane + 256 * j); }
#pragma unroll
        for (int j = 0; j < 4; ++j) s += (v[j].x * v[j].x + v[j].y * v[j].y) + (v[j].z * v[j].z + v[j].w * v[j].w);
        const float rs = 1.0f / sqrtf(wave_sum(s) * (1.0f / D) + EPS);
#pragma unroll
        for (int j = 0; j < 4; ++j) *(f32x4*)(xr + 4 * c.lane + 256 * j) = v[j] * rs * wv[j]; }
}

enum { PH_PRO = 0, PH_H0, PH_G0, PH_PREP0B, PH_S0, PH_GZ, PH_POST0, PH_G1, PH_H1, PH_G2, PH_G3, PH_H2, PH_G4, PH_PREP1, PH_GG, PH_SCORE1, PH_SCORE2, PH_S1F, PH_S1B, PH_H2B, PH_G5, PH_POST1, PH_G6, PH_H3, PH_G7, PH_G8, PH_FIN, PH_COUNT };

__device__ __forceinline__ void run_phase(int ph, const Params& P, LAS unsigned char* lds, int bid, int G, int tid) {
    Ctx c; c.lds = lds; c.tid = tid; c.lane = c.tid & 63; c.wave = __builtin_amdgcn_readfirstlane(c.tid >> 6); c.bid = bid; c.G = G;
    unsigned char* ws = P.ws_();
    float* mod = (float*)(ws + WS_MOD); float* mod1 = mod + (size_t)(NB + 1) * NMOD;
    bf16_t* WA = (bf16_t*)(ws + WS_WA); bf16_t* WB = (bf16_t*)(ws + WS_WB);
    bf16_t* H = (bf16_t*)(ws + WS_H); bf16_t* BIG = (bf16_t*)(ws + WS_BIG);
    float* ctxres = (float*)(ws + WS_CTXRES);
    switch (ph) {
    case PH_PRO: {
        phase_mods(c, P);
        int base = 0; const float* W = gmem(P.in_(I_AWIN));
        cvt_seg(c, W, A_IN, D, 0, 512, WA, C_Q, base);
        cvt_seg(c, W, A_IN, D, 512, 512, WA, C_K, base);
        cvt_seg(c, W, A_IN, D, 1024, 1024, WA, C_V, base);
        cvt_seg(c, W, A_IN, D, 4128, 1536, WA, C_XS, base);
        cvt_seg(c, W, A_IN, D, 3072, 32, WA, C_R, base);
        cvt_seg(c, W, A_IN, D, 5664, 32, WA, C_DT, base);
        { bf16_t* wgt = (bf16_t*)(ws + WS_GATES + 7 * MiB / 4); const float* wg = gmem(P.in_(I_AGW));
          for (int i = c.bid * NTHREADS + c.tid; i < 8 * 128 * 32; i += c.G * NTHREADS) { const int r = i & 31, kk = (i >> 5) & 127, dhh = i >> 12, dir = dhh >> 2, h = dhh & 3;
              wgt[i] = r < 16 ? (bf16_t)f2bf(wg[(size_t)dir * 16 * 512 + r * 512 + h * 128 + kk]) : (bf16_t)0; } }
        for (int i = c.bid * NTHREADS + c.tid; i < (NP0 - A_IN) * D / 8; i += c.G * NTHREADS) *(u32x4*)(WA + (size_t)A_IN * D + (size_t)i * 8) = (u32x4){0u, 0u, 0u, 0u};
    } break;
    case PH_H0: {
        phase_hnorm(c, gmem(P.in_(I_X)), gmem(P.in_(I_CTX)), gmem(P.in_(I_NMIX)), mod, 0, 1, H, 0, MT);
        int base = 0; const float* W = gmem(P.in_(I_AWIN));
        cvt_seg(c, W, A_IN, D, 2048, 1024, WA, C_G, base);
        cvt_seg(c, W, A_IN, D, 3104, 1024, WA, C_Z, base);
    } break;
    case PH_G0: {
        pg8::Gemm g{H, WA + (size_t)2048 * D, MT, NP0 - 2048, D, D}; pg8::StaticOrder S; S.init(MT, NP0 - 2048, D, G, bid);
        EpiStoreBf16Halo E{BIG + 2048, NP0, (bf16_t*)(ws + WS_WB)};
        pg8::gemm_phase(lds, g, S, E, c.tid);
    } break;
    case PH_PREP0B: sc0::phase_prep0b(c, P); break;
    case PH_S0: phase_scan0(c, P); break;
    case PH_GZ: {
        const int Mz = G >= 2 * (MC / 256) * 8 ? ML : MT;
        pg8::Gemm g{H, WA, Mz, 2048, D, D}; pg8::StaticOrder S; S.init(Mz, 2048, D, G, bid);
        EpiStoreBf16 E{BIG + C_G, NP0};
        pg8::gemm_phase(lds, g, S, E, c.tid);
    } break;
    case PH_POST0: {
        phase_post0(c, P);
        int base = 0; cvt_seg(c, gmem(P.in_(I_AWOUT)), D, 2048, 0, 1024, WB, 0, base);
    } break;
    case PH_G1: {
        pg8::Gemm g{BIG, WB, MT, D, 2048, NP0}; pg8::StaticOrderT<MC / 256, G1_NSL> S; S.init(ML, D, 2048, G, bid);
        EpiResid E{gmem(P.in_(I_X)), gmem(P.in_(I_CTX)), gmem(P.out_()), ctxres, mod + 2 * D, (float*)(BIG + 2048), NP0 / 2};
        pg8::gemm_phase(lds, g, S, E, c.tid);
        if (G == 256 && MC / 256 * 4 * G1_NSL < 256 && bid >= MC / 256 * 4 * G1_NSL) { __syncthreads(); Ctx c1 = c; c1.bid = bid - MC / 256 * 4 * G1_NSL; c1.G = 256 - MC / 256 * 4 * G1_NSL; int base = 0;
            for (int pn = 0; pn < DFF / 128; ++pn) { cvt_seg(c1, gmem(P.in_(I_W1)), DFF, D, 128 * pn, 128, WA, 256 * pn, base); cvt_seg(c1, gmem(P.in_(I_W3)), DFF, D, 128 * pn, 128, WA, 256 * pn + 128, base); } }
    } break;
    case PH_H1: {
        phase_hnorm(c, gmem(P.out_()), gmem(P.in_(I_CTX)), gmem(P.in_(I_NFFN)), mod, 3, 4, H, 0, MT, CtxFix{(const float*)(BIG + 2048), NP0 / 2, G1_NSL, mod + (size_t)NB * NMOD + 2 * D, ctxres});
        int base = 0;
        if (!(G == 256 && MC / 256 * 4 * G1_NSL < 256))
        for (int pn = 0; pn < DFF / 128; ++pn) { cvt_seg(c, gmem(P.in_(I_W1)), DFF, D, 128 * pn, 128, WA, 256 * pn, base); cvt_seg(c, gmem(P.in_(I_W3)), DFF, D, 128 * pn, 128, WA, 256 * pn + 128, base); }
        cvt_seg(c, gmem(P.in_(I_W2)), D, DFF, 0, 1024, WB, 0, base);
    } break;
    case PH_G2: {
        pg8::Gemm g{H, WA, MT, 2 * DFF, D, D}; pg8::StaticOrder S; S.init(MT, 2 * DFF, D, G, bid);
        EpiSwiGLU E{BIG, DFF};
        pg8::gemm_phase(lds, g, S, E, c.tid);
    } break;
    case PH_G3: {
        pg8::Gemm g{BIG, WB, MT, D, DFF, DFF}; pg8::StaticOrderT<MC / 256, G3_NSL> S; S.init(ML, D, DFF, G, bid);
        EpiResid E{gmem(P.out_()), ctxres, gmem(P.out_()), ctxres, mod + 5 * D, (float*)(BIG + (size_t)MT * DFF), D};
        pg8::gemm_phase(lds, g, S, E, c.tid);
    } break;
    case PH_H2: {
        phase_hnorm(c, gmem(P.out_()), ctxres, gmem(P.in_(I_NMIX)) + D, mod1, 0, 1, H, 0, MT, CtxFix{(const float*)(BIG + (size_t)MT * DFF), D, G3_NSL, mod + (size_t)NB * NMOD + 5 * D, ctxres});
        int base = 0;
        cvt_seg(c, gmem(P.in_(I_BWUP)), 4096, D, 0, 2048, WA, 0, base);
        if (!(G == 256 && MT / 256 * GATE_NSL < 256)) cvt_seg(c, gmem(P.in_(I_BWUP)), 4096, D, 2048, 2048, WB, 0, base);
        build_gate_weights(c, P, WA + (size_t)5 * MiB / 2);
        build_mblocks(c, P, (float*)(ws + WS_GATES + 3 * MiB / 2));
    } break;
    case PH_G4: {
        const int Mz = G >= 2 * (MC / 256) * 8 ? ML : MT;
        pg8::Gemm g{H, WA, Mz, 2048, D, D}; pg8::StaticOrder S; S.init(Mz, 2048, D, G, bid);
        EpiStoreBf16 E{BIG, 4096};
        pg8::gemm_phase(lds, g, S, E, c.tid);
    } break;
    case PH_PREP1: {
        constexpr int NXT = (MC / 256) * 8;
        if (G >= 2 * NXT) {
            if (bid < NXT) {
                pg8::Gemm g{H + (size_t)ML * D, WA, MC, 2048, D, D}; pg8::StaticOrder S; S.init(MC, 2048, D, NXT, bid);
                EpiStoreBf16 E{BIG + (size_t)ML * 4096, 4096};
                pg8::gemm_phase(lds, g, S, E, c.tid);
                static_assert(MC / 256 <= 8, "tile-of-workgroup formula below");
                const int wg_ = (bid % 8) * (MC / 256) + bid / 8, pm_ = wg_ % (MC / 256), pn_ = wg_ / (MC / 256);
                ASM_VMCNT(0); __syncthreads();
#ifndef EMU
                __builtin_amdgcn_fence(__ATOMIC_ACQUIRE, "agent");
#endif
                prep1_ctx_tile(c, P, pm_, pn_);
            } else { Ctx c1 = c; c1.bid = bid - NXT; c1.G = G - NXT; phase_prep1(c1, P, ML); }
        } else phase_prep1(c, P, MT);
    } break;
    case PH_GG: {
        pg8::Gemm g{BIG, WA + (size_t)5 * MiB / 2, MT, 256, 4096, 4096}; pg8::StaticOrderT<MT / 256, GATE_NSL> S; S.init(0, 256, 4096, G, bid);
        EpiGates E{gates_ptr(ws)};
        pg8::gemm_phase(lds, g, S, E, c.tid);
        if (G == 256 && MT / 256 * GATE_NSL < 256 && bid >= MT / 256 * GATE_NSL) { __syncthreads(); Ctx c1 = c; c1.bid = bid - MT / 256 * GATE_NSL; c1.G = 256 - MT / 256 * GATE_NSL; int base = 0;
            cvt_seg(c1, gmem(P.in_(I_BWUP)), 4096, D, 2048, 2048, WB, 0, base); }
    } break;
    case PH_SCORE1: sc1::phase_score1(c, P); break;
    case PH_SCORE2: sc1::phase_score2(c, P); break;
    case PH_S1F: phase_scan1(c, P, 0); break;
    case PH_S1B: phase_scan1(c, P, 1); break;
    case PH_H2B: phase_hnorm(c, gmem(P.out_()), ctxres, gmem(P.in_(I_NMIX)) + D, mod1, 0, 1, H, 0, ML); break;
    case PH_G5: {
        pg8::Gemm g{H, WB, ML, 2048, D, D}; pg8::StaticOrder S; S.init(ML, 2048, D, G, bid);
        EpiStoreBf16 E{BIG, 4096};
        pg8::gemm_phase(lds, g, S, E, c.tid);
    } break;
    case PH_POST1: {
        phase_post1(c, P);
        int base = 0; cvt_seg(c, gmem(P.in_(I_BWDOWN)), D, 2048, 0, 1024, WB, 0, base);
    } break;
    case PH_G6: {
        pg8::Gemm g{BIG + (size_t)MT * 4096, WB, ML, D, 2048, 2048}; pg8::StaticOrder S; S.init(ML, D, 2048, G, bid);
        EpiResid E{gmem(P.out_()), ctxres, gmem(P.out_()), ctxres, mod1 + 2 * D, nullptr, 0};
        pg8::gemm_phase(lds, g, S, E, c.tid);
    } break;
    case PH_H3: {
        phase_hnorm(c, gmem(P.out_()), ctxres, gmem(P.in_(I_NFFN)) + D, mod1, 3, 4, H, 0, ML);
        int base = 0; const float* w1 = gmem(P.in_(I_W1)) + (size_t)D * DFF; const float* w3 = gmem(P.in_(I_W3)) + (size_t)D * DFF;
        for (int pn = 0; pn < DFF / 128; ++pn) { cvt_seg(c, w1, DFF, D, 128 * pn, 128, WA, 256 * pn, base); cvt_seg(c, w3, DFF, D, 128 * pn, 128, WA, 256 * pn + 128, base); }
        if (!(G == 256 && ML / 256 * (2 * DFF / 256) == 1408)) cvt_seg(c, gmem(P.in_(I_W2)) + (size_t)DFF * D, D, DFF, 0, 1024, WB, 0, base);
    } break;
    case PH_G7: {
        pg8::Gemm g{H, WA, ML, 2 * DFF, D, D}; pg8::StaticOrder S; S.init(ML, 2 * DFF, D, G, bid);
        EpiSwiGLU E{BIG, DFF};
        pg8::gemm_phase(lds, g, S, E, c.tid);
        if (G == 256 && ML / 256 * (2 * DFF / 256) == 1408 && bid >= 128) { __syncthreads(); Ctx c1 = c; c1.bid = bid - 128; c1.G = 128; int base = 0;
            cvt_seg(c1, gmem(P.in_(I_W2)) + (size_t)DFF * D, D, DFF, 0, 1024, WB, 0, base); }
    } break;
    case PH_G8: {
        pg8::Gemm g{BIG, WB, ML, D, DFF, DFF}; pg8::StaticOrder S; S.init(ML, D, DFF, G, bid);
        EpiResid E{gmem(P.out_()), ctxres, gmem(P.out_()), ctxres, mod1 + 5 * D, nullptr, 0};
        pg8::gemm_phase(lds, g, S, E, c.tid);
    } break;
    case PH_FIN: phase_final(c, P); break;
    default: break;
    }
}

#ifndef EMU
#include <hip/hip_cooperative_groups.h>
namespace cg = cooperative_groups;
constexpr int LDS_BYTES = 147456;
#define XB_TMO      128
#define XB_XCNT(j)  (256  + 64 * (j))
#define XB_XSUB(j)  (1280 + 64 * (j))
#define XB_XGEN(j)  (2304 + 64 * (j))
#define XB_TOP      3328
#define XB_TOPGEN   3392
#define XCD_BAR_WORDS 3456
#define XB_SPIN_CAP (1u << 20)
__device__ __forceinline__ unsigned xb_ld(unsigned* p)              { return __hip_atomic_load(p, __ATOMIC_RELAXED, __HIP_MEMORY_SCOPE_AGENT); }
__device__ __forceinline__ unsigned xb_add(unsigned* p, unsigned v) { return __hip_atomic_fetch_add(p, v, __ATOMIC_RELAXED, __HIP_MEMORY_SCOPE_AGENT); }
__device__ __forceinline__ unsigned xb_xcc_id() { return (unsigned)__builtin_amdgcn_s_getreg((3 << 11) | 20) & 0xFu; }
#define XB_SPIN(cond, bar) do { unsigned _sp = 0; while (cond) { __builtin_amdgcn_s_sleep(1); \
    if ((++_sp & 255u) == 0u) { if (xb_ld(&(bar)[XB_TMO])) break; if (_sp > XB_SPIN_CAP) { atomicAdd(&(bar)[XB_TMO], 1u); break; } } } } while (0)
struct XcdBarrier { unsigned* bar; unsigned x; volatile LAS unsigned* st; };
__device__ __forceinline__ XcdBarrier xcd_barrier_post(unsigned* bar, volatile LAS unsigned* st) {
    XcdBarrier b; b.bar = bar; b.x = xb_xcc_id(); b.st = st;
    if (threadIdx.x == 0) (void)xb_add(&bar[XB_XCNT(b.x)], 1u);
    return b;
}
__device__ __forceinline__ void xcd_barrier_complete(unsigned* bar, unsigned x, unsigned& nloc, unsigned& nx) {
    const unsigned G = gridDim.x * gridDim.y * gridDim.z;
    unsigned sum, cnt, mine, sp = 0u;
    for (;;) {
        sum = 0u; cnt = 0u; mine = 0u;
#pragma unroll
        for (unsigned j = 0; j < 16; ++j) { const unsigned c = xb_ld(&bar[XB_XCNT(j)]); sum += c; cnt += (c > 0u) ? 1u : 0u; mine = (j == x) ? c : mine; }
        if (sum == G) break;
        __builtin_amdgcn_s_sleep(1);
        if ((++sp & 255u) == 0u) { if (xb_ld(&bar[XB_TMO])) break; if (sp > XB_SPIN_CAP) { atomicAdd(&bar[XB_TMO], 1u); break; } }
    }
    nloc = mine > 0u ? mine : 1u; nx = cnt > 0u ? cnt : 1u;
}
__device__ __forceinline__ void xcd_barrier(const XcdBarrier& b) {
    asm volatile("s_waitcnt vmcnt(0)" ::: "memory");
    __syncthreads();
    if (threadIdx.x == 0) {
        unsigned* bar = b.bar;
        __builtin_amdgcn_s_waitcnt(0);
        unsigned nloc = b.st[0], nx = b.st[1];
        if (nloc == 0u) { xcd_barrier_complete(bar, b.x, nloc, nx); b.st[0] = nloc; b.st[1] = nx; }
        const unsigned old = xb_add(&bar[XB_XSUB(b.x)], 1u);
        const unsigned gen = old / nloc;
        if (old + 1u == (gen + 1u) * nloc) {
            __builtin_amdgcn_fence(__ATOMIC_RELEASE, "agent");
            asm volatile("s_waitcnt vmcnt(0)" ::: "memory");
            const unsigned og = xb_add(&bar[XB_TOP], 1u);
            const unsigned tg = og / nx;
            if (og + 1u == (tg + 1u) * nx) xb_add(&bar[XB_TOPGEN], 1u);
            else XB_SPIN(xb_ld(&bar[XB_TOPGEN]) == tg, bar);
            __builtin_amdgcn_fence(__ATOMIC_ACQUIRE, "agent");
            xb_add(&bar[XB_XGEN(b.x)], 1u);
            asm volatile("s_waitcnt vmcnt(0)" ::: "memory");
        } else {
            XB_SPIN(xb_ld(&bar[XB_XGEN(b.x)]) == gen, bar);
            __builtin_amdgcn_fence(__ATOMIC_ACQUIRE, "agent");
            asm volatile("s_waitcnt vmcnt(0)" ::: "memory");
        }
    }
    __syncthreads();
}

__global__ void __launch_bounds__(NTHREADS, 2) fwd_megakernel(ParamsK K) {
    extern __shared__ __attribute__((aligned(16))) unsigned char lds[];
    cg::grid_group grid = cg::this_grid();
    LAS unsigned long long* pl = (LAS unsigned long long*)((LAS unsigned char*)lds + PARAM_LDS_OFF);
    volatile LAS unsigned* bst = (volatile LAS unsigned*)((LAS unsigned char*)lds + PARAM_LDS_OFF + 320);
    if (threadIdx.x == 0) {
#pragma unroll
        for (int i = 0; i < 34; ++i) pl[i] = (unsigned long long)K.in[i];
        pl[34] = (unsigned long long)K.out; pl[35] = (unsigned long long)K.ws;
        bst[0] = 0u; bst[1] = 0u;
    }
    __syncthreads();
    (void)xcd_barrier_post((unsigned*)(K.ws + WS_CTL), bst);
#pragma nounroll
    for (int ph = 0; ph < PH_COUNT; ++ph) {
        int phv = ph, bid = blockIdx.x, G = gridDim.x, tid = threadIdx.x; unsigned lo = 0;
        asm volatile("" : "+s"(phv), "+s"(bid), "+s"(G), "+s"(lo), "+v"(tid));
        Params P; P.pl = (const LAS unsigned long long*)((LAS unsigned char*)lds + PARAM_LDS_OFF + lo);
        run_phase(phv, P, (LAS unsigned char*)lds + lo, bid, G, tid);
#ifdef DUP_MASK
        if ((DUP_MASK >> ph) & 1u) {
            XcdBarrier bar; bar.bar = (unsigned*)(P.ws_() + WS_CTL); bar.x = xb_xcc_id(); bar.st = (volatile LAS unsigned*)((LAS unsigned char*)lds + lo + PARAM_LDS_OFF + 320);
            if (ph != 0) { xcd_barrier(bar); run_phase(phv, P, (LAS unsigned char*)lds + lo, bid, G, tid); } }
#endif
        if (ph == 0) grid.sync();
        else if (ph + 1 < PH_COUNT) {
            XcdBarrier bar; bar.bar = (unsigned*)(P.ws_() + WS_CTL); bar.x = xb_xcc_id(); bar.st = (volatile LAS unsigned*)((LAS unsigned char*)lds + lo + PARAM_LDS_OFF + 320);
            xcd_barrier(bar); }
    }
}
extern "C" void kernel_launch(void* const* d_in, const int* in_sizes, int n_in, void* d_out, int out_size, void* d_ws, size_t ws_size, hipStream_t stream) {
    static int grid = 0;
    if (grid == 0) {
        int dev = 0, cus = 0, per_cu = 0;
        (void)hipGetDevice(&dev); (void)hipDeviceGetAttribute(&cus, hipDeviceAttributeMultiprocessorCount, dev);
        (void)hipFuncSetAttribute((const void*)fwd_megakernel, hipFuncAttributeMaxDynamicSharedMemorySize, LDS_BYTES);
        if (hipOccupancyMaxActiveBlocksPerMultiprocessor(&per_cu, (const void*)fwd_megakernel, NTHREADS, LDS_BYTES) != hipSuccess || per_cu < 1) per_cu = 1;
        if (per_cu > 1) per_cu = 1;
        grid = (cus > 0 ? cus : 256) * per_cu;
        if (ws_size < WS_END) fprintf(stderr, "kernel_launch: workspace too small: %zu < %zu\n", ws_size, (size_t)WS_END);
    }
    ParamsK P{};
    for (int i = 0; i < 34; ++i) P.in[i] = (const float*)d_in[i];
    P.out = (float*)d_out; P.ws = (unsigned char*)d_ws;
    (void)hipMemsetAsync((char*)d_ws + WS_CTL, 0, CTL_ZERO_BYTES, stream);
    void* args[] = {&P};
    hipError_t e = hipLaunchCooperativeKernel((const void*)fwd_megakernel, dim3(grid), dim3(NTHREADS), args, LDS_BYTES, stream);
    if (e != hipSuccess) fprintf(stderr, "cooperative launch failed: %s (grid %d)\n", hipGetErrorString(e), grid);
}
#endif
```
